# Optimizing an MI355X kernel written in HIP

```python
import math
import jax, jax.numpy as jnp
from jax import lax
import numpy as np

D_MODEL = 2048
BATCH = 2
SEQ = 4096
DEPTH = 4

CTX_LEN = 256
GRID_W = 64
HY_WIDTH = 1024
ATT_HEADS = 8
KV_HEADS = 2
HEAD_DIM = 128
Q_PER_KV = ATT_HEADS // KV_HEADS
ATT_WIDTH = ATT_HEADS * HEAD_DIM
KV_WIDTH = KV_HEADS * HEAD_DIM
MIX_WIDTH = HY_WIDTH + ATT_WIDTH
IN_WIDTH = 3 * HY_WIDTH + ATT_WIDTH + 2 * KV_WIDTH
SPLITS = [3 * HY_WIDTH, 3 * HY_WIDTH + ATT_WIDTH, 3 * HY_WIDTH + ATT_WIDTH + KV_WIDTH]
HY_ORDER = 2
SHORT_CONV = 3
FILT_BANDS = 16
FILT_EMB = 1 + 2 * FILT_BANDS
FILT_HIDDEN = 64
DECAY_TARGET = 1e-2
FAST_DECAY_PCT = 0.3
SLOW_DECAY_PCT = 1.5
DECAY_MIN = math.log(DECAY_TARGET) / SLOW_DECAY_PCT
DECAY_MAX = math.log(DECAY_TARGET) / FAST_DECAY_PCT
WINDOW = 128
BLOCK = 128
ROPE_BASE = 10000.0
ROPE_PAIRS = HEAD_DIM // 4
SCALE = HEAD_DIM ** -0.5
NEG = -1e30
D_FF = -(-8 * D_MODEL // (3 * 256)) * 256
EPS = 1e-6

kernel_name = 'hybrid_hyena_swa_dit'


def rmsnorm(x, g):
    xf = x.astype(jnp.float32)
    y = xf * lax.rsqrt(jnp.mean(xf * xf, axis=-1, keepdims=True) + EPS)
    return y.astype(x.dtype) * g


def adaln(x, g, shift, scale):
    return rmsnorm(x, g) * (1.0 + scale) + shift


def short_conv(u, w, b):
    L = u.shape[1]
    pad = SHORT_CONV // 2
    up = jnp.pad(u, ((0, 0), (pad, pad), (0, 0)))
    return sum(up[:, j:j + L] * w[j] for j in range(SHORT_CONV)) + b


def hyena_filters(L, w1, b1, w2, b2, w3, freq):
    t = jnp.linspace(0.0, 1.0, L, dtype=jnp.float32)[:, None]
    w = (2.0 * math.pi / L) * jnp.arange(L, dtype=jnp.float32)[:, None]
    bands = jnp.linspace(1e-4, FILT_BANDS - 1, FILT_BANDS, dtype=jnp.float32)[None, :]
    emb = jnp.concatenate([t, jnp.cos(bands * w), -jnp.sin(bands * w)], axis=-1)
    hid = jnp.sin(freq * (emb @ w1 + b1))
    hid = jnp.sin(freq * (hid @ w2 + b2))
    h = (hid @ w3).reshape(L, HY_ORDER, 2, HY_WIDTH)
    deltas = jnp.abs(jnp.linspace(DECAY_MIN, DECAY_MAX, HY_WIDTH, dtype=jnp.float32))
    window = jnp.exp(-t * deltas)
    return h * window[:, None, None, :].astype(h.dtype)


def bidir_long_conv(z, h_fwd, h_bwd, bias):
    L = z.shape[1]
    taps = jnp.concatenate([h_fwd, jnp.zeros_like(h_fwd[:1]), h_bwd[:0:-1]], axis=0).astype(jnp.float32)
    tf = jnp.fft.rfft(taps, n=2 * L, axis=0)
    zf = jnp.fft.rfft(z.astype(jnp.float32), n=2 * L, axis=1)
    y = jnp.fft.irfft(zf * tf[None], n=2 * L, axis=1)[:, :L]
    return y.astype(z.dtype) + z * bias


def hyena_mixer(u, conv_w, conv_b, filt, filt_bias):
    u = short_conv(u, conv_w, conv_b)
    x1, x2, z = jnp.split(u, 3, axis=-1)
    for o, gate in enumerate((x1, x2)):
        z = gate * bidir_long_conv(z, filt[:, o, 0], filt[:, o, 1], filt_bias[o])
    return z


def rope_2d(x):
    L = x.shape[1]
    rows = L // GRID_W
    row = jnp.repeat(jnp.arange(rows, dtype=jnp.float32), GRID_W)
    col = jnp.tile(jnp.arange(GRID_W, dtype=jnp.float32), rows)
    inv = ROPE_BASE ** (-jnp.arange(ROPE_PAIRS, dtype=jnp.float32) / ROPE_PAIRS)

    def rot(xa, pos):
        ang = pos[:, None] * inv[None, :]
        cos = jnp.cos(ang)[None, :, None, :].astype(xa.dtype)
        sin = jnp.sin(ang)[None, :, None, :].astype(xa.dtype)
        a, b = jnp.split(xa, 2, axis=-1)
        return jnp.concatenate([a * cos - b * sin, a * sin + b * cos], axis=-1)

    half = HEAD_DIM // 2
    return jnp.concatenate([rot(x[..., :half], row), rot(x[..., half:], col)], axis=-1)


def window_attention(q, k, v, kc, vc, sink):
    B, L = q.shape[:2]
    C = kc.shape[1]
    nb = L // BLOCK
    nw = 3 * BLOCK
    qb = q.reshape(B, nb, BLOCK, KV_HEADS, Q_PER_KV, HEAD_DIM)

    def band(t):
        tp = jnp.pad(t, ((0, 0), (BLOCK, BLOCK), (0, 0), (0, 0))).reshape(B, nb + 2, BLOCK, KV_HEADS, HEAD_DIM)
        return jnp.concatenate([tp[:, :-2], tp[:, 1:-1], tp[:, 2:]], axis=2)

    kw, vw = band(k), band(v)
    s_win = jnp.einsum('bnqkgd,bnskd->bnkgqs', qb, kw).astype(jnp.float32) * SCALE
    qpos = jnp.arange(nb)[:, None, None] * BLOCK + jnp.arange(BLOCK)[None, :, None]
    kpos = jnp.arange(nb)[:, None, None] * BLOCK + jnp.arange(nw)[None, None, :] - BLOCK
    valid = (jnp.abs(kpos - qpos) <= WINDOW) & (kpos >= 0) & (kpos < L)
    s_win = jnp.where(valid[None, :, None, None], s_win, NEG)
    s_ctx = jnp.einsum('bnqkgd,bckd->bnkgqc', qb, kc).astype(jnp.float32) * SCALE
    s_sink = jnp.broadcast_to(sink.astype(jnp.float32).reshape(1, 1, KV_HEADS, Q_PER_KV, 1, 1),
                              s_win.shape[:-1] + (1,))
    p = jax.nn.softmax(jnp.concatenate([s_win, s_ctx, s_sink], axis=-1), axis=-1).astype(v.dtype)
    o = (jnp.einsum('bnkgqs,bnskd->bnqkgd', p[..., :nw], vw)
         + jnp.einsum('bnkgqc,bckd->bnqkgd', p[..., nw:nw + C], vc))
    return o.reshape(B, L, ATT_WIDTH)


def context_attention(qc, kc, vc, sink):
    B, C = qc.shape[:2]
    qg = qc.reshape(B, C, KV_HEADS, Q_PER_KV, HEAD_DIM)
    s = jnp.einsum('bqkgd,bckd->bkgqc', qg, kc).astype(jnp.float32) * SCALE
    s_sink = jnp.broadcast_to(sink.astype(jnp.float32).reshape(1, KV_HEADS, Q_PER_KV, 1, 1), s.shape[:-1] + (1,))
    p = jax.nn.softmax(jnp.concatenate([s, s_sink], axis=-1), axis=-1).astype(vc.dtype)
    o = jnp.einsum('bkgqc,bckd->bqkgd', p[..., :C], vc)
    return o.reshape(B, C, ATT_WIDTH)


def merge_groups(y_hy, y_at, g_hy, g_at, w_out):
    return jnp.concatenate([rmsnorm(y_hy, g_hy), rmsnorm(y_at, g_at)], axis=-1) @ w_out


def swiglu(h, w_gate, w_up, w_down):
    return (jax.nn.silu(h @ w_gate) * (h @ w_up)) @ w_down


def setup_inputs(seed: int = 0) -> dict:
    key = jax.random.key(seed)
    ks = jax.random.split(key, 32)

    def nrm(k, shape, s):
        return jax.random.normal(k, shape, jnp.float32) * s

    return {
        'x': nrm(ks[0], (BATCH, SEQ, D_MODEL), 1.0),
        'c': nrm(ks[1], (BATCH, D_MODEL), 1.0),
        'ctx': nrm(ks[2], (BATCH, CTX_LEN, D_MODEL), 1.0),
        'c_ctx': nrm(ks[3], (D_MODEL,), 1.0),
        'norm_mix_g': 1.0 + nrm(ks[4], (DEPTH, D_MODEL), 0.02),
        'norm_ffn_g': 1.0 + nrm(ks[5], (DEPTH, D_MODEL), 0.02),
        'w_mod': nrm(ks[6], (DEPTH, D_MODEL, 6 * D_MODEL), D_MODEL ** -0.5),
        'b_mod': nrm(ks[7], (DEPTH, 6 * D_MODEL), 0.02),
        'w_in': nrm(ks[8], (DEPTH, D_MODEL, IN_WIDTH), D_MODEL ** -0.5),
        'conv_w': nrm(ks[9], (DEPTH, SHORT_CONV, 3 * HY_WIDTH), SHORT_CONV ** -0.5),
        'conv_b': nrm(ks[10], (DEPTH, 3 * HY_WIDTH), 0.02),
        'filt_w1': nrm(ks[11], (DEPTH, FILT_EMB, FILT_HIDDEN), FILT_EMB ** -0.5),
        'filt_b1': nrm(ks[12], (DEPTH, FILT_HIDDEN), 0.1),
        'filt_w2': nrm(ks[13], (DEPTH, FILT_HIDDEN, FILT_HIDDEN), FILT_HIDDEN ** -0.5),
        'filt_b2': nrm(ks[14], (DEPTH, FILT_HIDDEN), 0.1),
        'filt_w3': nrm(ks[15], (DEPTH, FILT_HIDDEN, HY_ORDER * 2 * HY_WIDTH), 0.02),
        'filt_freq': 1.0 + nrm(ks[16], (DEPTH, FILT_HIDDEN), 0.02),
        'filt_bias': nrm(ks[17], (DEPTH, HY_ORDER, HY_WIDTH), 1.0),
        'attn_sink': nrm(ks[18], (DEPTH, ATT_HEADS), 0.5),
        'out_norm_hy': 1.0 + nrm(ks[19], (DEPTH, HY_WIDTH), 0.02),
        'out_norm_att': 1.0 + nrm(ks[20], (DEPTH, ATT_WIDTH), 0.02),
        'w_out': nrm(ks[21], (DEPTH, MIX_WIDTH, D_MODEL), MIX_WIDTH ** -0.5),
        'w_gate': nrm(ks[22], (DEPTH, D_MODEL, D_FF), D_MODEL ** -0.5),
        'w_up': nrm(ks[23], (DEPTH, D_MODEL, D_FF), D_MODEL ** -0.5),
        'w_down': nrm(ks[24], (DEPTH, D_FF, D_MODEL), D_FF ** -0.5),
        'final_g': 1.0 + nrm(ks[25], (D_MODEL,), 0.02),
    }


def reference(x, c, ctx, c_ctx, norm_mix_g, norm_ffn_g, w_mod, b_mod, w_in, conv_w, conv_b,
              filt_w1, filt_b1, filt_w2, filt_b2, filt_w3, filt_freq, filt_bias, attn_sink,
              out_norm_hy, out_norm_att, w_out, w_gate, w_up, w_down, final_g):
    B, L, _ = x.shape
    C = ctx.shape[1]
    silu_c = jax.nn.silu(c)
    silu_cc = jax.nn.silu(c_ctx)
    xc = ctx
    for i in range(DEPTH):
        last = i == DEPTH - 1
        mod = (silu_c @ w_mod[i] + b_mod[i]).reshape(B, 6, 1, D_MODEL)
        modc = (silu_cc @ w_mod[i] + b_mod[i]).reshape(6, D_MODEL)
        filt_args = (filt_w1[i], filt_b1[i], filt_w2[i], filt_b2[i], filt_w3[i], filt_freq[i])

        h = adaln(x, norm_mix_g[i], mod[:, 0], mod[:, 1])
        p_hy, q, k, v = jnp.split(h @ w_in[i], SPLITS, axis=-1)
        hc = adaln(xc, norm_mix_g[i], modc[0], modc[1])
        if last:
            kc, vc = jnp.split(hc @ w_in[i][:, SPLITS[1]:], 2, axis=-1)
        else:
            pc_hy, qc, kc, vc = jnp.split(hc @ w_in[i], SPLITS, axis=-1)
        kc = kc.reshape(B, C, KV_HEADS, HEAD_DIM)
        vc = vc.reshape(B, C, KV_HEADS, HEAD_DIM)

        q = rope_2d(q.reshape(B, L, ATT_HEADS, HEAD_DIM))
        k = rope_2d(k.reshape(B, L, KV_HEADS, HEAD_DIM))
        v = v.reshape(B, L, KV_HEADS, HEAD_DIM)
        y_at = window_attention(q, k, v, kc, vc, attn_sink[i])
        filt = hyena_filters(L, *filt_args)
        y_hy = hyena_mixer(p_hy, conv_w[i], conv_b[i], filt, filt_bias[i])
        x = x + mod[:, 2] * merge_groups(y_hy, y_at, out_norm_hy[i], out_norm_att[i], w_out[i])

        x = x + mod[:, 5] * swiglu(adaln(x, norm_ffn_g[i], mod[:, 3], mod[:, 4]), w_gate[i], w_up[i], w_down[i])

        if not last:
            filt_c = hyena_filters(C, *filt_args)
            yc_hy = hyena_mixer(pc_hy, conv_w[i], conv_b[i], filt_c, filt_bias[i])
            yc_at = context_attention(qc.reshape(B, C, ATT_HEADS, HEAD_DIM), kc, vc, attn_sink[i])
            xc = xc + modc[2] * merge_groups(yc_hy, yc_at, out_norm_hy[i], out_norm_att[i], w_out[i])
            xc = xc + modc[5] * swiglu(adaln(xc, norm_ffn_g[i], modc[3], modc[4]), w_gate[i], w_up[i], w_down[i])
    return rmsnorm(x, final_g)
```

```cpp
#include <hip/hip_runtime.h>
#include <hip/hip_bf16.h>
#include <cstdint>
#include <cstdio>

namespace {
constexpr int D = 2048, BATCH = 2, SEQ = 4096, DEPTH = 4, CTX = 256;
constexpr int HY = 1024, NH = 8, NKV = 2, HD = 128, ATTW = 1024, KVW = 256;
constexpr int INW = 4608, FF = 5632, FH = 64, FE = 33;
constexpr int ML = BATCH * SEQ;
constexpr int MC = BATCH * CTX;
constexpr int MT = ML + MC;
constexpr float EPS = 1e-6f;
constexpr int WINDOW = 128;

typedef short bf16x8 __attribute__((ext_vector_type(8)));
typedef float f32x4 __attribute__((ext_vector_type(4)));

__device__ __forceinline__ unsigned short f2bf(float f) {
    unsigned u = __builtin_bit_cast(unsigned, f);
    return (unsigned short)((u + 0x7fffu + ((u >> 16) & 1u)) >> 16);
}
__device__ __forceinline__ float silu_f(float v) { return v / (1.f + expf(-v)); }
__device__ __forceinline__ float wave_sum(float v) {
#pragma unroll
    for (int o = 1; o < 64; o <<= 1) v += __shfl_xor(v, o);
    return v;
}
__device__ __forceinline__ float block_sum256(float v, float* red) {
    v = wave_sum(v);
    const int w = threadIdx.x >> 6, l = threadIdx.x & 63;
    __syncthreads();
    if (l == 0) red[w] = v;
    __syncthreads();
    return red[0] + red[1] + red[2] + red[3];
}

__global__ void __launch_bounds__(256) k_gemm(const float* __restrict__ A, int lda, const float* __restrict__ B, int ldb,
                                               float* __restrict__ C, int ldc, int K) {
    __shared__ __attribute__((aligned(16))) unsigned short sA[128][40];
    __shared__ __attribute__((aligned(16))) unsigned short sB[128][40];
    const int tid = threadIdx.x, lane = tid & 63, wid = tid >> 6, wy = wid >> 1, wx = wid & 1;
    const int m0 = blockIdx.y * 128, n0 = blockIdx.x * 128;
    f32x4 acc[4][4];
#pragma unroll
    for (int i = 0; i < 4; ++i)
#pragma unroll
        for (int j = 0; j < 4; ++j) acc[i][j] = (f32x4){0.f, 0.f, 0.f, 0.f};
    for (int k0 = 0; k0 < K; k0 += 32) {
#pragma unroll
        for (int i = 0; i < 4; ++i) {
            const int e = tid + 256 * i, r = e >> 3, c4 = e & 7;
            const f32x4 v = *(const f32x4*)(A + (size_t)(m0 + r) * lda + k0 + c4 * 4);
            sA[r][c4 * 4 + 0] = f2bf(v[0]); sA[r][c4 * 4 + 1] = f2bf(v[1]); sA[r][c4 * 4 + 2] = f2bf(v[2]); sA[r][c4 * 4 + 3] = f2bf(v[3]);
        }
#pragma unroll
        for (int i = 0; i < 4; ++i) {
            const int e = tid + 256 * i, kr = e >> 5, n4 = e & 31;
            const f32x4 v = *(const f32x4*)(B + (size_t)(k0 + kr) * ldb + n0 + n4 * 4);
            sB[n4 * 4 + 0][kr] = f2bf(v[0]); sB[n4 * 4 + 1][kr] = f2bf(v[1]); sB[n4 * 4 + 2][kr] = f2bf(v[2]); sB[n4 * 4 + 3][kr] = f2bf(v[3]);
        }
        __syncthreads();
        bf16x8 a[4], b[4];
#pragma unroll
        for (int i = 0; i < 4; ++i) a[i] = *(const bf16x8*)&sA[wy * 64 + i * 16 + (lane & 15)][8 * (lane >> 4)];
#pragma unroll
        for (int j = 0; j < 4; ++j) b[j] = *(const bf16x8*)&sB[wx * 64 + j * 16 + (lane & 15)][8 * (lane >> 4)];
#pragma unroll
        for (int i = 0; i < 4; ++i)
#pragma unroll
            for (int j = 0; j < 4; ++j) acc[i][j] = __builtin_amdgcn_mfma_f32_16x16x32_bf16(a[i], b[j], acc[i][j], 0, 0, 0);
        __syncthreads();
    }
#pragma unroll
    for (int i = 0; i < 4; ++i)
#pragma unroll
        for (int j = 0; j < 4; ++j)
#pragma unroll
            for (int r = 0; r < 4; ++r) {
                const int row = m0 + wy * 64 + i * 16 + (lane >> 4) * 4 + r, col = n0 + wx * 64 + j * 16 + (lane & 15);
                C[(size_t)row * ldc + col] = acc[i][j][r];
            }
}

__global__ void k_init_x(const float* __restrict__ x, const float* __restrict__ ctx, float* __restrict__ X) {
    const size_t i = (size_t)blockIdx.x * 256 + threadIdx.x;
    const size_t nl = (size_t)ML * D / 4, nt = (size_t)MT * D / 4;
    if (i < nl) ((f32x4*)X)[i] = ((const f32x4*)x)[i];
    else if (i < nt) ((f32x4*)X)[i] = ((const f32x4*)ctx)[i - nl];
}
__global__ void k_silu(const float* __restrict__ c, const float* __restrict__ cc, float* __restrict__ SV) {
    const int i = blockIdx.x * 256 + threadIdx.x;
    if (i < 2 * D) SV[i] = silu_f(c[i]);
    else if (i < 3 * D) SV[i] = silu_f(cc[i - 2 * D]);
}
__global__ void k_mod(const float* __restrict__ SV, const float* __restrict__ w_mod, const float* __restrict__ b_mod, float* __restrict__ MOD) {
    const int n = blockIdx.x * 256 + threadIdx.x, layer = blockIdx.y;
    const float* W = w_mod + (size_t)layer * D * 6 * D;
    float a0 = 0.f, a1 = 0.f, a2 = 0.f;
    for (int k = 0; k < D; ++k) { const float w = W[(size_t)k * 6 * D + n]; a0 += SV[k] * w; a1 += SV[D + k] * w; a2 += SV[2 * D + k] * w; }
    const float b = b_mod[(size_t)layer * 6 * D + n];
    float* o = MOD + (size_t)layer * 3 * 6 * D;
    o[n] = a0 + b; o[6 * D + n] = a1 + b; o[12 * D + n] = a2 + b;
}
__device__ __forceinline__ int row_vec(int row) { return row < ML ? row / SEQ : 2; }
__global__ void k_adaln(const float* __restrict__ X, const float* __restrict__ g, const float* __restrict__ mod  , int shift_idx, int scale_idx, float* __restrict__ H) {
    __shared__ float red[4];
    const int row = blockIdx.x, tid = threadIdx.x;
    const float* xr = X + (size_t)row * D;
    float v[8]; float s = 0.f;
#pragma unroll
    for (int i = 0; i < 8; ++i) { v[i] = xr[tid + 256 * i]; s += v[i] * v[i]; }
    s = block_sum256(s, red);
    const float rstd = 1.f / sqrtf(s / D + EPS);
    const float* mv = mod + (size_t)row_vec(row) * 6 * D;
#pragma unroll
    for (int i = 0; i < 8; ++i) { const int c = tid + 256 * i; H[(size_t)row * D + c] = v[i] * rstd * g[c] * (1.f + mv[scale_idx * D + c]) + mv[shift_idx * D + c]; }
}
__global__ void k_rope(float* __restrict__ T) {
    const int row = blockIdx.x, l = row % SEQ;
    const float prow = (float)(l / 64), pcol = (float)(l % 64);
    float* base = T + (size_t)row * INW + 3 * HY;
    for (int e = threadIdx.x; e < 10 * 64; e += 256) {
        const int head = e / 64, pr = e % 64, axis = pr / 32, p = pr % 32;
        const float inv = powf(10000.f, -(float)p / 32.f);
        const float ang = (axis == 0 ? prow : pcol) * inv;
        const float cs = cosf(ang), sn = sinf(ang);
        float* h = base + head * HD + axis * 64;
        const float a = h[p], b = h[p + 32];
        h[p] = a * cs - b * sn; h[p + 32] = a * sn + b * cs;
    }
}
__global__ void k_filt_hidden(int L, const float* __restrict__ w1, const float* __restrict__ b1, const float* __restrict__ w2, const float* __restrict__ b2,
                              const float* __restrict__ freq, float* __restrict__ HID) {
    __shared__ float emb[FE]; __shared__ float h1[FH];
    const int l = blockIdx.x, k = threadIdx.x;
    if (k < FE) {
        const float t = (float)l / (float)(L - 1);
        const float w = (2.0f * 3.14159265358979323846f / (float)L) * (float)l;
        float v;
        if (k == 0) v = t;
        else { const int bi = (k - 1) % 16; const float band = 1e-4f + (float)bi * ((15.0f - 1e-4f) / 15.0f); v = (k <= 16) ? cosf(band * w) : -sinf(band * w); }
        emb[k] = v;
    }
    __syncthreads();
    float a = b1[k];
    for (int j = 0; j < FE; ++j) a += emb[j] * w1[j * FH + k];
    h1[k] = sinf(freq[k] * a);
    __syncthreads();
    float c = b2[k];
    for (int j = 0; j < FH; ++j) c += h1[j] * w2[j * FH + k];
    HID[(size_t)l * FH + k] = sinf(freq[k] * c);
}
__global__ void k_filt_taps(int L, const float* __restrict__ HID, const float* __restrict__ w3, float* __restrict__ FL) {
    __shared__ float h[FH];
    const int l = blockIdx.y, j = blockIdx.x * 256 + threadIdx.x;
    if (threadIdx.x < FH) h[threadIdx.x] = HID[(size_t)l * FH + threadIdx.x];
    __syncthreads();
    float a = 0.f;
    for (int k = 0; k < FH; ++k) a += h[k] * w3[(size_t)k * 4096 + j];
    const int c = j & 1023;
    const float dmin = logf(1e-2f) / 1.5f, dmax = logf(1e-2f) / 0.3f;
    const float delta = fabsf(dmin + (float)c * ((dmax - dmin) / 1023.f));
    const float t = (float)l / (float)(L - 1);
    FL[(size_t)l * 4096 + j] = a * expf(-t * delta);
}
__global__ void k_short_conv(const float* __restrict__ T, const float* __restrict__ cw, const float* __restrict__ cb, float* __restrict__ U) {
    const int row = blockIdx.y, ch = blockIdx.x * 256 + threadIdx.x;
    int l, L;
    if (row < ML) { l = row % SEQ; L = SEQ; } else { l = (row - ML) % CTX; L = CTX; }
    float a = cb[ch];
    a += T[(size_t)row * INW + ch] * cw[1 * 3 * HY + ch];
    if (l > 0) a += T[(size_t)(row - 1) * INW + ch] * cw[0 * 3 * HY + ch];
    if (l < L - 1) a += T[(size_t)(row + 1) * INW + ch] * cw[2 * 3 * HY + ch];
    U[(size_t)row * 3 * HY + ch] = a;
}
template <int L>
__global__ void __launch_bounds__(256) k_hyena(const float* __restrict__ U, const float* __restrict__ FL  , const float* __restrict__ fbias  ,
                                                float* __restrict__ Z, int row_base) {
    __shared__ float G[2 * L];
    __shared__ float z[L];
    constexpr int NI = L / 256;
    const int c = blockIdx.x, seq = blockIdx.y, tid = threadIdx.x;
    const int row0 = row_base + seq * L;
    for (int t = tid; t < L; t += 256) z[t] = U[(size_t)(row0 + t) * 3 * HY + 2 * HY + c];
    for (int o = 0; o < 2; ++o) {
        __syncthreads();
        for (int d = tid; d < L; d += 256) {
            G[d + L - 1] = FL[(size_t)d * 4096 + (o * 2 + 0) * HY + c];
            if (d > 0) G[L - 1 - d] = FL[(size_t)d * 4096 + (o * 2 + 1) * HY + c];
        }
        __syncthreads();
        float acc[NI];
#pragma unroll
        for (int i = 0; i < NI; ++i) acc[i] = 0.f;
        for (int s = 0; s < L; ++s) {
            const float zs = z[s];
#pragma unroll
            for (int i = 0; i < NI; ++i) acc[i] += zs * G[tid + 256 * i - s + L - 1];
        }
        const float fb = fbias[o * HY + c];
        float zn[NI];
#pragma unroll
        for (int i = 0; i < NI; ++i) { const int t = tid + 256 * i; zn[i] = U[(size_t)(row0 + t) * 3 * HY + o * HY + c] * (acc[i] + fb * z[t]); }
        __syncthreads();
#pragma unroll
        for (int i = 0; i < NI; ++i) z[tid + 256 * i] = zn[i];
    }
    __syncthreads();
    for (int t = tid; t < L; t += 256) Z[(size_t)(row0 + t) * HY + c] = z[t];
}
__global__ void __launch_bounds__(64) k_attn(const float* __restrict__ T, const float* __restrict__ sink, float* __restrict__ O) {
    __shared__ float q[HD]; __shared__ float p[640];
    const int row = blockIdx.x, h = blockIdx.y, kv = h / 4, lane = threadIdx.x;
    const float* qr = T + (size_t)row * INW + 3 * HY + h * HD;
    q[lane] = qr[lane]; q[lane + 64] = qr[lane + 64];
    __syncthreads();
    int b, j0 = 0, nwin = 0;
    if (row < ML) { b = row / SEQ; const int l = row % SEQ; j0 = l - WINDOW < 0 ? 0 : l - WINDOW; const int j1 = l + WINDOW > SEQ - 1 ? SEQ - 1 : l + WINDOW; nwin = j1 - j0 + 1; }
    else b = (row - ML) / CTX;
    const int nk = nwin + CTX;
    const float scale = 0.08838834764831845f;
    float mx = -3.0e38f;
    for (int j = lane; j < nk; j += 64) {
        const int krow = j < nwin ? b * SEQ + j0 + j : ML + b * CTX + (j - nwin);
        const float* kr = T + (size_t)krow * INW + 3 * HY + ATTW + kv * HD;
        float s = 0.f;
        for (int d = 0; d < HD; d += 4) { const f32x4 kk = *(const f32x4*)(kr + d); s += q[d] * kk[0] + q[d + 1] * kk[1] + q[d + 2] * kk[2] + q[d + 3] * kk[3]; }
        s *= scale; p[j] = s; mx = fmaxf(mx, s);
    }
    const float sk = sink[h];
    mx = fmaxf(mx, sk);
#pragma unroll
    for (int o = 1; o < 64; o <<= 1) mx = fmaxf(mx, __shfl_xor(mx, o));
    float sum = 0.f;
    for (int j = lane; j < nk; j += 64) { const float e = expf(p[j] - mx); p[j] = e; sum += e; }
    sum = wave_sum(sum) + expf(sk - mx);
    __syncthreads();
    float o0 = 0.f, o1 = 0.f;
    for (int j = 0; j < nk; ++j) {
        const int krow = j < nwin ? b * SEQ + j0 + j : ML + b * CTX + (j - nwin);
        const float* vr = T + (size_t)krow * INW + 3 * HY + ATTW + KVW + kv * HD;
        const float pj = p[j];
        o0 += pj * vr[lane]; o1 += pj * vr[lane + 64];
    }
    const float inv = 1.f / sum;
    O[(size_t)row * ATTW + h * HD + lane] = o0 * inv; O[(size_t)row * ATTW + h * HD + lane + 64] = o1 * inv;
}
__global__ void k_merge_norm(const float* __restrict__ Z, const float* __restrict__ O, const float* __restrict__ ghy, const float* __restrict__ gat, float* __restrict__ Y) {
    __shared__ float red[4];
    const int row = blockIdx.x, tid = threadIdx.x;
    float a[4], b[4]; float sa = 0.f, sb = 0.f;
#pragma unroll
    for (int i = 0; i < 4; ++i) { a[i] = Z[(size_t)row * HY + tid + 256 * i]; b[i] = O[(size_t)row * ATTW + tid + 256 * i]; sa += a[i] * a[i]; sb += b[i] * b[i]; }
    sa = block_sum256(sa, red); sb = block_sum256(sb, red);
    const float ra = 1.f / sqrtf(sa / HY + EPS), rb = 1.f / sqrtf(sb / ATTW + EPS);
#pragma unroll
    for (int i = 0; i < 4; ++i) { const int c = tid + 256 * i; Y[(size_t)row * D + c] = a[i] * ra * ghy[c]; Y[(size_t)row * D + HY + c] = b[i] * rb * gat[c]; }
}
__global__ void k_resid(float* __restrict__ X, const float* __restrict__ R, const float* __restrict__ mod, int gate_idx) {
    const int row = blockIdx.y, c = blockIdx.x * 256 + threadIdx.x;
    X[(size_t)row * D + c] += mod[(size_t)row_vec(row) * 6 * D + gate_idx * D + c] * R[(size_t)row * D + c];
}
__global__ void k_swiglu(float* __restrict__ G, const float* __restrict__ Uu, size_t n4) {
    const size_t i = (size_t)blockIdx.x * 256 + threadIdx.x;
    if (i < n4) { f32x4 g = ((f32x4*)G)[i]; const f32x4 u = ((const f32x4*)Uu)[i];
        g[0] = silu_f(g[0]) * u[0]; g[1] = silu_f(g[1]) * u[1]; g[2] = silu_f(g[2]) * u[2]; g[3] = silu_f(g[3]) * u[3]; ((f32x4*)G)[i] = g; }
}
__global__ void k_final(const float* __restrict__ X, const float* __restrict__ g, float* __restrict__ out) {
    __shared__ float red[4];
    const int row = blockIdx.x, tid = threadIdx.x;
    float v[8]; float s = 0.f;
#pragma unroll
    for (int i = 0; i < 8; ++i) { v[i] = X[(size_t)row * D + tid + 256 * i]; s += v[i] * v[i]; }
    s = block_sum256(s, red);
    const float rstd = 1.f / sqrtf(s / D + EPS);
#pragma unroll
    for (int i = 0; i < 8; ++i) { const int c = tid + 256 * i; out[(size_t)row * D + c] = v[i] * rstd * g[c]; }
}
}

extern "C" void kernel_launch(void* const* d_in, const int* in_sizes, int n_in, void* d_out, int out_size, void* d_ws, size_t ws_size, hipStream_t stream) {
    const float* x = (const float*)d_in[0]; const float* c = (const float*)d_in[1]; const float* ctx = (const float*)d_in[2]; const float* c_ctx = (const float*)d_in[3];
    const float* norm_mix_g = (const float*)d_in[4]; const float* norm_ffn_g = (const float*)d_in[5]; const float* w_mod = (const float*)d_in[6]; const float* b_mod = (const float*)d_in[7];
    const float* w_in = (const float*)d_in[8]; const float* conv_w = (const float*)d_in[9]; const float* conv_b = (const float*)d_in[10];
    const float* filt_w1 = (const float*)d_in[11]; const float* filt_b1 = (const float*)d_in[12]; const float* filt_w2 = (const float*)d_in[13]; const float* filt_b2 = (const float*)d_in[14];
    const float* filt_w3 = (const float*)d_in[15]; const float* filt_freq = (const float*)d_in[16]; const float* filt_bias = (const float*)d_in[17]; const float* attn_sink = (const float*)d_in[18];
    const float* out_norm_hy = (const float*)d_in[19]; const float* out_norm_att = (const float*)d_in[20]; const float* w_out = (const float*)d_in[21];
    const float* w_gate = (const float*)d_in[22]; const float* w_up = (const float*)d_in[23]; const float* w_down = (const float*)d_in[24]; const float* final_g = (const float*)d_in[25];
    float* out = (float*)d_out;

    float* ws = (float*)d_ws; size_t off = 0;
    auto take = [&](size_t n) { float* p = ws + off; off += (n + 63) & ~(size_t)63; return p; };
    float* X = take((size_t)MT * D);
    float* SV = take(3 * D);
    float* MOD = take((size_t)DEPTH * 3 * 6 * D);
    float* H = take((size_t)MT * D);
    float* T = take((size_t)MT * INW);
    float* U = take((size_t)MT * 3 * HY);
    float* Z = take((size_t)MT * HY);
    float* O = take((size_t)MT * ATTW);
    float* Y = take((size_t)MT * D);
    float* R = take((size_t)MT * D);
    float* Gb = take((size_t)MT * FF);
    float* Ub = take((size_t)MT * FF);
    float* HIDL = take((size_t)SEQ * FH);
    float* HIDC = take((size_t)CTX * FH);
    float* FLL = take((size_t)SEQ * 4096);
    float* FLC = take((size_t)CTX * 4096);
    if (off * 4 > ws_size) { fprintf(stderr, "workspace too small: need %zu have %zu\n", off * 4, ws_size); return; }

    k_init_x<<<(unsigned)(((size_t)MT * D / 4 + 255) / 256), 256, 0, stream>>>(x, ctx, X);
    k_silu<<<3 * D / 256, 256, 0, stream>>>(c, c_ctx, SV);
    k_mod<<<dim3(6 * D / 256, DEPTH), 256, 0, stream>>>(SV, w_mod, b_mod, MOD);

    for (int i = 0; i < DEPTH; ++i) {
        const float* mod = MOD + (size_t)i * 3 * 6 * D;
        k_adaln<<<MT, 256, 0, stream>>>(X, norm_mix_g + (size_t)i * D, mod, 0, 1, H);
        k_gemm<<<dim3(INW / 128, MT / 128), 256, 0, stream>>>(H, D, w_in + (size_t)i * D * INW, INW, T, INW, D);
        k_rope<<<ML, 256, 0, stream>>>(T);
        k_attn<<<dim3(MT, NH), 64, 0, stream>>>(T, attn_sink + (size_t)i * NH, O);
        k_filt_hidden<<<SEQ, 64, 0, stream>>>(SEQ, filt_w1 + (size_t)i * FE * FH, filt_b1 + (size_t)i * FH, filt_w2 + (size_t)i * FH * FH, filt_b2 + (size_t)i * FH, filt_freq + (size_t)i * FH, HIDL);
        k_filt_hidden<<<CTX, 64, 0, stream>>>(CTX, filt_w1 + (size_t)i * FE * FH, filt_b1 + (size_t)i * FH, filt_w2 + (size_t)i * FH * FH, filt_b2 + (size_t)i * FH, filt_freq + (size_t)i * FH, HIDC);
        k_filt_taps<<<dim3(16, SEQ), 256, 0, stream>>>(SEQ, HIDL, filt_w3 + (size_t)i * FH * 4096, FLL);
        k_filt_taps<<<dim3(16, CTX), 256, 0, stream>>>(CTX, HIDC, filt_w3 + (size_t)i * FH * 4096, FLC);
        k_short_conv<<<dim3(3 * HY / 256, MT), 256, 0, stream>>>(T, conv_w + (size_t)i * 3 * 3 * HY, conv_b + (size_t)i * 3 * HY, U);
        k_hyena<SEQ><<<dim3(HY, BATCH), 256, 0, stream>>>(U, FLL, filt_bias + (size_t)i * 2 * HY, Z, 0);
        k_hyena<CTX><<<dim3(HY, BATCH), 256, 0, stream>>>(U, FLC, filt_bias + (size_t)i * 2 * HY, Z, ML);
        k_merge_norm<<<MT, 256, 0, stream>>>(Z, O, out_norm_hy + (size_t)i * HY, out_norm_att + (size_t)i * ATTW, Y);
        k_gemm<<<dim3(D / 128, MT / 128), 256, 0, stream>>>(Y, D, w_out + (size_t)i * D * D, D, R, D, D);
        k_resid<<<dim3(D / 256, MT), 256, 0, stream>>>(X, R, mod, 2);
        k_adaln<<<MT, 256, 0, stream>>>(X, norm_ffn_g + (size_t)i * D, mod, 3, 4, H);
        k_gemm<<<dim3(FF / 128, MT / 128), 256, 0, stream>>>(H, D, w_gate + (size_t)i * D * FF, FF, Gb, FF, D);
        k_gemm<<<dim3(FF / 128, MT / 128), 256, 0, stream>>>(H, D, w_up + (size_t)i * D * FF, FF, Ub, FF, D);
        k_swiglu<<<(unsigned)(((size_t)MT * FF / 4 + 255) / 256), 256, 0, stream>>>(Gb, Ub, (size_t)MT * FF / 4);
        k_gemm<<<dim3(D / 128, MT / 128), 256, 0, stream>>>(Gb, FF, w_down + (size_t)i * FF * D, D, R, D, FF);
        k_resid<<<dim3(D / 256, MT), 256, 0, stream>>>(X, R, mod, 5);
    }
    k_final<<<ML, 256, 0, stream>>>(X, final_g, out);
}
```

```cpp
#include <hip/hip_runtime.h>
#include <cstdint>
#include <cstdio>
#define LAS __attribute__((address_space(3)))
#define GAS __attribute__((address_space(1)))
#define MK_LANE_ASM(l) asm volatile("v_mbcnt_lo_u32_b32 %0, -1, 0\n\tv_mbcnt_hi_u32_b32 %0, -1, %0" : "=v"(l))
namespace pg8 {
#define PG8_LAS __attribute__((address_space(3)))
typedef unsigned short bf16_t;
typedef short bf16x8 __attribute__((ext_vector_type(8)));
typedef float f32x4 __attribute__((ext_vector_type(4)));
typedef unsigned u32x4 __attribute__((ext_vector_type(4)));
constexpr int BM = 256, BK = 64, HALF = 128, HTB = HALF * BK * 2  , STAGE_BYTES = 8 * HTB, NXCD = 8, WGM = 8;

__host__ __device__ __forceinline__ int lds_byte(int r, int c) { const int st = (r >> 4) * 2 + (c >> 5), rr = r & 15, cc = c & 31, ob = rr * 64 + cc * 2; return st * 1024 + (ob ^ (((ob >> 9) & 1) << 5)); }
__host__ __device__ __forceinline__ void stage_rc(int b, int& R, int& C) { const int st = b / 1024, sb = b % 1024, swz = sb ^ (((sb >> 9) & 1) << 5); R = (st >> 1) * 16 + swz / 64; C = (st & 1) * 32 + (swz % 64) / 2; }
__host__ __device__ __forceinline__ int perm32(int rho) { const int n = rho >> 4, i = rho & 15; return 8 * (i >> 2) + 4 * n + (i & 3); }

struct Unit { int pm, pn; };
struct Gemm { const bf16_t* A; const bf16_t* Bt; int M, N, K, lda, ldb; };

struct StaticOrder {
    int nM, nN, nwg, G, c;
    __host__ __device__ void init(int M, int N, int G_, int c_) { nM = M / BM; nN = N / BM; nwg = nM * nN; G = G_; c = c_; }
    __host__ __device__ bool next(int i, Unit& u) const {
        const long L = (long)i * G + c; if (L >= nwg) return false;
        int wgid = (int)L; { const int q = nwg / NXCD, r = nwg % NXCD, xcd = wgid % NXCD, off = wgid / NXCD; wgid = (xcd < r ? xcd * (q + 1) : r * (q + 1) + (xcd - r) * q) + off; }
        const int nig = WGM * nN, gid = wgid / nig, fm = gid * WGM, gsz = (nM - fm) < WGM ? (nM - fm) : WGM;
        u.pm = fm + ((wgid % nig) % gsz); u.pn = (wgid % nig) / gsz; return true;
    }
    __device__ __forceinline__ void a_ready(const Unit&) const {}
    __device__ __forceinline__ void done(const Unit&) const {}
};

template <class Epi, class Sched, bool ALIGN_EPI = false, bool SP2 = false>
__device__ __forceinline__ void gemm_phase(PG8_LAS unsigned char* lds, const Gemm g, const Sched& S, const Epi& E, const int wave_s) {
    int lane_; MK_LANE_ASM(lane_); int wv_ = wave_s; asm volatile("" : "+s"(wv_)); const int wid = wv_, lane = lane_, tid = wid * 64 + lane, wr = wid >> 2, wc = wid & 3, fr = lane & 15, fq = lane >> 4;
    const int K = g.K, nt = K / BK;
    unsigned voffA[2], voffB[2];
#pragma unroll
    for (int i = 0; i < 2; ++i) { int R, C; stage_rc(tid * 16 + i * 8192, R, C); const int Rb = Epi::PERM ? ((R & ~31) + perm32(R & 31)) : R;
        voffA[i] = (unsigned)(R * g.lda + C) * 2u; voffB[i] = (unsigned)(Rb * g.ldb + C) * 2u; }
    const size_t kstep = (size_t)(BK * 2);
    const size_t hstepA = (size_t)HALF * g.lda * 2, hstepB = (size_t)HALF * g.ldb * 2;
    const size_t tstepA = 2 * hstepA, tstepB = 2 * hstepB;
    const unsigned ldsw = (unsigned)wid * 1024u;
    const int aoff = lds_byte(wr * 64 + fr, fq * 8), boff = lds_byte(wc * 32 + fr, fq * 8);
#define PG8_SA(b, h) (((b) * 2 + (h)) * HTB)
#define PG8_SB(b, h) ((4 + (b) * 2 + (h)) * HTB)
#define PG8_STAGE(bufoff, gbase, voff) do { _Pragma("unroll") for (int _i = 0; _i < 2; ++_i) \
        __builtin_amdgcn_global_load_lds((const unsigned*)((const char*)(gbase) + (voff)[_i]), (PG8_LAS unsigned*)(lds + (bufoff) + ldsw + _i * 8192), 16, 0, 0); } while (0)
#define PG8_LDA(dst, b, h) do { _Pragma("unroll") for (int m = 0; m < 4; ++m) _Pragma("unroll") for (int k = 0; k < 2; ++k) dst[m][k] = *(const PG8_LAS bf16x8*)(lds + PG8_SA(b, h) + aoff + m * 2048 + k * 1024); } while (0)
#define PG8_LDB(dst, b, h) do { _Pragma("unroll") for (int n = 0; n < 2; ++n) _Pragma("unroll") for (int k = 0; k < 2; ++k) dst[n][k] = *(const PG8_LAS bf16x8*)(lds + PG8_SB(b, h) + boff + n * 2048 + k * 1024); } while (0)
#define PG8_MMA(ai, bj, At, Bt) do { __builtin_amdgcn_s_setprio(1); _Pragma("unroll") for (int m = 0; m < 4; ++m) _Pragma("unroll") for (int n = 0; n < 2; ++n) _Pragma("unroll") for (int k = 0; k < 2; ++k) \
        acc[ai][bj][m][n] = __builtin_amdgcn_mfma_f32_16x16x32_bf16(Bt[n][k], At[m][k], acc[ai][bj][m][n], 0, 0, 0); __builtin_amdgcn_s_setprio(0); } while (0)
#define PG8_WAIT_V(n) asm volatile("s_waitcnt vmcnt(" #n ")" ::: "memory")
#define PG8_WAIT_L(n) asm volatile("s_waitcnt lgkmcnt(" #n ")" ::: "memory")
#define PG8_BAR __builtin_amdgcn_s_barrier()
#define PG8_SCHED __builtin_amdgcn_sched_barrier(0)
    Unit cur, nxt; int ui = 0;
    (void)S.next(0, cur);
    f32x4 acc[2][2][4][2];
#pragma unroll
    for (int a = 0; a < 2; ++a)
#pragma unroll
        for (int b = 0; b < 2; ++b)
#pragma unroll
            for (int m = 0; m < 4; ++m)
#pragma unroll
                for (int n = 0; n < 2; ++n) acc[a][b][m][n] = (f32x4){0.f, 0.f, 0.f, 0.f};
    bf16x8 At[4][2], B0[2][2], B1[2][2];
    const char* cA = (const char*)g.A + (size_t)cur.pm * tstepA; const char* cB = (const char*)g.Bt + (size_t)cur.pn * tstepB;
    S.a_ready(cur);
    if constexpr (SP2) {
        PG8_STAGE(PG8_SB(0, 0), cB, voffB); PG8_STAGE(PG8_SB(0, 1), cB + hstepB, voffB); PG8_STAGE(PG8_SA(0, 0), cA, voffA); PG8_STAGE(PG8_SA(0, 1), cA + hstepA, voffA);
        if (wr == 1) PG8_BAR;
        PG8_WAIT_V(2); PG8_BAR;
        PG8_STAGE(PG8_SB(1, 0), cB + kstep, voffB); PG8_STAGE(PG8_SA(1, 0), cA + kstep, voffA); PG8_STAGE(PG8_SB(1, 1), cB + hstepB + kstep, voffB);
        PG8_WAIT_V(6); PG8_BAR;
    } else {
        PG8_STAGE(PG8_SB(0, 0), cB, voffB); PG8_STAGE(PG8_SA(0, 0), cA, voffA); PG8_STAGE(PG8_SB(0, 1), cB + hstepB, voffB); PG8_STAGE(PG8_SA(0, 1), cA + hstepA, voffA);
        if (wr == 1) PG8_BAR;
        PG8_WAIT_V(4); PG8_BAR;
        PG8_STAGE(PG8_SB(1, 0), cB + kstep, voffB); PG8_STAGE(PG8_SA(1, 0), cA + kstep, voffA); PG8_STAGE(PG8_SB(1, 1), cB + hstepB + kstep, voffB);
        PG8_WAIT_V(6); PG8_BAR;
    }
    for (;;) {
        const bool has_next = S.next(ui + 1, nxt);
        const char* nA = has_next ? (const char*)g.A + (size_t)nxt.pm * tstepA : cA; const char* nB = has_next ? (const char*)g.Bt + (size_t)nxt.pn * tstepB : cB;
        for (int t = 0; t < nt; t += 2) {
            const bool last = (t == nt - 2);
            const char* a1 = cA + (size_t)(t + 1) * kstep;
            const char* a2 = last ? nA : cA + (size_t)(t + 2) * kstep; const char* b2 = last ? nB : cB + (size_t)(t + 2) * kstep;
            const char* a3 = a2 + kstep; const char* b3 = b2 + kstep;
            if (last && has_next) S.a_ready(nxt);
            if constexpr (SP2) {
            PG8_LDB(B0, 0, 0); PG8_LDB(B1, 0, 1); PG8_SCHED; PG8_LDA(At, 0, 0); PG8_STAGE(PG8_SA(1, 1), a1 + hstepA, voffA);
            PG8_WAIT_V(8); PG8_WAIT_L(0); PG8_BAR; PG8_MMA(0, 0, At, B0); PG8_MMA(0, 1, At, B1); PG8_BAR; PG8_SCHED;
            PG8_LDA(At, 0, 1); PG8_STAGE(PG8_SB(0, 0), b2, voffB); PG8_STAGE(PG8_SB(0, 1), b2 + hstepB, voffB); PG8_STAGE(PG8_SA(0, 0), a2, voffA);
            PG8_WAIT_V(8); PG8_WAIT_L(0); PG8_BAR; PG8_MMA(1, 0, At, B0); PG8_MMA(1, 1, At, B1); PG8_BAR; PG8_SCHED;
            PG8_LDB(B0, 1, 0); PG8_LDB(B1, 1, 1); PG8_SCHED; PG8_LDA(At, 1, 0); PG8_STAGE(PG8_SA(0, 1), a2 + hstepA, voffA);
            PG8_WAIT_V(8); PG8_WAIT_L(0); PG8_BAR; PG8_MMA(0, 0, At, B0); PG8_MMA(0, 1, At, B1); PG8_BAR; PG8_SCHED;
            PG8_LDA(At, 1, 1); PG8_STAGE(PG8_SB(1, 0), b3, voffB); PG8_STAGE(PG8_SB(1, 1), b3 + hstepB, voffB); PG8_STAGE(PG8_SA(1, 0), a3, voffA);
            PG8_WAIT_V(8); PG8_WAIT_L(0); PG8_BAR; PG8_MMA(1, 0, At, B0); PG8_MMA(1, 1, At, B1); PG8_BAR; PG8_SCHED;
            } else {
            PG8_LDB(B0, 0, 0); PG8_SCHED; PG8_LDA(At, 0, 0); PG8_STAGE(PG8_SA(1, 1), a1 + hstepA, voffA);
            PG8_WAIT_L(8); PG8_BAR; PG8_WAIT_L(0); PG8_MMA(0, 0, At, B0); PG8_BAR; PG8_SCHED;
            PG8_LDB(B1, 0, 1); PG8_STAGE(PG8_SB(0, 0), b2, voffB);
            PG8_BAR; PG8_WAIT_L(0); PG8_MMA(0, 1, At, B1); PG8_BAR;
            PG8_LDA(At, 0, 1); PG8_STAGE(PG8_SA(0, 0), a2, voffA);
            PG8_BAR; PG8_WAIT_L(0); PG8_MMA(1, 0, At, B0); PG8_BAR; PG8_SCHED;
            PG8_STAGE(PG8_SB(0, 1), b2 + hstepB, voffB);
            PG8_WAIT_V(6); PG8_BAR; PG8_MMA(1, 1, At, B1); PG8_BAR;
            PG8_LDB(B0, 1, 0); PG8_SCHED; PG8_LDA(At, 1, 0); PG8_STAGE(PG8_SA(0, 1), a2 + hstepA, voffA);
            PG8_WAIT_L(8); PG8_BAR; PG8_WAIT_L(0); PG8_MMA(0, 0, At, B0); PG8_BAR; PG8_SCHED;
            PG8_LDB(B1, 1, 1); PG8_STAGE(PG8_SB(1, 0), b3, voffB);
            PG8_BAR; PG8_WAIT_L(0); PG8_MMA(0, 1, At, B1); PG8_BAR;
            PG8_LDA(At, 1, 1); PG8_STAGE(PG8_SA(1, 0), a3, voffA);
            PG8_BAR; PG8_WAIT_L(0); PG8_MMA(1, 0, At, B0); PG8_BAR; PG8_SCHED;
            PG8_STAGE(PG8_SB(1, 1), b3 + hstepB, voffB);
            PG8_WAIT_V(6); PG8_BAR; PG8_MMA(1, 1, At, B1); PG8_BAR;
            }
        }
        if constexpr (ALIGN_EPI) { if (wr == 0) PG8_BAR; }
        if constexpr (!Epi::AFTER_DRAIN) { E(acc, cur, wr, wc, fr, fq); S.done(cur); }
        if (!has_next) break;
#pragma unroll
        for (int a = 0; a < 2; ++a)
#pragma unroll
            for (int b = 0; b < 2; ++b)
#pragma unroll
                for (int m = 0; m < 4; ++m)
#pragma unroll
                    for (int n = 0; n < 2; ++n) acc[a][b][m][n] = (f32x4){0.f, 0.f, 0.f, 0.f};
        cur = nxt; cA = nA; cB = nB; ++ui;
        if constexpr (ALIGN_EPI) { if (wr == 1) PG8_BAR; }
    }
    PG8_WAIT_V(0);
    if constexpr (!ALIGN_EPI) { if (wr == 0) PG8_BAR; }
    PG8_BAR;
    if constexpr (Epi::AFTER_DRAIN) { E.fused(acc, cur, wr, wc, fr, fq, lds, wid, lane); S.done(cur); }
#undef PG8_SA
#undef PG8_SB
#undef PG8_STAGE
#undef PG8_LDA
#undef PG8_LDB
#undef PG8_MMA
#undef PG8_WAIT_V
#undef PG8_WAIT_L
#undef PG8_BAR
#undef PG8_SCHED
}
}

#define XB_TMO      128
#define XB_XCNT(j)  (256  + 64 * (j))
#define XB_XSUB(j)  (1280 + 64 * (j))
#define XB_XGEN(j)  (2304 + 64 * (j))
#define XB_TOP      3328
#define XB_TOPGEN   3392
#define XCD_BAR_WORDS 3456
#define XB_SPIN_CAP (1u << 18)

__device__ __forceinline__ unsigned xb_ld(unsigned* p)              { return __hip_atomic_load(p, __ATOMIC_RELAXED, __HIP_MEMORY_SCOPE_AGENT); }
__device__ __forceinline__ unsigned xb_add(unsigned* p, unsigned v) { return __hip_atomic_fetch_add(p, v, __ATOMIC_RELAXED, __HIP_MEMORY_SCOPE_AGENT); }
__device__ __forceinline__ unsigned xb_xcc_id() { return (unsigned)__builtin_amdgcn_s_getreg((3 << 11) | 20) & 0xFu; }
#define XB_SPIN(cond, bar) do { unsigned _sp = 0; while (cond) { __builtin_amdgcn_s_sleep(1); \
    if ((++_sp & 255u) == 0u) { if (xb_ld(&(bar)[XB_TMO])) break; if (_sp > XB_SPIN_CAP) { atomicAdd(&(bar)[XB_TMO], 1u); break; } } } } while (0)

struct XcdBarrier {
    unsigned* bar; unsigned x;
    volatile LAS unsigned* st;
};

__device__ __forceinline__ XcdBarrier xcd_barrier_post(unsigned* bar, volatile LAS unsigned* st) {
    XcdBarrier b; b.bar = bar; b.x = xb_xcc_id(); b.st = st;
    if (threadIdx.x == 0) (void)xb_add(&bar[XB_XCNT(b.x)], 1u);
    return b;
}
__device__ __forceinline__ void xcd_barrier_complete(unsigned* bar, unsigned x, unsigned& nloc, unsigned& nx) {
    const unsigned G = gridDim.x * gridDim.y * gridDim.z;
    unsigned sum, cnt, mine, sp = 0u;
    for (;;) {
        sum = 0u; cnt = 0u; mine = 0u;
#pragma unroll
        for (unsigned j = 0; j < 16; ++j) { const unsigned c = xb_ld(&bar[XB_XCNT(j)]); sum += c; cnt += (c > 0u) ? 1u : 0u; mine = (j == x) ? c : mine; }
        if (sum == G) break;
        __builtin_amdgcn_s_sleep(1);
        if ((++sp & 255u) == 0u) { if (xb_ld(&bar[XB_TMO])) break; if (sp > XB_SPIN_CAP) { atomicAdd(&bar[XB_TMO], 1u); break; } }
    }
    nloc = mine > 0u ? mine : 1u; nx = cnt > 0u ? cnt : 1u;
}

__device__ __forceinline__ void xcd_barrier(const XcdBarrier& b, const int wave_s) {
    int xb_lane_; MK_LANE_ASM(xb_lane_); const bool xb_t0 = (wave_s == 0) && (xb_lane_ == 0);
    asm volatile("s_waitcnt vmcnt(0)" ::: "memory");
    __syncthreads();
    if (xb_t0) {
        unsigned* bar = b.bar;
        __builtin_amdgcn_s_waitcnt(0);
        unsigned nloc = b.st[0], nx = b.st[1];
        if (nloc == 0u) { xcd_barrier_complete(bar, b.x, nloc, nx); b.st[0] = nloc; b.st[1] = nx; }
        const unsigned old = xb_add(&bar[XB_XSUB(b.x)], 1u);
        const unsigned gen = old / nloc;
        if (old + 1u == (gen + 1u) * nloc) {
            __builtin_amdgcn_fence(__ATOMIC_RELEASE, "agent");
            asm volatile("s_waitcnt vmcnt(0)" ::: "memory");
            const unsigned og = xb_add(&bar[XB_TOP], 1u);
            const unsigned tg = og / nx;
            if (og + 1u == (tg + 1u) * nx) xb_add(&bar[XB_TOPGEN], 1u);
            else XB_SPIN(xb_ld(&bar[XB_TOPGEN]) == tg, bar);
            __builtin_amdgcn_fence(__ATOMIC_ACQUIRE, "agent");
            xb_add(&bar[XB_XGEN(b.x)], 1u);
            asm volatile("s_waitcnt vmcnt(0)" ::: "memory");
        } else {
            XB_SPIN(xb_ld(&bar[XB_XGEN(b.x)]) == gen, bar);
            __builtin_amdgcn_fence(__ATOMIC_ACQUIRE, "agent");
            asm volatile("s_waitcnt vmcnt(0)" ::: "memory");
        }
    }
    __syncthreads();
}


namespace mk {
using pg8::bf16_t; using pg8::f32x4; using pg8::Unit; using pg8::BM; using pg8::HALF;
typedef unsigned u32x4 __attribute__((ext_vector_type(4)));
typedef unsigned u32x2 __attribute__((ext_vector_type(2)));
typedef float f32x2 __attribute__((ext_vector_type(2)));

constexpr int D = 2048, BATCH = 2, SEQ = 4096, DEPTH = 4, CTX = 256;
constexpr int HY = 1024, NH = 8, NKV = 2, HD = 128, ATTW = 1024, KVW = 256;
constexpr int INW = 4608, FF = 5632, GU = 2 * FF, FH = 64, FE = 33;
constexpr int ML = BATCH * SEQ, MC = BATCH * CTX, MT = ML + MC;
constexpr float EPS = 1e-6f;
constexpr float LOG2E = 1.4426950408889634f;
constexpr float QSCALE = 0.08838834764831845f * LOG2E;
constexpr int WINDOW = 128;
constexpr int NWAVES = 8, NTHR = 512;
constexpr int MOD_KC = 8;

constexpr size_t al(size_t x) { return (x + 255) & ~(size_t)255; }
constexpr size_t WS_CTL = 0, CTL_BYTES = 1u << 20;
constexpr size_t WS_X = CTL_BYTES;
constexpr size_t WS_AN = WS_X + al((size_t)MT * D * 4);
constexpr size_t WS_SSQ = WS_AN + al((size_t)MT * D * 2);
constexpr size_t WS_PHY = WS_SSQ + al((size_t)MT * 32 * 4);
constexpr size_t WS_Q = WS_PHY + al((size_t)3 * HY * MT * 2);
constexpr size_t WS_K = WS_Q + al((size_t)MT * ATTW * 2);
constexpr size_t WS_V = WS_K + al((size_t)MT * KVW * 2);
constexpr size_t WS_YM = WS_V + al((size_t)MT * KVW * 2);
constexpr size_t WS_SSHY = WS_YM + al((size_t)MT * D * 2);
constexpr size_t WS_HB = WS_SSHY + al((size_t)HY * MT * 4);
constexpr size_t WS_MODP = WS_HB + al((size_t)MT * FF * 2);
constexpr size_t WS_MOD = WS_MODP + al((size_t)MOD_KC * DEPTH * 3 * 6 * D * 4);
constexpr size_t WS_GMV = WS_MOD + al((size_t)DEPTH * 3 * 6 * D * 4);
constexpr size_t WS_SHWIN = WS_GMV + al((size_t)DEPTH * 2 * 3 * D * 4);
constexpr size_t WS_SHWGU = WS_SHWIN + al((size_t)DEPTH * 3 * INW * 4);
constexpr size_t WS_HIDL = WS_SHWGU + al((size_t)DEPTH * 3 * GU * 4);
constexpr size_t WS_HIDC = WS_HIDL + al((size_t)DEPTH * SEQ * FH * 4);
constexpr size_t WS_ROPE = WS_HIDC + al((size_t)DEPTH * CTX * FH * 4);
constexpr size_t WS_FLT = WS_ROPE + al((size_t)64 * 32 * 2 * 4);
constexpr size_t WS_FLTC = WS_FLT + al((size_t)DEPTH * 4 * HY * SEQ * 4);
constexpr size_t WS_WIN = WS_FLTC + al((size_t)DEPTH * 4 * HY * CTX * 4);
constexpr size_t WS_WOUT = WS_WIN + al((size_t)DEPTH * INW * D * 2);
constexpr size_t WS_WGU = WS_WOUT + al((size_t)DEPTH * D * D * 2);
constexpr size_t WS_WD = WS_WGU + al((size_t)DEPTH * GU * D * 2);
constexpr size_t WS_END = WS_WD + al((size_t)DEPTH * D * FF * 2);
constexpr int CW_BAR = 4096;

constexpr int RING_BYTES = 131072, MISC_OFF = RING_BYTES + 320, LDS_BYTES = 147456;

__device__ __forceinline__ unsigned f2bf(float f) { unsigned u = __builtin_bit_cast(unsigned, f); return (u + 0x7fffu + ((u >> 16) & 1u)) >> 16; }
__device__ __forceinline__ unsigned pk2(float lo, float hi) { return f2bf(lo) | (f2bf(hi) << 16); }
__device__ __forceinline__ float bf_lo(unsigned w) { return __builtin_bit_cast(float, w << 16); }
__device__ __forceinline__ float bf_hi(unsigned w) { return __builtin_bit_cast(float, w & 0xffff0000u); }
__device__ __forceinline__ float bf1(bf16_t b) { return __builtin_bit_cast(float, (unsigned)b << 16); }
__device__ __forceinline__ float wave_sum(float v) {
#pragma unroll
    for (int o = 1; o < 64; o <<= 1) v += __shfl_xor(v, o);
    return v;
}
__device__ __forceinline__ float wave_max(float v) {
#pragma unroll
    for (int o = 1; o < 64; o <<= 1) v = fmaxf(v, __shfl_xor(v, o));
    return v;
}
__device__ __forceinline__ int vec_of_panel(int pm) { return pm < 16 ? 0 : (pm < 32 ? 1 : 2); }
__device__ __forceinline__ int vec_of_row(int row) { return row < SEQ ? 0 : (row < ML ? 1 : 2); }
__host__ __device__ __forceinline__ int qk_dim(int j) { const int wc = j >> 5, fq = (j >> 3) & 3, n = (j >> 2) & 1, e = j & 3, idx = wc * 16 + fq * 4 + e; return (idx < 32 ? idx : idx + 32) + 32 * n; }

#define FRESH_IDS int lane_; MK_LANE_ASM(lane_); int wv_ = wave_s; asm volatile("" : "+s"(wv_)); const int lane = lane_, wave = wv_, tid = wv_ * 64 + lane_; (void)lane; (void)wave; (void)tid
struct Params {
    const float* in[26];
    float* out;
    unsigned char* ws;
    int ph_lo, ph_hi;
};
typedef __attribute__((address_space(4))) const Params* KP;
#define FRESH_KP KP Pp; { unsigned long long ki_ = (unsigned long long)__builtin_amdgcn_kernarg_segment_ptr(); asm volatile("" : "+s"(ki_)); Pp = (KP)ki_; }

__device__ __forceinline__ void load_rstd8(const float* ssq, int row0, int fq, float (&rs)[2][4]) {
#pragma unroll
    for (int ai = 0; ai < 2; ++ai)
#pragma unroll
        for (int m = 0; m < 4; ++m) {
            const int row = row0 + ai * HALF + m * 16;
            const f32x4 a = *(const f32x4*)(ssq + ((size_t)(2 * fq) * MT + row) * 4), b = *(const f32x4*)(ssq + ((size_t)(2 * fq + 1) * MT + row) * 4);
            float s = ((a[0] + a[1]) + (a[2] + a[3])) + ((b[0] + b[1]) + (b[2] + b[3]));
            s += __shfl_xor(s, 16); s += __shfl_xor(s, 32);
            rs[ai][m] = 1.0f / sqrtf(s * (1.0f / D) + EPS);
        }
}

struct EpiIn {
    static constexpr bool PERM = true, AFTER_DRAIN = false;
    const float* ssq; const float* shw;
    bf16_t* PHY; bf16_t* Q; bf16_t* Kb; bf16_t* Vb; const float* rope;
    __device__ __forceinline__ void operator()(const f32x4 (&acc)[2][2][4][2], const Unit& u, int wr, int wc, int fr_, int fq_) const {
        int fr = fr_, fq = fq_; asm volatile("" : "+v"(fr), "+v"(fq));
        const int row0 = u.pm * BM + wr * 64 + fr, v = vec_of_panel(u.pm);
        float rs[2][4]; load_rstd8(ssq, row0, fq, rs);
        const int cpos = wc * 32 + 8 * fq;
        const int colb = u.pn * BM + cpos;
        f32x4 sh[2][2];
#pragma unroll
        for (int bj = 0; bj < 2; ++bj)
#pragma unroll
            for (int n = 0; n < 2; ++n) sh[bj][n] = *(const f32x4*)(shw + (size_t)v * INW + colb + bj * HALF + 4 * n);
        if (u.pn < 12) {
#pragma unroll
            for (int ai = 0; ai < 2; ++ai)
#pragma unroll
                for (int m = 0; m < 4; ++m) { const int row = row0 + ai * HALF + m * 16; const float r = rs[ai][m];
#pragma unroll
                    for (int bj = 0; bj < 2; ++bj)
#pragma unroll
                        for (int n = 0; n < 2; ++n) { const f32x4 x = acc[ai][bj][m][n] * r + sh[bj][n];
                            u32x2 w; w.x = pk2(x[0], x[1]); w.y = pk2(x[2], x[3]);
                            const int cg = (colb + bj * HALF) / 4 + n;
                            *(u32x2*)(PHY + ((size_t)cg * MT + row) * 4) = w; } }
        } else if (u.pn < 17) {
            const bool isq = u.pn < 16, latent = u.pm < 32;
            const int axis = wc >> 1, p0 = (wc * 16 + fq * 4) & 31;
            const float qs = isq ? QSCALE : 1.0f;
#pragma unroll
            for (int ai = 0; ai < 2; ++ai)
#pragma unroll
                for (int m = 0; m < 4; ++m) { const int row = row0 + ai * HALF + m * 16; const float r = rs[ai][m];
                    const int l = row & (SEQ - 1), pos = axis ? (l & 63) : (l >> 6);
                    f32x4 t0 = (f32x4){1.f, 0.f, 1.f, 0.f}, t1 = t0;
                    if (latent) { const f32x4* tp = (const f32x4*)(rope + ((size_t)pos * 32 + p0) * 2); t0 = tp[0]; t1 = tp[1]; }
                    const float cs[4] = {t0[0], t0[2], t1[0], t1[2]}, sn[4] = {t0[1], t0[3], t1[1], t1[3]};
#pragma unroll
                    for (int bj = 0; bj < 2; ++bj) { const f32x4 a = acc[ai][bj][m][0] * r + sh[bj][0], b = acc[ai][bj][m][1] * r + sh[bj][1];
                        float ra[4], rb[4];
#pragma unroll
                        for (int e = 0; e < 4; ++e) { ra[e] = (a[e] * cs[e] - b[e] * sn[e]) * qs; rb[e] = (a[e] * sn[e] + b[e] * cs[e]) * qs; }
                        u32x4 w; w.x = pk2(ra[0], ra[1]); w.y = pk2(ra[2], ra[3]); w.z = pk2(rb[0], rb[1]); w.w = pk2(rb[2], rb[3]);
                        bf16_t* dst = isq ? Q + (size_t)row * ATTW + (u.pn - 12) * BM + bj * HALF + cpos : Kb + (size_t)row * KVW + bj * HALF + cpos;
                        *(u32x4*)dst = w; } }
        } else {
#pragma unroll
            for (int ai = 0; ai < 2; ++ai)
#pragma unroll
                for (int m = 0; m < 4; ++m) { const int row = row0 + ai * HALF + m * 16; const float r = rs[ai][m];
#pragma unroll
                    for (int bj = 0; bj < 2; ++bj) { const f32x4 a = acc[ai][bj][m][0] * r + sh[bj][0], b = acc[ai][bj][m][1] * r + sh[bj][1];
                        u32x4 w; w.x = pk2(a[0], a[1]); w.y = pk2(a[2], a[3]); w.z = pk2(b[0], b[1]); w.w = pk2(b[2], b[3]);
                        *(u32x4*)(Vb + (size_t)row * KVW + bj * HALF + cpos) = w; } }
        }
    }
};

struct EpiOutA {
    static constexpr bool PERM = true, AFTER_DRAIN = false;
    float* X; const float* gate;
    const float* sshy;
    __device__ __forceinline__ void operator()(const f32x4 (&acc)[2][2][4][2], const Unit& u, int wr, int wc, int fr_, int fq_) const {
        int fr = fr_, fq = fq_; asm volatile("" : "+v"(fr), "+v"(fq));
        const int row0 = u.pm * BM + wr * 64 + fr, v = vec_of_panel(u.pm);
        const int colb = u.pn * BM + wc * 32 + 8 * fq;
        f32x4 gt[2][2];
#pragma unroll
        for (int bj = 0; bj < 2; ++bj)
#pragma unroll
            for (int n = 0; n < 2; ++n) gt[bj][n] = *(const f32x4*)(gate + (size_t)v * 6 * D + colb + bj * HALF + 4 * n);
#pragma unroll
        for (int ai = 0; ai < 2; ++ai)
#pragma unroll
            for (int m = 0; m < 4; ++m) { const int row = row0 + ai * HALF + m * 16;
                const float r = 1.0f / sqrtf(sshy[row] * (1.0f / HY) + EPS);
                float* xr = X + (size_t)row * D + colb;
#pragma unroll
                for (int bj = 0; bj < 2; ++bj)
#pragma unroll
                    for (int n = 0; n < 2; ++n) { f32x4* px = (f32x4*)(xr + bj * HALF + 4 * n); *px = *px + gt[bj][n] * (acc[ai][bj][m][n] * r); } }
    }
};

struct EpiResid {
    static constexpr bool PERM = true, AFTER_DRAIN = false;
    float* X; const float* gate; const float* gnext  ; bf16_t* AN; float* ssq;
    __device__ __forceinline__ void operator()(const f32x4 (&acc)[2][2][4][2], const Unit& u, int wr, int wc, int fr_, int fq_) const {
        int fr = fr_, fq = fq_; asm volatile("" : "+v"(fr), "+v"(fq));
        const int row0 = u.pm * BM + wr * 64 + fr, v = vec_of_panel(u.pm);
        const int colb = u.pn * BM + wc * 32 + 8 * fq;
        f32x4 gt[2][2], gn[2][2];
#pragma unroll
        for (int bj = 0; bj < 2; ++bj)
#pragma unroll
            for (int n = 0; n < 2; ++n) { gt[bj][n] = *(const f32x4*)(gate + (size_t)v * 6 * D + colb + bj * HALF + 4 * n);
                gn[bj][n] = gnext ? *(const f32x4*)(gnext + (size_t)v * D + colb + bj * HALF + 4 * n) : (f32x4){0.f, 0.f, 0.f, 0.f}; }
#pragma unroll
        for (int ai = 0; ai < 2; ++ai)
#pragma unroll
            for (int m = 0; m < 4; ++m) { const int row = row0 + ai * HALF + m * 16;
                float* xr = X + (size_t)row * D + colb; float s = 0.f;
#pragma unroll
                for (int bj = 0; bj < 2; ++bj) { f32x4 x[2];
#pragma unroll
                    for (int n = 0; n < 2; ++n) { f32x4* px = (f32x4*)(xr + bj * HALF + 4 * n); x[n] = *px + gt[bj][n] * acc[ai][bj][m][n]; *px = x[n];
                        s += (x[n][0] * x[n][0] + x[n][1] * x[n][1]) + (x[n][2] * x[n][2] + x[n][3] * x[n][3]); }
                    if (gnext) { const f32x4 a = x[0] * gn[bj][0], b = x[1] * gn[bj][1];
                        u32x4 w; w.x = pk2(a[0], a[1]); w.y = pk2(a[2], a[3]); w.z = pk2(b[0], b[1]); w.w = pk2(b[2], b[3]);
                        *(u32x4*)(AN + (size_t)row * D + colb + bj * HALF) = w; } }
                s += __shfl_xor(s, 16); s += __shfl_xor(s, 32);
                if (fq == 0) ssq[((size_t)u.pn * MT + row) * 4 + wc] = s; }
    }
};

struct EpiGU {
    static constexpr bool PERM = true, AFTER_DRAIN = false;
    const float* ssq; const float* shw;
    bf16_t* HB;
    __device__ __forceinline__ void operator()(const f32x4 (&acc)[2][2][4][2], const Unit& u, int wr, int wc, int fr_, int fq_) const {
        int fr = fr_, fq = fq_; asm volatile("" : "+v"(fr), "+v"(fq));
        const int row0 = u.pm * BM + wr * 64 + fr, v = vec_of_panel(u.pm);
        float rs[2][4]; load_rstd8(ssq, row0, fq, rs);
        const int colb = u.pn * BM + wc * 32 + 8 * fq;
        f32x4 sh[2][2];
#pragma unroll
        for (int bj = 0; bj < 2; ++bj)
#pragma unroll
            for (int n = 0; n < 2; ++n) sh[bj][n] = *(const f32x4*)(shw + (size_t)v * GU + colb + bj * HALF + 4 * n);
#pragma unroll
        for (int ai = 0; ai < 2; ++ai)
#pragma unroll
            for (int m = 0; m < 4; ++m) { const int row = row0 + ai * HALF + m * 16; const float r = rs[ai][m];
#pragma unroll
                for (int bj = 0; bj < 2; ++bj) { const f32x4 g = acc[ai][bj][m][0] * r + sh[bj][0], up = acc[ai][bj][m][1] * r + sh[bj][1];
                    float h[4];
#pragma unroll
                    for (int e = 0; e < 4; ++e) h[e] = g[e] * __builtin_amdgcn_rcpf(1.0f + __builtin_amdgcn_exp2f(-g[e] * LOG2E)) * up[e];
                    u32x2 w; w.x = pk2(h[0], h[1]); w.y = pk2(h[2], h[3]);
                    const int ff = (colb + bj * HALF) >> 1;
                    *(u32x2*)(HB + (size_t)row * FF + ff) = w; } }
    }
};

template <class RowMap>
__device__ __forceinline__ void transpose_item(const float* W, int K, int N, bf16_t* WT, LAS float* scr, int item, int lane, const RowMap& rm) {
    const int nblk = N / 32, kb = item / nblk, nb = item % nblk, k0 = 64 * kb, n0 = 32 * nb;
#pragma unroll 8
    for (int i = 0; i < 32; ++i) { const int kk = 2 * i + (lane >> 5); scr[kk * 33 + (lane & 31)] = W[(size_t)(k0 + kk) * N + n0 + (lane & 31)]; }
    asm volatile("s_waitcnt lgkmcnt(0)" ::: "memory");
    const int c = lane & 7;
#pragma unroll
    for (int j = 0; j < 4; ++j) { const int n = (lane >> 3) + 8 * j; const LAS float* s = scr + (8 * c) * 33 + n;
        u32x4 o; o.x = pk2(s[0 * 33], s[1 * 33]); o.y = pk2(s[2 * 33], s[3 * 33]); o.z = pk2(s[4 * 33], s[5 * 33]); o.w = pk2(s[6 * 33], s[7 * 33]);
        *(u32x4*)(WT + (size_t)rm(n0 + n) * K + k0 + 8 * c) = o; }
    asm volatile("s_waitcnt lgkmcnt(0)" ::: "memory");
}
struct MapId { __device__ __forceinline__ int operator()(int n) const { return n; } };
struct MapIn { __device__ __forceinline__ int operator()(int n) const {
    if (n < 3 * HY || n >= 3 * HY + ATTW + KVW) return n;
    const int h0 = (n - 3 * HY) & ~127, d = (n - 3 * HY) & 127;
    const int nn = (d >> 5) & 1, base = d - 32 * nn, idx = base < 32 ? base : base - 32, wc = idx >> 4, fq = (idx >> 2) & 3, e = idx & 3;
    return 3 * HY + h0 + 32 * wc + 8 * fq + 4 * nn + e; } };
struct MapGU { int up; __device__ __forceinline__ int operator()(int n) const { return (n >> 2) * 8 + up * 4 + (n & 3); } };

__device__ __forceinline__ float silu_acc(float v) { return v / (1.f + expf(-v)); }

__device__ __forceinline__ void p0a(LAS unsigned char* lds, int G, const int wave_s) {
    FRESH_IDS; FRESH_KP;
    unsigned char* ws = Pp->ws;
    const int gw = blockIdx.x * NWAVES + wave, NGW = G * NWAVES;
    const int gt = blockIdx.x * NTHR + tid, NGT = G * NTHR;
    { const f32x4* xs = (const f32x4*)Pp->in[0]; const f32x4* cs = (const f32x4*)Pp->in[2]; f32x4* X = (f32x4*)(ws + WS_X);
      const int nl = ML * D / 4, nt = MT * D / 4;
      for (int i = gt; i < nt; i += NGT) X[i] = i < nl ? xs[i] : cs[i - nl]; }
    { float* rope = (float*)(ws + WS_ROPE);
      for (int i = gt; i < 64 * 32; i += NGT) { const int pos = i >> 5, p = i & 31; const float inv = powf(10000.f, -(float)p / 32.f); const float ang = (float)pos * inv; rope[2 * i] = cosf(ang); rope[2 * i + 1] = sinf(ang); }
    }
    LAS float* SV = (LAS float*)(lds + 98304);
    for (int i = tid; i < 3 * D; i += NTHR) SV[i] = silu_acc(i < 2 * D ? Pp->in[1][i] : Pp->in[3][i - 2 * D]);
    __syncthreads();
    { float* MODP = (float*)(ws + WS_MODP);
      constexpr int KCH = D / MOD_KC, NCH = 6 * D / 256, NIT = DEPTH * NCH * MOD_KC;
      for (int it = gw; it < NIT; it += NGW) {
          const int kc = it % MOD_KC, nc = (it / MOD_KC) % NCH, layer = it / (MOD_KC * NCH);
          const float* W = Pp->in[6] + (size_t)layer * D * 6 * D + (size_t)(kc * KCH) * 6 * D + nc * 256 + lane * 4;
          f32x4 a0 = {0.f, 0.f, 0.f, 0.f}, a1 = a0, a2 = a0;
#pragma unroll 8
          for (int k = 0; k < KCH; ++k) { const f32x4 w = *(const f32x4*)(W + (size_t)k * 6 * D); const int kk = kc * KCH + k;
              a0 += w * SV[kk]; a1 += w * SV[D + kk]; a2 += w * SV[2 * D + kk]; }
          float* o = MODP + ((size_t)(kc * DEPTH + layer) * 3) * 6 * D + nc * 256 + lane * 4;
          *(f32x4*)o = a0; *(f32x4*)(o + 6 * D) = a1; *(f32x4*)(o + 12 * D) = a2; } }
    { for (int it = gw; it < DEPTH * (SEQ + CTX); it += NGW) {
          const int layer = it / (SEQ + CTX), r = it % (SEQ + CTX); const bool isc = r >= SEQ; const int l = isc ? r - SEQ : r, L = isc ? CTX : SEQ;
          const float* w1 = Pp->in[11] + (size_t)layer * FE * FH; const float* b1 = Pp->in[12] + layer * FH; const float* w2 = Pp->in[13] + (size_t)layer * FH * FH; const float* b2 = Pp->in[14] + layer * FH; const float* fr = Pp->in[16] + layer * FH;
          float emb = 0.f;
          if (lane < FE) { const float t = (float)l / (float)(L - 1); const float w = (2.0f * 3.14159265358979323846f / (float)L) * (float)l;
              if (lane == 0) emb = t; else { const int bi = (lane - 1) & 15; const float band = 1e-4f + (float)bi * ((15.0f - 1e-4f) / 15.0f); emb = lane <= 16 ? cosf(band * w) : -sinf(band * w); } }
          float a = b1[lane];
          for (int j = 0; j < FE; ++j) a += __shfl(emb, j) * w1[j * FH + lane];
          const float h1 = sinf(fr[lane] * a);
          float c = b2[lane];
          for (int j = 0; j < FH; ++j) c += __shfl(h1, j) * w2[j * FH + lane];
          float* dst = isc ? (float*)(ws + WS_HIDC) + ((size_t)layer * CTX + l) * FH : (float*)(ws + WS_HIDL) + ((size_t)layer * SEQ + l) * FH;
          dst[lane] = sinf(fr[lane] * c); } }
    { LAS float* scr = (LAS float*)(lds + wave * 8704);
      constexpr int I_IN = (D / 64) * (INW / 32), I_OUT = (D / 64) * (D / 32), I_G = (D / 64) * (FF / 32), I_D = (FF / 64) * (D / 32);
      constexpr int PER = I_IN + I_OUT + 2 * I_G + I_D;
      for (int it = gw; it < DEPTH * PER; it += NGW) {
          const int layer = it / PER; int r = it % PER;
          if (r < I_IN) { transpose_item(Pp->in[8] + (size_t)layer * D * INW, D, INW, (bf16_t*)(ws + WS_WIN) + (size_t)layer * INW * D, scr, r, lane, MapIn{}); continue; } r -= I_IN;
          if (r < I_OUT) { transpose_item(Pp->in[21] + (size_t)layer * D * D, D, D, (bf16_t*)(ws + WS_WOUT) + (size_t)layer * D * D, scr, r, lane, MapId{}); continue; } r -= I_OUT;
          if (r < I_G) { transpose_item(Pp->in[22] + (size_t)layer * D * FF, D, FF, (bf16_t*)(ws + WS_WGU) + (size_t)layer * GU * D, scr, r, lane, MapGU{0}); continue; } r -= I_G;
          if (r < I_G) { transpose_item(Pp->in[23] + (size_t)layer * D * FF, D, FF, (bf16_t*)(ws + WS_WGU) + (size_t)layer * GU * D, scr, r, lane, MapGU{1}); continue; } r -= I_G;
          transpose_item(Pp->in[24] + (size_t)layer * FF * D, FF, D, (bf16_t*)(ws + WS_WD) + (size_t)layer * D * FF, scr, r, lane, MapId{}); } }
}

__device__ __forceinline__ void p0b(int G, const int wave_s) {
    FRESH_IDS; FRESH_KP;
    unsigned char* ws = Pp->ws; const int gt = blockIdx.x * NTHR + tid, NGT = G * NTHR;
    const float* MODP = (const float*)(ws + WS_MODP); float* MOD = (float*)(ws + WS_MOD);
    constexpr int NTOT = DEPTH * 3 * 6 * D;
    for (int i = gt; i < NTOT; i += NGT) { const int layer = i / (3 * 6 * D), n = i % (6 * D); float s = Pp->in[7][(size_t)layer * 6 * D + n];
#pragma unroll
        for (int kc = 0; kc < MOD_KC; ++kc) { const int rest = i % (3 * 6 * D); s += MODP[((size_t)(kc * DEPTH + layer) * 3) * 6 * D + rest]; }
        MOD[i] = s; }
}

__device__ __forceinline__ void p0c(LAS unsigned char* lds, int G, const int wave_s) {
    FRESH_IDS; FRESH_KP;
    unsigned char* ws = Pp->ws;
    const int gw = blockIdx.x * NWAVES + wave, NGW = G * NWAVES;
    const int gt = blockIdx.x * NTHR + tid, NGT = G * NTHR;
    const float* MOD = (const float*)(ws + WS_MOD);
    { float* GMV = (float*)(ws + WS_GMV);
      for (int i = gt; i < DEPTH * 2 * 3 * D; i += NGT) { const int c = i % D, v = (i / D) % 3, which = (i / (3 * D)) % 2, layer = i / (6 * D);
          const float g = which ? Pp->in[5][layer * D + c] : Pp->in[4][layer * D + c];
          GMV[i] = g * (1.0f + MOD[((size_t)layer * 3 + v) * 6 * D + (which ? 4 : 1) * D + c]); } }
    { constexpr int PER = (INW + GU) / 32;
      for (int it = gw; it < DEPTH * PER; it += NGW) { const int layer = it / PER, r0 = (it % PER) * 32; const bool isin = r0 < INW;
          const bf16_t* wbase = isin ? (const bf16_t*)(ws + WS_WIN) + ((size_t)layer * INW + r0) * D : (const bf16_t*)(ws + WS_WGU) + ((size_t)layer * GU + (r0 - INW)) * D;
          const float* sh = MOD + (size_t)layer * 3 * 6 * D + (isin ? 0 : 3) * D;
          float k0 = 0.f, k1 = 0.f, k2 = 0.f;
#pragma nounroll
          for (int rr = 0; rr < 32; ++rr) { const bf16_t* wrow = wbase + (size_t)rr * D;
              float a0 = 0.f, a1 = 0.f, a2 = 0.f;
#pragma unroll
              for (int j = 0; j < 4; ++j) { const int k = lane * 8 + 512 * j; const u32x4 w = *(const u32x4*)(wrow + k);
                  const float wf[8] = {bf_lo(w.x), bf_hi(w.x), bf_lo(w.y), bf_hi(w.y), bf_lo(w.z), bf_hi(w.z), bf_lo(w.w), bf_hi(w.w)};
#pragma unroll
                  for (int e = 0; e < 8; ++e) { a0 += wf[e] * sh[k + e]; a1 += wf[e] * sh[6 * D + k + e]; a2 += wf[e] * sh[12 * D + k + e]; } }
              a0 = wave_sum(a0); a1 = wave_sum(a1); a2 = wave_sum(a2);
              if (lane == rr) { k0 = a0; k1 = a1; k2 = a2; } }
          if (lane < 32) { float* o = isin ? (float*)(ws + WS_SHWIN) + (size_t)layer * 3 * INW + r0 + lane : (float*)(ws + WS_SHWGU) + (size_t)layer * 3 * GU + (r0 - INW) + lane;
              const int st = isin ? INW : GU; o[0] = k0; o[st] = k1; o[2 * st] = k2; } } }
    { const float* X = (const float*)(ws + WS_X); bf16_t* AN = (bf16_t*)(ws + WS_AN); float* SSQ = (float*)(ws + WS_SSQ);
      for (int row = gw; row < MT; row += NGW) { const int v = vec_of_row(row); const float* xr = X + (size_t)row * D; float s = 0.f;
#pragma unroll
          for (int j = 0; j < 4; ++j) { const int c = lane * 8 + 512 * j; const f32x4 a = *(const f32x4*)(xr + c), b = *(const f32x4*)(xr + c + 4);
              s += (a[0] * a[0] + a[1] * a[1]) + (a[2] * a[2] + a[3] * a[3]) + (b[0] * b[0] + b[1] * b[1]) + (b[2] * b[2] + b[3] * b[3]);
              float gm[8];
#pragma unroll
              for (int e = 0; e < 8; ++e) gm[e] = Pp->in[4][c + e] * (1.0f + MOD[(size_t)v * 6 * D + 1 * D + c + e]);
              u32x4 w; w.x = pk2(a[0] * gm[0], a[1] * gm[1]); w.y = pk2(a[2] * gm[2], a[3] * gm[3]); w.z = pk2(b[0] * gm[4], b[1] * gm[5]); w.w = pk2(b[2] * gm[6], b[3] * gm[7]);
              *(u32x4*)(AN + (size_t)row * D + c) = w; }
          s = wave_sum(s);
          if (lane < 32) SSQ[((size_t)(lane >> 2) * MT + row) * 4 + (lane & 3)] = lane == 0 ? s : 0.f; } }
    { constexpr int CB = HY / 8, IT_L = (SEQ / 512) * CB, IT_C = CB, PER = IT_L + IT_C;
      for (int it = blockIdx.x; it < DEPTH * PER; it += G) {
          const int layer = it / PER; int r = it % PER; const bool isc = r >= IT_L; if (isc) r -= IT_L;
          const int cb = r % CB, lb = r / CB, c0 = cb * 8, L = isc ? CTX : SEQ, l = lb * 512 + tid;
          const float* w3 = Pp->in[15] + (size_t)layer * FH * 4096 + c0;
          if (l < L) {
              const float* hp = (isc ? (const float*)(ws + WS_HIDC) + ((size_t)layer * CTX + l) * FH : (const float*)(ws + WS_HIDL) + ((size_t)layer * SEQ + l) * FH);
              float acc[4][8];
#pragma unroll
              for (int od = 0; od < 4; ++od)
#pragma unroll
                  for (int e = 0; e < 8; ++e) acc[od][e] = 0.f;
#pragma nounroll
              for (int k4 = 0; k4 < 16; ++k4) { const f32x4 h4 = *(const f32x4*)(hp + 4 * k4);
#pragma unroll
                  for (int kk = 0; kk < 4; ++kk) { const float* wk = w3 + (size_t)(4 * k4 + kk) * 4096;
#pragma unroll
                      for (int od = 0; od < 4; ++od)
#pragma unroll
                          for (int e = 0; e < 8; ++e) acc[od][e] += h4[kk] * wk[od * 1024 + e]; } }
              const float t = (float)l / (float)(L - 1);
              float* dstb = isc ? (float*)(ws + WS_FLTC) + (size_t)layer * 4 * HY * CTX : (float*)(ws + WS_FLT) + (size_t)layer * 4 * HY * SEQ;
#pragma unroll
              for (int e = 0; e < 8; ++e) { const int c = c0 + e;
                  const float dmin = -3.0701134573253945f, dmax = -15.350567286626973f;
                  const float delta = fabsf(dmin + (float)c * ((dmax - dmin) / 1023.f));
                  const float wdw = expf(-t * delta);
#pragma unroll
                  for (int od = 0; od < 4; ++od) dstb[((size_t)od * HY + c) * L + l] = acc[od][e] * wdw; }
          } } }
}

__device__ __forceinline__ void attn_simple(LAS unsigned char* lds, int layer, int G, int nrows, const int wave_s) {
    FRESH_IDS; FRESH_KP;
    unsigned char* ws = Pp->ws;
    const bf16_t* Q = (const bf16_t*)(ws + WS_Q); const bf16_t* Kb = (const bf16_t*)(ws + WS_K); const bf16_t* Vb = (const bf16_t*)(ws + WS_V);
    bf16_t* YM = (bf16_t*)(ws + WS_YM);
    LAS float* qs = (LAS float*)lds + wave * HD;
    LAS float* ps = (LAS float*)(lds + 4096) + wave * 640;
    LAS float* red = (LAS float*)(lds + 4096 + 8 * 640 * 4);
    const int h = wave, kv = h >> 2;
    const float sk = Pp->in[18][layer * NH + h] * LOG2E;
    const float* gat = Pp->in[20] + layer * ATTW; const float* ghy = Pp->in[19] + layer * HY; const float* ZT = (const float*)(ws + WS_SSHY);
    for (int row = blockIdx.x; row < nrows; row += G) {
        { const unsigned w = *(const unsigned*)(Q + (size_t)row * ATTW + h * HD + 2 * lane); qs[2 * lane] = bf_lo(w); qs[2 * lane + 1] = bf_hi(w); }
        int b, j0 = 0, nwin = 0;
        if (row < ML) { b = row / SEQ; const int l = row % SEQ; j0 = l - WINDOW < 0 ? 0 : l - WINDOW; const int j1 = l + WINDOW > SEQ - 1 ? SEQ - 1 : l + WINDOW; nwin = j1 - j0 + 1; }
        else b = (row - ML) / CTX;
        const int nk = nwin + CTX;
        float mx = -3.0e38f;
        for (int j = lane; j < nk; j += 64) {
            const int krow = j < nwin ? b * SEQ + j0 + j : ML + b * CTX + (j - nwin);
            const bf16_t* kr = Kb + (size_t)krow * KVW + kv * HD;
            float s = 0.f;
#pragma unroll
            for (int d = 0; d < HD; d += 8) { const u32x4 w = *(const u32x4*)(kr + d);
                s += qs[d] * bf_lo(w.x) + qs[d + 1] * bf_hi(w.x) + qs[d + 2] * bf_lo(w.y) + qs[d + 3] * bf_hi(w.y) + qs[d + 4] * bf_lo(w.z) + qs[d + 5] * bf_hi(w.z) + qs[d + 6] * bf_lo(w.w) + qs[d + 7] * bf_hi(w.w); }
            ps[j] = s; mx = fmaxf(mx, s);
        }
        mx = fmaxf(wave_max(mx), sk);
        float sum = 0.f;
        for (int j = lane; j < nk; j += 64) { const float e = __builtin_amdgcn_exp2f(ps[j] - mx); ps[j] = e; sum += e; }
        sum = wave_sum(sum) + __builtin_amdgcn_exp2f(sk - mx);
        float o0 = 0.f, o1 = 0.f;
        for (int j = 0; j < nk; ++j) {
            const int krow = j < nwin ? b * SEQ + j0 + j : ML + b * CTX + (j - nwin);
            const unsigned w = *(const unsigned*)(Vb + (size_t)krow * KVW + kv * HD + 2 * lane);
            const float pj = ps[j]; o0 += pj * bf_lo(w); o1 += pj * bf_hi(w);
        }
        const float inv = 1.f / sum; o0 *= inv; o1 *= inv;
        const float part = wave_sum(o0 * o0 + o1 * o1);
        const float z0 = ZT[(size_t)(2 * tid) * MT + row], z1 = ZT[(size_t)(2 * tid + 1) * MT + row];
        const float parth = wave_sum(z0 * z0 + z1 * z1);
        __syncthreads();
        if (lane == 0) { red[wave] = part; red[8 + wave] = parth; }
        __syncthreads();
        float tot = 0.f, toth = 0.f;
#pragma unroll
        for (int i = 0; i < 8; ++i) { tot += red[i]; toth += red[8 + i]; }
        const float r = 1.0f / sqrtf(tot * (1.0f / ATTW) + EPS), rh = 1.0f / sqrtf(toth * (1.0f / HY) + EPS);
        const int c = h * HD + 2 * lane;
        *(unsigned*)(YM + (size_t)row * D + HY + c) = pk2(o0 * r * gat[c], o1 * r * gat[c + 1]);
        *(unsigned*)(YM + (size_t)row * D + 2 * tid) = pk2(z0 * rh * ghy[2 * tid], z1 * rh * ghy[2 * tid + 1]);
    }
    __syncthreads();
}

__device__ __forceinline__ float phy_at(const bf16_t* PHY, int row, int ch) { return bf1(PHY[((size_t)(ch >> 2) * MT + row) * 4 + (ch & 3)]); }
__device__ __forceinline__ float sconv(const bf16_t* PHY, const float* cw, const float* cb, int row, int ch, int l, int L) {
    float a = cb[ch] + cw[3 * HY + ch] * phy_at(PHY, row, ch);
    if (l > 0) a += cw[ch] * phy_at(PHY, row - 1, ch);
    if (l < L - 1) a += cw[2 * 3 * HY + ch] * phy_at(PHY, row + 1, ch);
    return a;
}
template <int L>
__device__ __forceinline__ void hyena_direct(LAS unsigned char* lds, int layer, int G, int row_base, const int wave_s) {
    FRESH_IDS; FRESH_KP;
    unsigned char* ws = Pp->ws;
    constexpr int TPB = L < NTHR ? L : NTHR, NI = L / TPB;
    const bf16_t* PHY = (const bf16_t*)(ws + WS_PHY); float* ZT = (float*)(ws + WS_SSHY);
    const float* FL = L == SEQ ? (const float*)(ws + WS_FLT) + (size_t)layer * 4 * HY * SEQ : (const float*)(ws + WS_FLTC) + (size_t)layer * 4 * HY * CTX;
    const float* cw = Pp->in[9] + (size_t)layer * 3 * 3 * HY; const float* cb = Pp->in[10] + (size_t)layer * 3 * HY;
    const float* fbias = Pp->in[17] + (size_t)layer * 2 * HY;
    LAS float* G0 = (LAS float*)lds; LAS float* G1 = G0 + 2 * L; LAS float* z = G1 + 2 * L;
    for (int it = blockIdx.x; it < HY * BATCH; it += G) {
        const int c = it % HY, seq = it / HY, row0 = row_base + seq * L;
        __syncthreads();
#pragma nounroll
        for (int d = tid; d < L; d += NTHR) {
            G0[L - 1 + d] = FL[((size_t)0 * HY + c) * L + d]; G1[L - 1 + d] = FL[((size_t)2 * HY + c) * L + d];
            if (d > 0) { G0[L - 1 - d] = FL[((size_t)1 * HY + c) * L + d]; G1[L - 1 - d] = FL[((size_t)3 * HY + c) * L + d]; }
            z[d] = sconv(PHY, cw, cb, row0 + d, 2 * HY + c, d, L);
        }
        __syncthreads();
#pragma unroll
        for (int o = 0; o < 2; ++o) {
            LAS float* Gg = o ? G1 : G0;
            float acc[NI], zn[NI];
#pragma unroll
            for (int i = 0; i < NI; ++i) acc[i] = 0.f;
            if (tid < TPB) {
                for (int s = 0; s < L; ++s) { const float zs = z[s];
#pragma unroll
                    for (int i = 0; i < NI; ++i) acc[i] += zs * Gg[tid + TPB * i - s + L - 1]; }
                const float fb = fbias[o * HY + c];
#pragma nounroll
                for (int i = 0; i < NI; ++i) { const int t = tid + TPB * i; zn[i] = sconv(PHY, cw, cb, row0 + t, o * HY + c, t, L) * (acc[i] + fb * z[t]); }
            }
            __syncthreads();
            if (tid < TPB) {
#pragma unroll
                for (int i = 0; i < NI; ++i) z[tid + TPB * i] = zn[i];
            }
            __syncthreads();
        }
        if (tid < TPB) {
#pragma unroll
            for (int i = 0; i < NI; ++i) { const int t = tid + TPB * i; ZT[(size_t)c * MT + row0 + t] = z[t]; } }
    }
    __syncthreads();
}

__device__ __forceinline__ void final_norm(int G, const int wave_s) {
    FRESH_IDS; FRESH_KP;
    unsigned char* ws = Pp->ws; const int gw = blockIdx.x * NWAVES + wave, NGW = G * NWAVES;
    const float* X = (const float*)(ws + WS_X); const float* SSQ = (const float*)(ws + WS_SSQ); const float* g = Pp->in[25];
    for (int row = gw; row < ML; row += NGW) {
        const float s = wave_sum(lane < 32 ? SSQ[((size_t)(lane >> 2) * MT + row) * 4 + (lane & 3)] : 0.f);
        const float r = 1.0f / sqrtf(s * (1.0f / D) + EPS);
#pragma unroll
        for (int j = 0; j < 8; ++j) { const int c = lane * 4 + 256 * j; const f32x4 x = *(const f32x4*)(X + (size_t)row * D + c), gg = *(const f32x4*)(g + c);
            *(f32x4*)(Pp->out + (size_t)row * D + c) = x * r * gg; }
    }
}

constexpr int NPHASE = 3 + 6 * DEPTH + 1;
__global__ void __launch_bounds__(NTHR, 2) mk_fwd(Params P) {
    extern __shared__ __attribute__((aligned(16))) unsigned char lds_raw[];
    LAS unsigned char* lds = (LAS unsigned char*)lds_raw;
    const int tid = threadIdx.x, G = gridDim.x, wave_s = __builtin_amdgcn_readfirstlane(tid >> 6);
    unsigned char* ws; int lo, hi; { FRESH_KP; ws = Pp->ws; lo = Pp->ph_lo; hi = Pp->ph_hi; }
    volatile LAS unsigned* MISC = (volatile LAS unsigned*)(lds + MISC_OFF);
    for (int u = tid; u < (LDS_BYTES - RING_BYTES) / 4; u += NTHR) ((LAS unsigned*)(lds + RING_BYTES))[u] = 0u;
    __syncthreads();
    XcdBarrier bar = xcd_barrier_post((unsigned*)(ws + WS_CTL) + CW_BAR, MISC + 8);
#define IN(k) (lo <= (k) && (k) < hi)
#define SEAM(k) do { if (IN(k) && IN((k) + 1)) xcd_barrier(bar, wave_s); } while (0)

    if (IN(0)) { p0a(lds, G, wave_s); } SEAM(0);
    if (IN(1)) { p0b(G, wave_s); } SEAM(1);
    if (IN(2)) { p0c(lds, G, wave_s); } SEAM(2);

    for (int layer = 0; layer < DEPTH; ++layer) {
        const int pb = 3 + 6 * layer;
#define WSL FRESH_KP; unsigned char* w = Pp->ws; const float* MODL = (const float*)(w + WS_MOD) + (size_t)layer * 3 * 6 * D; (void)MODL
        if (IN(pb)) {
            WSL;
            pg8::Gemm g{(const bf16_t*)(w + WS_AN), (const bf16_t*)(w + WS_WIN) + (size_t)layer * INW * D, MT, INW, D, D, D};
            pg8::StaticOrder S; S.init(MT, INW, G, (int)blockIdx.x);
            EpiIn E{(const float*)(w + WS_SSQ), (const float*)(w + WS_SHWIN) + (size_t)layer * 3 * INW, (bf16_t*)(w + WS_PHY), (bf16_t*)(w + WS_Q), (bf16_t*)(w + WS_K), (bf16_t*)(w + WS_V), (const float*)(w + WS_ROPE)};
            pg8::gemm_phase<EpiIn, pg8::StaticOrder, true, true>(lds, g, S, E, wave_s);
        }
        SEAM(pb);
        if (IN(pb + 1)) {
            hyena_direct<SEQ>(lds, layer, G, 0, wave_s);
            if (layer != DEPTH - 1) hyena_direct<CTX>(lds, layer, G, ML, wave_s);
        }
        SEAM(pb + 1);
        if (IN(pb + 2)) {
            attn_simple(lds, layer, G, layer == DEPTH - 1 ? ML : MT, wave_s);
        }
        SEAM(pb + 2);
        if (IN(pb + 3)) {
            WSL;
            pg8::Gemm g{(const bf16_t*)(w + WS_YM), (const bf16_t*)(w + WS_WOUT) + (size_t)layer * D * D, MT, D, D, D, D};
            pg8::StaticOrder S; S.init(MT, D, G, (int)blockIdx.x);
            EpiResid E{(float*)(w + WS_X), MODL + 2 * D, (const float*)(w + WS_GMV) + ((size_t)layer * 2 + 1) * 3 * D, (bf16_t*)(w + WS_AN), (float*)(w + WS_SSQ)};
            pg8::gemm_phase<EpiResid, pg8::StaticOrder, true, true>(lds, g, S, E, wave_s);
        }
        SEAM(pb + 3);
        if (IN(pb + 4)) {
            WSL;
            pg8::Gemm g{(const bf16_t*)(w + WS_AN), (const bf16_t*)(w + WS_WGU) + (size_t)layer * GU * D, MT, GU, D, D, D};
            pg8::StaticOrder S; S.init(MT, GU, G, (int)blockIdx.x);
            EpiGU E{(const float*)(w + WS_SSQ), (const float*)(w + WS_SHWGU) + (size_t)layer * 3 * GU, (bf16_t*)(w + WS_HB)};
            pg8::gemm_phase<EpiGU, pg8::StaticOrder, true, true>(lds, g, S, E, wave_s);
        }
        SEAM(pb + 4);
        if (IN(pb + 5)) {
            WSL;
            pg8::Gemm g{(const bf16_t*)(w + WS_HB), (const bf16_t*)(w + WS_WD) + (size_t)layer * D * FF, MT, D, FF, FF, FF};
            pg8::StaticOrder S; S.init(MT, D, G, (int)blockIdx.x);
            EpiResid E{(float*)(w + WS_X), MODL + 5 * D, layer + 1 < DEPTH ? (const float*)(w + WS_GMV) + ((size_t)(layer + 1) * 2 + 0) * 3 * D : nullptr, (bf16_t*)(w + WS_AN), (float*)(w + WS_SSQ)};
            pg8::gemm_phase<EpiResid, pg8::StaticOrder, true, true>(lds, g, S, E, wave_s);
        }
        SEAM(pb + 5);
    }
    if (IN(NPHASE - 1)) final_norm(G, wave_s);
#undef IN
#undef SEAM
}
}

#ifndef MK_N_LAUNCHES
#define MK_N_LAUNCHES 1
#endif
extern "C" void kernel_launch(void* const* d_in, const int* in_sizes, int n_in, void* d_out, int out_size, void* d_ws, size_t ws_size, hipStream_t stream) {
    using namespace mk;
    static int grid = 0;
    if (grid == 0) {
        if (n_in != 26 || ws_size < WS_END) { fprintf(stderr, "kernel_launch: need 26 inputs and %zu bytes of workspace (got %d, %zu)\n", (size_t)WS_END, n_in, ws_size); grid = -1; return; }
        int dev = 0, cus = 0, per_cu = 0;
        if (hipGetDevice(&dev) != hipSuccess || hipDeviceGetAttribute(&cus, hipDeviceAttributeMultiprocessorCount, dev) != hipSuccess) { grid = -1; return; }
        if (hipFuncSetAttribute((const void*)mk_fwd, hipFuncAttributeMaxDynamicSharedMemorySize, LDS_BYTES) != hipSuccess) { fprintf(stderr, "kernel_launch: hipFuncSetAttribute failed\n"); grid = -1; return; }
        if (hipOccupancyMaxActiveBlocksPerMultiprocessor(&per_cu, (const void*)mk_fwd, NTHR, LDS_BYTES) != hipSuccess || per_cu < 1) { fprintf(stderr, "kernel_launch: occupancy query says %d\n", per_cu); }
        (void)hipGetLastError();
        grid = cus;
    }
    if (grid < 0) return;
    (void)hipMemsetAsync((char*)d_ws + WS_CTL, 0, CTL_BYTES, stream);
    Params p{};
    for (int i = 0; i < 26; ++i) p.in[i] = (const float*)d_in[i];
    p.out = (float*)d_out; p.ws = (unsigned char*)d_ws;
#if MK_N_LAUNCHES == 1
    p.ph_lo = 0; p.ph_hi = NPHASE;
    hipLaunchKernelGGL(mk_fwd, dim3(grid), dim3(NTHR), LDS_BYTES, stream, p);
#else
    for (int ph = 0; ph < NPHASE; ++ph) { p.ph_lo = ph; p.ph_hi = ph + 1; hipLaunchKernelGGL(mk_fwd, dim3(grid), dim3(NTHR), LDS_BYTES, stream, p); }
#endif
}
```

```cpp
#include <hip/hip_runtime.h>
#include <cstdint>
#include <cstdio>
#define LAS __attribute__((address_space(3)))
#define GAS __attribute__((address_space(1)))
#define MK_LANE_ASM(l) asm volatile("v_mbcnt_lo_u32_b32 %0, -1, 0\n\tv_mbcnt_hi_u32_b32 %0, -1, %0" : "=v"(l))
namespace pg8 {
#define PG8_LAS __attribute__((address_space(3)))
typedef unsigned short bf16_t;
typedef short bf16x8 __attribute__((ext_vector_type(8)));
typedef float f32x4 __attribute__((ext_vector_type(4)));
typedef unsigned u32x4 __attribute__((ext_vector_type(4)));
constexpr int BM = 256, BK = 64, HALF = 128, HTB = HALF * BK * 2  , STAGE_BYTES = 8 * HTB, NXCD = 8, WGM = 8;

__host__ __device__ __forceinline__ int lds_byte(int r, int c) { const int st = (r >> 4) * 2 + (c >> 5), rr = r & 15, cc = c & 31, ob = rr * 64 + cc * 2; return st * 1024 + (ob ^ (((ob >> 9) & 1) << 5)); }
__host__ __device__ __forceinline__ void stage_rc(int b, int& R, int& C) { const int st = b / 1024, sb = b % 1024, swz = sb ^ (((sb >> 9) & 1) << 5); R = (st >> 1) * 16 + swz / 64; C = (st & 1) * 32 + (swz % 64) / 2; }
__host__ __device__ __forceinline__ int perm32(int rho) { const int n = rho >> 4, i = rho & 15; return 8 * (i >> 2) + 4 * n + (i & 3); }

struct Unit { int pm, pn; };
struct Gemm { const bf16_t* A; const bf16_t* Bt; int M, N, K, lda, ldb; };

struct StaticOrder {
    int nM, nN, nwg, G, c;
    __host__ __device__ void init(int M, int N, int G_, int c_) { nM = M / BM; nN = N / BM; nwg = nM * nN; G = G_; c = c_; }
    __host__ __device__ bool next(int i, Unit& u) const {
        const long L = (long)i * G + c; if (L >= nwg) return false;
        int wgid = (int)L; { const int q = nwg / NXCD, r = nwg % NXCD, xcd = wgid % NXCD, off = wgid / NXCD; wgid = (xcd < r ? xcd * (q + 1) : r * (q + 1) + (xcd - r) * q) + off; }
        const int nig = WGM * nN, gid = wgid / nig, fm = gid * WGM, gsz = (nM - fm) < WGM ? (nM - fm) : WGM;
        u.pm = fm + ((wgid % nig) % gsz); u.pn = (wgid % nig) / gsz; return true;
    }
    __device__ __forceinline__ void a_ready(const Unit&) const {}
    __device__ __forceinline__ void done(const Unit&) const {}
};

template <class Epi, class Sched, bool ALIGN_EPI = false, bool SP2 = false>
__device__ __forceinline__ void gemm_phase(PG8_LAS unsigned char* lds, const Gemm g, const Sched& S, const Epi& E, const int wave_s) {
    int lane_; MK_LANE_ASM(lane_); int wv_ = wave_s; asm volatile("" : "+s"(wv_)); const int wid = wv_, lane = lane_, tid = wid * 64 + lane, wr = wid >> 2, wc = wid & 3, fr = lane & 15, fq = lane >> 4;
    const int K = g.K, nt = K / BK;
    unsigned voffA[2], voffB[2];
#pragma unroll
    for (int i = 0; i < 2; ++i) { int R, C; stage_rc(tid * 16 + i * 8192, R, C); const int Rb = Epi::PERM ? ((R & ~31) + perm32(R & 31)) : R;
        voffA[i] = (unsigned)(R * g.lda + C) * 2u; voffB[i] = (unsigned)(Rb * g.ldb + C) * 2u; }
    const size_t kstep = (size_t)(BK * 2);
    const size_t hstepA = (size_t)HALF * g.lda * 2, hstepB = (size_t)HALF * g.ldb * 2;
    const size_t tstepA = 2 * hstepA, tstepB = 2 * hstepB;
    const unsigned ldsw = (unsigned)wid * 1024u;
    const int aoff = lds_byte(wr * 64 + fr, fq * 8), boff = lds_byte(wc * 32 + fr, fq * 8);
#define PG8_SA(b, h) (((b) * 2 + (h)) * HTB)
#define PG8_SB(b, h) ((4 + (b) * 2 + (h)) * HTB)
#define PG8_STAGE(bufoff, gbase, voff) do { _Pragma("unroll") for (int _i = 0; _i < 2; ++_i) \
        __builtin_amdgcn_global_load_lds((const unsigned*)((const char*)(gbase) + (voff)[_i]), (PG8_LAS unsigned*)(lds + (bufoff) + ldsw + _i * 8192), 16, 0, 0); } while (0)
#define PG8_LDA(dst, b, h) do { _Pragma("unroll") for (int m = 0; m < 4; ++m) _Pragma("unroll") for (int k = 0; k < 2; ++k) dst[m][k] = *(const PG8_LAS bf16x8*)(lds + PG8_SA(b, h) + aoff + m * 2048 + k * 1024); } while (0)
#define PG8_LDB(dst, b, h) do { _Pragma("unroll") for (int n = 0; n < 2; ++n) _Pragma("unroll") for (int k = 0; k < 2; ++k) dst[n][k] = *(const PG8_LAS bf16x8*)(lds + PG8_SB(b, h) + boff + n * 2048 + k * 1024); } while (0)
#define PG8_MMA(ai, bj, At, Bt) do { __builtin_amdgcn_s_setprio(1); _Pragma("unroll") for (int m = 0; m < 4; ++m) _Pragma("unroll") for (int n = 0; n < 2; ++n) _Pragma("unroll") for (int k = 0; k < 2; ++k) \
        acc[ai][bj][m][n] = __builtin_amdgcn_mfma_f32_16x16x32_bf16(Bt[n][k], At[m][k], acc[ai][bj][m][n], 0, 0, 0); __builtin_amdgcn_s_setprio(0); } while (0)
#define PG8_WAIT_V(n) asm volatile("s_waitcnt vmcnt(" #n ")" ::: "memory")
#define PG8_WAIT_L(n) asm volatile("s_waitcnt lgkmcnt(" #n ")" ::: "memory")
#define PG8_BAR __builtin_amdgcn_s_barrier()
#define PG8_SCHED __builtin_amdgcn_sched_barrier(0)
    Unit cur, nxt; int ui = 0;
    (void)S.next(0, cur);
    f32x4 acc[2][2][4][2];
#pragma unroll
    for (int a = 0; a < 2; ++a)
#pragma unroll
        for (int b = 0; b < 2; ++b)
#pragma unroll
            for (int m = 0; m < 4; ++m)
#pragma unroll
                for (int n = 0; n < 2; ++n) acc[a][b][m][n] = (f32x4){0.f, 0.f, 0.f, 0.f};
    bf16x8 At[4][2], B0[2][2], B1[2][2];
    const char* cA = (const char*)g.A + (size_t)cur.pm * tstepA; const char* cB = (const char*)g.Bt + (size_t)cur.pn * tstepB;
    S.a_ready(cur);
    if constexpr (SP2) {
        PG8_STAGE(PG8_SB(0, 0), cB, voffB); PG8_STAGE(PG8_SB(0, 1), cB + hstepB, voffB); PG8_STAGE(PG8_SA(0, 0), cA, voffA); PG8_STAGE(PG8_SA(0, 1), cA + hstepA, voffA);
        if (wr == 1) PG8_BAR;
        PG8_WAIT_V(2); PG8_BAR;
        PG8_STAGE(PG8_SB(1, 0), cB + kstep, voffB); PG8_STAGE(PG8_SA(1, 0), cA + kstep, voffA); PG8_STAGE(PG8_SB(1, 1), cB + hstepB + kstep, voffB);
        PG8_WAIT_V(6); PG8_BAR;
    } else {
        PG8_STAGE(PG8_SB(0, 0), cB, voffB); PG8_STAGE(PG8_SA(0, 0), cA, voffA); PG8_STAGE(PG8_SB(0, 1), cB + hstepB, voffB); PG8_STAGE(PG8_SA(0, 1), cA + hstepA, voffA);
        if (wr == 1) PG8_BAR;
        PG8_WAIT_V(4); PG8_BAR;
        PG8_STAGE(PG8_SB(1, 0), cB + kstep, voffB); PG8_STAGE(PG8_SA(1, 0), cA + kstep, voffA); PG8_STAGE(PG8_SB(1, 1), cB + hstepB + kstep, voffB);
        PG8_WAIT_V(6); PG8_BAR;
    }
    for (;;) {
        const bool has_next = S.next(ui + 1, nxt);
        const char* nA = has_next ? (const char*)g.A + (size_t)nxt.pm * tstepA : cA; const char* nB = has_next ? (const char*)g.Bt + (size_t)nxt.pn * tstepB : cB;
        for (int t = 0; t < nt; t += 2) {
            const bool last = (t == nt - 2);
            const char* a1 = cA + (size_t)(t + 1) * kstep;
            const char* a2 = last ? nA : cA + (size_t)(t + 2) * kstep; const char* b2 = last ? nB : cB + (size_t)(t + 2) * kstep;
            const char* a3 = a2 + kstep; const char* b3 = b2 + kstep;
            if (last && has_next) S.a_ready(nxt);
            if constexpr (SP2) {
            PG8_LDB(B0, 0, 0); PG8_LDB(B1, 0, 1); PG8_SCHED; PG8_LDA(At, 0, 0); PG8_STAGE(PG8_SA(1, 1), a1 + hstepA, voffA);
            PG8_WAIT_V(8); PG8_WAIT_L(0); PG8_BAR; PG8_MMA(0, 0, At, B0); PG8_MMA(0, 1, At, B1); PG8_BAR; PG8_SCHED;
            PG8_LDA(At, 0, 1); PG8_STAGE(PG8_SB(0, 0), b2, voffB); PG8_STAGE(PG8_SB(0, 1), b2 + hstepB, voffB); PG8_STAGE(PG8_SA(0, 0), a2, voffA);
            PG8_WAIT_V(8); PG8_WAIT_L(0); PG8_BAR; PG8_MMA(1, 0, At, B0); PG8_MMA(1, 1, At, B1); PG8_BAR; PG8_SCHED;
            PG8_LDB(B0, 1, 0); PG8_LDB(B1, 1, 1); PG8_SCHED; PG8_LDA(At, 1, 0); PG8_STAGE(PG8_SA(0, 1), a2 + hstepA, voffA);
            PG8_WAIT_V(8); PG8_WAIT_L(0); PG8_BAR; PG8_MMA(0, 0, At, B0); PG8_MMA(0, 1, At, B1); PG8_BAR; PG8_SCHED;
            PG8_LDA(At, 1, 1); PG8_STAGE(PG8_SB(1, 0), b3, voffB); PG8_STAGE(PG8_SB(1, 1), b3 + hstepB, voffB); PG8_STAGE(PG8_SA(1, 0), a3, voffA);
            PG8_WAIT_V(8); PG8_WAIT_L(0); PG8_BAR; PG8_MMA(1, 0, At, B0); PG8_MMA(1, 1, At, B1); PG8_BAR; PG8_SCHED;
            } else {
            PG8_LDB(B0, 0, 0); PG8_SCHED; PG8_LDA(At, 0, 0); PG8_STAGE(PG8_SA(1, 1), a1 + hstepA, voffA);
            PG8_WAIT_L(8); PG8_BAR; PG8_WAIT_L(0); PG8_MMA(0, 0, At, B0); PG8_BAR; PG8_SCHED;
            PG8_LDB(B1, 0, 1); PG8_STAGE(PG8_SB(0, 0), b2, voffB);
            PG8_BAR; PG8_WAIT_L(0); PG8_MMA(0, 1, At, B1); PG8_BAR;
            PG8_LDA(At, 0, 1); PG8_STAGE(PG8_SA(0, 0), a2, voffA);
            PG8_BAR; PG8_WAIT_L(0); PG8_MMA(1, 0, At, B0); PG8_BAR; PG8_SCHED;
            PG8_STAGE(PG8_SB(0, 1), b2 + hstepB, voffB);
            PG8_WAIT_V(6); PG8_BAR; PG8_MMA(1, 1, At, B1); PG8_BAR;
            PG8_LDB(B0, 1, 0); PG8_SCHED; PG8_LDA(At, 1, 0); PG8_STAGE(PG8_SA(0, 1), a2 + hstepA, voffA);
            PG8_WAIT_L(8); PG8_BAR; PG8_WAIT_L(0); PG8_MMA(0, 0, At, B0); PG8_BAR; PG8_SCHED;
            PG8_LDB(B1, 1, 1); PG8_STAGE(PG8_SB(1, 0), b3, voffB);
            PG8_BAR; PG8_WAIT_L(0); PG8_MMA(0, 1, At, B1); PG8_BAR;
            PG8_LDA(At, 1, 1); PG8_STAGE(PG8_SA(1, 0), a3, voffA);
            PG8_BAR; PG8_WAIT_L(0); PG8_MMA(1, 0, At, B0); PG8_BAR; PG8_SCHED;
            PG8_STAGE(PG8_SB(1, 1), b3 + hstepB, voffB);
            PG8_WAIT_V(6); PG8_BAR; PG8_MMA(1, 1, At, B1); PG8_BAR;
            }
        }
        if constexpr (ALIGN_EPI) { if (wr == 0) PG8_BAR; }
        if constexpr (!Epi::AFTER_DRAIN) { E(acc, cur, wr, wc, fr, fq); S.done(cur); }
        if (!has_next) break;
#pragma unroll
        for (int a = 0; a < 2; ++a)
#pragma unroll
            for (int b = 0; b < 2; ++b)
#pragma unroll
                for (int m = 0; m < 4; ++m)
#pragma unroll
                    for (int n = 0; n < 2; ++n) acc[a][b][m][n] = (f32x4){0.f, 0.f, 0.f, 0.f};
        cur = nxt; cA = nA; cB = nB; ++ui;
        if constexpr (ALIGN_EPI) { if (wr == 1) PG8_BAR; }
    }
    PG8_WAIT_V(0);
    if constexpr (!ALIGN_EPI) { if (wr == 0) PG8_BAR; }
    PG8_BAR;
    if constexpr (Epi::AFTER_DRAIN) { E.fused(acc, cur, wr, wc, fr, fq, lds, wid, lane); S.done(cur); }
#undef PG8_SA
#undef PG8_SB
#undef PG8_STAGE
#undef PG8_LDA
#undef PG8_LDB
#undef PG8_MMA
#undef PG8_WAIT_V
#undef PG8_WAIT_L
#undef PG8_BAR
#undef PG8_SCHED
}
}

#define XB_TMO      128
#define XB_XCNT(j)  (256  + 64 * (j))
#define XB_XSUB(j)  (1280 + 64 * (j))
#define XB_XGEN(j)  (2304 + 64 * (j))
#define XB_TOP      3328
#define XB_TOPGEN   3392
#define XCD_BAR_WORDS 3456
#define XB_SPIN_CAP (1u << 18)

__device__ __forceinline__ unsigned xb_ld(unsigned* p)              { return __hip_atomic_load(p, __ATOMIC_RELAXED, __HIP_MEMORY_SCOPE_AGENT); }
__device__ __forceinline__ unsigned xb_add(unsigned* p, unsigned v) { return __hip_atomic_fetch_add(p, v, __ATOMIC_RELAXED, __HIP_MEMORY_SCOPE_AGENT); }
__device__ __forceinline__ unsigned xb_xcc_id() { return (unsigned)__builtin_amdgcn_s_getreg((3 << 11) | 20) & 0xFu; }
#define XB_SPIN(cond, bar) do { unsigned _sp = 0; while (cond) { __builtin_amdgcn_s_sleep(1); \
    if ((++_sp & 255u) == 0u) { if (xb_ld(&(bar)[XB_TMO])) break; if (_sp > XB_SPIN_CAP) { atomicAdd(&(bar)[XB_TMO], 1u); break; } } } } while (0)

struct XcdBarrier {
    unsigned* bar; unsigned x;
    volatile LAS unsigned* st;
};

__device__ __forceinline__ XcdBarrier xcd_barrier_post(unsigned* bar, volatile LAS unsigned* st) {
    XcdBarrier b; b.bar = bar; b.x = xb_xcc_id(); b.st = st;
    if (threadIdx.x == 0) (void)xb_add(&bar[XB_XCNT(b.x)], 1u);
    return b;
}
__device__ __forceinline__ void xcd_barrier_complete(unsigned* bar, unsigned x, unsigned& nloc, unsigned& nx) {
    const unsigned G = gridDim.x * gridDim.y * gridDim.z;
    unsigned sum, cnt, mine, sp = 0u;
    for (;;) {
        sum = 0u; cnt = 0u; mine = 0u;
#pragma unroll
        for (unsigned j = 0; j < 16; ++j) { const unsigned c = xb_ld(&bar[XB_XCNT(j)]); sum += c; cnt += (c > 0u) ? 1u : 0u; mine = (j == x) ? c : mine; }
        if (sum == G) break;
        __builtin_amdgcn_s_sleep(1);
        if ((++sp & 255u) == 0u) { if (xb_ld(&bar[XB_TMO])) break; if (sp > XB_SPIN_CAP) { atomicAdd(&bar[XB_TMO], 1u); break; } }
    }
    nloc = mine > 0u ? mine : 1u; nx = cnt > 0u ? cnt : 1u;
}

__device__ __forceinline__ void xcd_barrier(const XcdBarrier& b, const int wave_s) {
    int xb_lane_; MK_LANE_ASM(xb_lane_); const bool xb_t0 = (wave_s == 0) && (xb_lane_ == 0);
    asm volatile("s_waitcnt vmcnt(0)" ::: "memory");
    __syncthreads();
    if (xb_t0) {
        unsigned* bar = b.bar;
        __builtin_amdgcn_s_waitcnt(0);
        unsigned nloc = b.st[0], nx = b.st[1];
        if (nloc == 0u) { xcd_barrier_complete(bar, b.x, nloc, nx); b.st[0] = nloc; b.st[1] = nx; }
        const unsigned old = xb_add(&bar[XB_XSUB(b.x)], 1u);
        const unsigned gen = old / nloc;
        if (old + 1u == (gen + 1u) * nloc) {
            __builtin_amdgcn_fence(__ATOMIC_RELEASE, "agent");
            asm volatile("s_waitcnt vmcnt(0)" ::: "memory");
            const unsigned og = xb_add(&bar[XB_TOP], 1u);
            const unsigned tg = og / nx;
            if (og + 1u == (tg + 1u) * nx) xb_add(&bar[XB_TOPGEN], 1u);
            else XB_SPIN(xb_ld(&bar[XB_TOPGEN]) == tg, bar);
            __builtin_amdgcn_fence(__ATOMIC_ACQUIRE, "agent");
            xb_add(&bar[XB_XGEN(b.x)], 1u);
            asm volatile("s_waitcnt vmcnt(0)" ::: "memory");
        } else {
            XB_SPIN(xb_ld(&bar[XB_XGEN(b.x)]) == gen, bar);
            __builtin_amdgcn_fence(__ATOMIC_ACQUIRE, "agent");
            asm volatile("s_waitcnt vmcnt(0)" ::: "memory");
        }
    }
    __syncthreads();
}


namespace mk {
using pg8::bf16_t; using pg8::f32x4; using pg8::Unit; using pg8::BM; using pg8::HALF;
typedef unsigned u32x4 __attribute__((ext_vector_type(4)));
typedef unsigned u32x2 __attribute__((ext_vector_type(2)));
typedef float f32x2 __attribute__((ext_vector_type(2)));

constexpr int D = 2048, BATCH = 2, SEQ = 4096, DEPTH = 4, CTX = 256;
constexpr int HY = 1024, NH = 8, NKV = 2, HD = 128, ATTW = 1024, KVW = 256;
constexpr int INW = 4608, FF = 5632, GU = 2 * FF, FH = 64, FE = 33;
constexpr int ML = BATCH * SEQ, MC = BATCH * CTX, MT = ML + MC;
constexpr float EPS = 1e-6f;
constexpr float LOG2E = 1.4426950408889634f;
constexpr float QSCALE = 0.08838834764831845f * LOG2E;
constexpr int WINDOW = 128;
constexpr int NWAVES = 8, NTHR = 512;
constexpr int MOD_KC = 8;

constexpr size_t al(size_t x) { return (x + 255) & ~(size_t)255; }
constexpr size_t WS_CTL = 0, CTL_BYTES = 1u << 20;
constexpr size_t WS_X = CTL_BYTES;
constexpr size_t WS_AN = WS_X + al((size_t)MT * D * 4);
constexpr size_t WS_SSQ = WS_AN + al((size_t)MT * D * 2);
constexpr size_t WS_PHY = WS_SSQ + al((size_t)MT * 32 * 4);
constexpr size_t WS_Q = WS_PHY + al((size_t)3 * HY * MT * 2);
constexpr size_t WS_K = WS_Q + al((size_t)MT * ATTW * 2);
constexpr size_t WS_V = WS_K + al((size_t)MT * KVW * 2);
constexpr size_t WS_YM = WS_V + al((size_t)MT * KVW * 2);
constexpr size_t WS_SSHY = WS_YM + al((size_t)MT * D * 2);
constexpr size_t WS_HB = WS_SSHY + al((size_t)HY * MT * 4);
constexpr size_t WS_MODP = WS_HB + al((size_t)MT * FF * 2);
constexpr size_t WS_MOD = WS_MODP + al((size_t)MOD_KC * DEPTH * 3 * 6 * D * 4);
constexpr size_t WS_GMV = WS_MOD + al((size_t)DEPTH * 3 * 6 * D * 4);
constexpr size_t WS_SHWIN = WS_GMV + al((size_t)DEPTH * 2 * 3 * D * 4);
constexpr size_t WS_SHWGU = WS_SHWIN + al((size_t)DEPTH * 3 * INW * 4);
constexpr size_t WS_HIDL = WS_SHWGU + al((size_t)DEPTH * 3 * GU * 4);
constexpr size_t WS_HIDC = WS_HIDL + al((size_t)DEPTH * SEQ * FH * 4);
constexpr size_t WS_ROPE = WS_HIDC + al((size_t)DEPTH * CTX * FH * 4);
constexpr size_t WS_FLT = WS_ROPE + al((size_t)64 * 32 * 2 * 4);
constexpr size_t WS_FLTC = WS_FLT + al((size_t)DEPTH * 4 * HY * SEQ * 4);
constexpr size_t WS_WIN = WS_FLTC + al((size_t)DEPTH * 4 * HY * CTX * 4);
constexpr size_t WS_WOUT = WS_WIN + al((size_t)DEPTH * INW * D * 2);
constexpr size_t WS_WGU = WS_WOUT + al((size_t)DEPTH * D * D * 2);
constexpr size_t WS_WD = WS_WGU + al((size_t)DEPTH * GU * D * 2);
constexpr size_t WS_END = WS_WD + al((size_t)DEPTH * D * FF * 2);
constexpr int CW_BAR = 4096;

constexpr int RING_BYTES = 135168  , MISC_OFF = RING_BYTES + 320, LDS_BYTES = RING_BYTES + 4096;

__device__ __forceinline__ unsigned f2bf(float f) { unsigned u = __builtin_bit_cast(unsigned, f); return (u + 0x7fffu + ((u >> 16) & 1u)) >> 16; }
__device__ __forceinline__ unsigned pk2(float lo, float hi) { return f2bf(lo) | (f2bf(hi) << 16); }
__device__ __forceinline__ float bf_lo(unsigned w) { return __builtin_bit_cast(float, w << 16); }
__device__ __forceinline__ float bf_hi(unsigned w) { return __builtin_bit_cast(float, w & 0xffff0000u); }
__device__ __forceinline__ float bf1(bf16_t b) { return __builtin_bit_cast(float, (unsigned)b << 16); }
__device__ __forceinline__ float wave_sum(float v) {
#pragma unroll
    for (int o = 1; o < 64; o <<= 1) v += __shfl_xor(v, o);
    return v;
}
__device__ __forceinline__ float wave_max(float v) {
#pragma unroll
    for (int o = 1; o < 64; o <<= 1) v = fmaxf(v, __shfl_xor(v, o));
    return v;
}
__device__ __forceinline__ int vec_of_panel(int pm) { return pm < 16 ? 0 : (pm < 32 ? 1 : 2); }
__device__ __forceinline__ int vec_of_row(int row) { return row < SEQ ? 0 : (row < ML ? 1 : 2); }
__host__ __device__ __forceinline__ int qk_dim(int j) { const int wc = j >> 5, fq = (j >> 3) & 3, n = (j >> 2) & 1, e = j & 3, idx = wc * 16 + fq * 4 + e; return (idx < 32 ? idx : idx + 32) + 32 * n; }

#define FRESH_IDS int lane_; MK_LANE_ASM(lane_); int wv_ = wave_s; asm volatile("" : "+s"(wv_)); const int lane = lane_, wave = wv_, tid = wv_ * 64 + lane_; (void)lane; (void)wave; (void)tid
struct Params {
    const float* in[26];
    float* out;
    unsigned char* ws;
    int ph_lo, ph_hi;
};
typedef __attribute__((address_space(4))) const Params* KP;
#define FRESH_KP KP Pp; { unsigned long long ki_ = (unsigned long long)__builtin_amdgcn_kernarg_segment_ptr(); asm volatile("" : "+s"(ki_)); Pp = (KP)ki_; }

__device__ __forceinline__ void load_rstd8(const float* ssq, int row0, int fq, float (&rs)[2][4]) {
#pragma unroll
    for (int ai = 0; ai < 2; ++ai)
#pragma unroll
        for (int m = 0; m < 4; ++m) {
            const int row = row0 + ai * HALF + m * 16;
            const f32x4 a = *(const f32x4*)(ssq + ((size_t)(2 * fq) * MT + row) * 4), b = *(const f32x4*)(ssq + ((size_t)(2 * fq + 1) * MT + row) * 4);
            float s = ((a[0] + a[1]) + (a[2] + a[3])) + ((b[0] + b[1]) + (b[2] + b[3]));
            s += __shfl_xor(s, 16); s += __shfl_xor(s, 32);
            rs[ai][m] = 1.0f / sqrtf(s * (1.0f / D) + EPS);
        }
}

struct EpiIn {
    static constexpr bool PERM = true, AFTER_DRAIN = false;
    const float* ssq; const float* shw;
    bf16_t* PHY; bf16_t* Q; bf16_t* Kb; bf16_t* Vb; const float* rope;
    __device__ __forceinline__ void operator()(const f32x4 (&acc)[2][2][4][2], const Unit& u, int wr, int wc, int fr_, int fq_) const {
        int fr = fr_, fq = fq_; asm volatile("" : "+v"(fr), "+v"(fq));
        const int row0 = u.pm * BM + wr * 64 + fr, v = vec_of_panel(u.pm);
        float rs[2][4]; load_rstd8(ssq, row0, fq, rs);
        const int cpos = wc * 32 + 8 * fq;
        const int colb = u.pn * BM + cpos;
        f32x4 sh[2][2];
#pragma unroll
        for (int bj = 0; bj < 2; ++bj)
#pragma unroll
            for (int n = 0; n < 2; ++n) sh[bj][n] = *(const f32x4*)(shw + (size_t)v * INW + colb + bj * HALF + 4 * n);
        if (u.pn < 12) {
#pragma unroll
            for (int ai = 0; ai < 2; ++ai)
#pragma unroll
                for (int m = 0; m < 4; ++m) { const int row = row0 + ai * HALF + m * 16; const float r = rs[ai][m];
#pragma unroll
                    for (int bj = 0; bj < 2; ++bj)
#pragma unroll
                        for (int n = 0; n < 2; ++n) { const f32x4 x = acc[ai][bj][m][n] * r + sh[bj][n];
                            u32x2 w; w.x = pk2(x[0], x[1]); w.y = pk2(x[2], x[3]);
                            const int cg = (colb + bj * HALF) / 4 + n;
                            *(u32x2*)(PHY + ((size_t)cg * MT + row) * 4) = w; } }
        } else if (u.pn < 17) {
            const bool isq = u.pn < 16, latent = u.pm < 32;
            const int axis = wc >> 1, p0 = (wc * 16 + fq * 4) & 31;
            const float qs = isq ? QSCALE : 1.0f;
#pragma unroll
            for (int ai = 0; ai < 2; ++ai)
#pragma unroll
                for (int m = 0; m < 4; ++m) { const int row = row0 + ai * HALF + m * 16; const float r = rs[ai][m];
                    const int l = row & (SEQ - 1), pos = axis ? (l & 63) : (l >> 6);
                    f32x4 t0 = (f32x4){1.f, 0.f, 1.f, 0.f}, t1 = t0;
                    if (latent) { const f32x4* tp = (const f32x4*)(rope + ((size_t)pos * 32 + p0) * 2); t0 = tp[0]; t1 = tp[1]; }
                    const float cs[4] = {t0[0], t0[2], t1[0], t1[2]}, sn[4] = {t0[1], t0[3], t1[1], t1[3]};
#pragma unroll
                    for (int bj = 0; bj < 2; ++bj) { const f32x4 a = acc[ai][bj][m][0] * r + sh[bj][0], b = acc[ai][bj][m][1] * r + sh[bj][1];
                        float ra[4], rb[4];
#pragma unroll
                        for (int e = 0; e < 4; ++e) { ra[e] = (a[e] * cs[e] - b[e] * sn[e]) * qs; rb[e] = (a[e] * sn[e] + b[e] * cs[e]) * qs; }
                        u32x4 w; w.x = pk2(ra[0], ra[1]); w.y = pk2(ra[2], ra[3]); w.z = pk2(rb[0], rb[1]); w.w = pk2(rb[2], rb[3]);
                        bf16_t* dst = isq ? Q + (size_t)row * ATTW + (u.pn - 12) * BM + bj * HALF + cpos : Kb + (size_t)row * KVW + bj * HALF + cpos;
                        *(u32x4*)dst = w; } }
        } else {
#pragma unroll
            for (int ai = 0; ai < 2; ++ai)
#pragma unroll
                for (int m = 0; m < 4; ++m) { const int row = row0 + ai * HALF + m * 16; const float r = rs[ai][m];
#pragma unroll
                    for (int bj = 0; bj < 2; ++bj) { const f32x4 a = acc[ai][bj][m][0] * r + sh[bj][0], b = acc[ai][bj][m][1] * r + sh[bj][1];
                        u32x4 w; w.x = pk2(a[0], a[1]); w.y = pk2(a[2], a[3]); w.z = pk2(b[0], b[1]); w.w = pk2(b[2], b[3]);
                        *(u32x4*)(Vb + (size_t)row * KVW + bj * HALF + cpos) = w; } }
        }
    }
};

struct EpiOutA {
    static constexpr bool PERM = true, AFTER_DRAIN = false;
    float* X; const float* gate;
    const float* sshy;
    __device__ __forceinline__ void operator()(const f32x4 (&acc)[2][2][4][2], const Unit& u, int wr, int wc, int fr_, int fq_) const {
        int fr = fr_, fq = fq_; asm volatile("" : "+v"(fr), "+v"(fq));
        const int row0 = u.pm * BM + wr * 64 + fr, v = vec_of_panel(u.pm);
        const int colb = u.pn * BM + wc * 32 + 8 * fq;
        f32x4 gt[2][2];
#pragma unroll
        for (int bj = 0; bj < 2; ++bj)
#pragma unroll
            for (int n = 0; n < 2; ++n) gt[bj][n] = *(const f32x4*)(gate + (size_t)v * 6 * D + colb + bj * HALF + 4 * n);
#pragma unroll
        for (int ai = 0; ai < 2; ++ai)
#pragma unroll
            for (int m = 0; m < 4; ++m) { const int row = row0 + ai * HALF + m * 16;
                const float r = 1.0f / sqrtf(sshy[row] * (1.0f / HY) + EPS);
                float* xr = X + (size_t)row * D + colb;
#pragma unroll
                for (int bj = 0; bj < 2; ++bj)
#pragma unroll
                    for (int n = 0; n < 2; ++n) { f32x4* px = (f32x4*)(xr + bj * HALF + 4 * n); *px = *px + gt[bj][n] * (acc[ai][bj][m][n] * r); } }
    }
};

struct EpiResid {
    static constexpr bool PERM = true, AFTER_DRAIN = false;
    float* X; const float* gate; const float* gnext  ; bf16_t* AN; float* ssq;
    __device__ __forceinline__ void operator()(const f32x4 (&acc)[2][2][4][2], const Unit& u, int wr, int wc, int fr_, int fq_) const {
        int fr = fr_, fq = fq_; asm volatile("" : "+v"(fr), "+v"(fq));
        const int row0 = u.pm * BM + wr * 64 + fr, v = vec_of_panel(u.pm);
        const int colb = u.pn * BM + wc * 32 + 8 * fq;
        f32x4 gt[2][2], gn[2][2];
#pragma unroll
        for (int bj = 0; bj < 2; ++bj)
#pragma unroll
            for (int n = 0; n < 2; ++n) { gt[bj][n] = *(const f32x4*)(gate + (size_t)v * 6 * D + colb + bj * HALF + 4 * n);
                gn[bj][n] = gnext ? *(const f32x4*)(gnext + (size_t)v * D + colb + bj * HALF + 4 * n) : (f32x4){0.f, 0.f, 0.f, 0.f}; }
#pragma unroll
        for (int ai = 0; ai < 2; ++ai)
#pragma unroll
            for (int m = 0; m < 4; ++m) { const int row = row0 + ai * HALF + m * 16;
                float* xr = X + (size_t)row * D + colb; float s = 0.f;
#pragma unroll
                for (int bj = 0; bj < 2; ++bj) { f32x4 x[2];
#pragma unroll
                    for (int n = 0; n < 2; ++n) { f32x4* px = (f32x4*)(xr + bj * HALF + 4 * n); x[n] = *px + gt[bj][n] * acc[ai][bj][m][n]; *px = x[n];
                        s += (x[n][0] * x[n][0] + x[n][1] * x[n][1]) + (x[n][2] * x[n][2] + x[n][3] * x[n][3]); }
                    if (gnext) { const f32x4 a = x[0] * gn[bj][0], b = x[1] * gn[bj][1];
                        u32x4 w; w.x = pk2(a[0], a[1]); w.y = pk2(a[2], a[3]); w.z = pk2(b[0], b[1]); w.w = pk2(b[2], b[3]);
                        *(u32x4*)(AN + (size_t)row * D + colb + bj * HALF) = w; } }
                s += __shfl_xor(s, 16); s += __shfl_xor(s, 32);
                if (fq == 0) ssq[((size_t)u.pn * MT + row) * 4 + wc] = s; }
    }
};

struct EpiGU {
    static constexpr bool PERM = true, AFTER_DRAIN = false;
    const float* ssq; const float* shw;
    bf16_t* HB;
    __device__ __forceinline__ void operator()(const f32x4 (&acc)[2][2][4][2], const Unit& u, int wr, int wc, int fr_, int fq_) const {
        int fr = fr_, fq = fq_; asm volatile("" : "+v"(fr), "+v"(fq));
        const int row0 = u.pm * BM + wr * 64 + fr, v = vec_of_panel(u.pm);
        float rs[2][4]; load_rstd8(ssq, row0, fq, rs);
        const int colb = u.pn * BM + wc * 32 + 8 * fq;
        f32x4 sh[2][2];
#pragma unroll
        for (int bj = 0; bj < 2; ++bj)
#pragma unroll
            for (int n = 0; n < 2; ++n) sh[bj][n] = *(const f32x4*)(shw + (size_t)v * GU + colb + bj * HALF + 4 * n);
#pragma unroll
        for (int ai = 0; ai < 2; ++ai)
#pragma unroll
            for (int m = 0; m < 4; ++m) { const int row = row0 + ai * HALF + m * 16; const float r = rs[ai][m];
#pragma unroll
                for (int bj = 0; bj < 2; ++bj) { const f32x4 g = acc[ai][bj][m][0] * r + sh[bj][0], up = acc[ai][bj][m][1] * r + sh[bj][1];
                    float h[4];
#pragma unroll
                    for (int e = 0; e < 4; ++e) h[e] = g[e] * __builtin_amdgcn_rcpf(1.0f + __builtin_amdgcn_exp2f(-g[e] * LOG2E)) * up[e];
                    u32x2 w; w.x = pk2(h[0], h[1]); w.y = pk2(h[2], h[3]);
                    const int ff = (colb + bj * HALF) >> 1;
                    *(u32x2*)(HB + (size_t)row * FF + ff) = w; } }
    }
};

template <class RowMap>
__device__ __forceinline__ void transpose_item(const float* W, int K, int N, bf16_t* WT, LAS float* scr, int item, int lane, const RowMap& rm) {
    const int nblk = N / 32, kb = item / nblk, nb = item % nblk, k0 = 64 * kb, n0 = 32 * nb;
#pragma unroll 8
    for (int i = 0; i < 32; ++i) { const int kk = 2 * i + (lane >> 5); scr[kk * 33 + (lane & 31)] = W[(size_t)(k0 + kk) * N + n0 + (lane & 31)]; }
    asm volatile("s_waitcnt lgkmcnt(0)" ::: "memory");
    const int c = lane & 7;
#pragma unroll
    for (int j = 0; j < 4; ++j) { const int n = (lane >> 3) + 8 * j; const LAS float* s = scr + (8 * c) * 33 + n;
        u32x4 o; o.x = pk2(s[0 * 33], s[1 * 33]); o.y = pk2(s[2 * 33], s[3 * 33]); o.z = pk2(s[4 * 33], s[5 * 33]); o.w = pk2(s[6 * 33], s[7 * 33]);
        *(u32x4*)(WT + (size_t)rm(n0 + n) * K + k0 + 8 * c) = o; }
    asm volatile("s_waitcnt lgkmcnt(0)" ::: "memory");
}
struct MapId { __device__ __forceinline__ int operator()(int n) const { return n; } };
struct MapIn { __device__ __forceinline__ int operator()(int n) const {
    if (n < 3 * HY || n >= 3 * HY + ATTW + KVW) return n;
    const int h0 = (n - 3 * HY) & ~127, d = (n - 3 * HY) & 127;
    const int nn = (d >> 5) & 1, base = d - 32 * nn, idx = base < 32 ? base : base - 32, wc = idx >> 4, fq = (idx >> 2) & 3, e = idx & 3;
    return 3 * HY + h0 + 32 * wc + 8 * fq + 4 * nn + e; } };
struct MapGU { int up; __device__ __forceinline__ int operator()(int n) const { return (n >> 2) * 8 + up * 4 + (n & 3); } };

__device__ __forceinline__ float silu_acc(float v) { return v / (1.f + expf(-v)); }

__device__ __forceinline__ void p0a(LAS unsigned char* lds, int G, const int wave_s) {
    FRESH_IDS; FRESH_KP;
    unsigned char* ws = Pp->ws;
    const int gw = blockIdx.x * NWAVES + wave, NGW = G * NWAVES;
    const int gt = blockIdx.x * NTHR + tid, NGT = G * NTHR;
    { const f32x4* xs = (const f32x4*)Pp->in[0]; const f32x4* cs = (const f32x4*)Pp->in[2]; f32x4* X = (f32x4*)(ws + WS_X);
      const int nl = ML * D / 4, nt = MT * D / 4;
      for (int i = gt; i < nt; i += NGT) X[i] = i < nl ? xs[i] : cs[i - nl]; }
    { float* rope = (float*)(ws + WS_ROPE);
      for (int i = gt; i < 64 * 32; i += NGT) { const int pos = i >> 5, p = i & 31; const float inv = powf(10000.f, -(float)p / 32.f); const float ang = (float)pos * inv; rope[2 * i] = cosf(ang); rope[2 * i + 1] = sinf(ang); }
    }
    LAS float* SV = (LAS float*)(lds + 98304);
    for (int i = tid; i < 3 * D; i += NTHR) SV[i] = silu_acc(i < 2 * D ? Pp->in[1][i] : Pp->in[3][i - 2 * D]);
    __syncthreads();
    { float* MODP = (float*)(ws + WS_MODP);
      constexpr int KCH = D / MOD_KC, NCH = 6 * D / 256, NIT = DEPTH * NCH * MOD_KC;
      for (int it = gw; it < NIT; it += NGW) {
          const int kc = it % MOD_KC, nc = (it / MOD_KC) % NCH, layer = it / (MOD_KC * NCH);
          const float* W = Pp->in[6] + (size_t)layer * D * 6 * D + (size_t)(kc * KCH) * 6 * D + nc * 256 + lane * 4;
          f32x4 a0 = {0.f, 0.f, 0.f, 0.f}, a1 = a0, a2 = a0;
#pragma unroll 8
          for (int k = 0; k < KCH; ++k) { const f32x4 w = *(const f32x4*)(W + (size_t)k * 6 * D); const int kk = kc * KCH + k;
              a0 += w * SV[kk]; a1 += w * SV[D + kk]; a2 += w * SV[2 * D + kk]; }
          float* o = MODP + ((size_t)(kc * DEPTH + layer) * 3) * 6 * D + nc * 256 + lane * 4;
          *(f32x4*)o = a0; *(f32x4*)(o + 6 * D) = a1; *(f32x4*)(o + 12 * D) = a2; } }
    { for (int it = gw; it < DEPTH * (SEQ + CTX); it += NGW) {
          const int layer = it / (SEQ + CTX), r = it % (SEQ + CTX); const bool isc = r >= SEQ; const int l = isc ? r - SEQ : r, L = isc ? CTX : SEQ;
          const float* w1 = Pp->in[11] + (size_t)layer * FE * FH; const float* b1 = Pp->in[12] + layer * FH; const float* w2 = Pp->in[13] + (size_t)layer * FH * FH; const float* b2 = Pp->in[14] + layer * FH; const float* fr = Pp->in[16] + layer * FH;
          float emb = 0.f;
          if (lane < FE) { const float t = (float)l / (float)(L - 1); const float w = (2.0f * 3.14159265358979323846f / (float)L) * (float)l;
              if (lane == 0) emb = t; else { const int bi = (lane - 1) & 15; const float band = 1e-4f + (float)bi * ((15.0f - 1e-4f) / 15.0f); emb = lane <= 16 ? cosf(band * w) : -sinf(band * w); } }
          float a = b1[lane];
          for (int j = 0; j < FE; ++j) a += __shfl(emb, j) * w1[j * FH + lane];
          const float h1 = sinf(fr[lane] * a);
          float c = b2[lane];
          for (int j = 0; j < FH; ++j) c += __shfl(h1, j) * w2[j * FH + lane];
          float* dst = isc ? (float*)(ws + WS_HIDC) + ((size_t)layer * CTX + l) * FH : (float*)(ws + WS_HIDL) + ((size_t)layer * SEQ + l) * FH;
          dst[lane] = sinf(fr[lane] * c); } }
    { LAS float* scr = (LAS float*)(lds + wave * 8704);
      constexpr int I_IN = (D / 64) * (INW / 32), I_OUT = (D / 64) * (D / 32), I_G = (D / 64) * (FF / 32), I_D = (FF / 64) * (D / 32);
      constexpr int PER = I_IN + I_OUT + 2 * I_G + I_D;
      for (int it = gw; it < DEPTH * PER; it += NGW) {
          const int layer = it / PER; int r = it % PER;
          if (r < I_IN) { transpose_item(Pp->in[8] + (size_t)layer * D * INW, D, INW, (bf16_t*)(ws + WS_WIN) + (size_t)layer * INW * D, scr, r, lane, MapIn{}); continue; } r -= I_IN;
          if (r < I_OUT) { transpose_item(Pp->in[21] + (size_t)layer * D * D, D, D, (bf16_t*)(ws + WS_WOUT) + (size_t)layer * D * D, scr, r, lane, MapId{}); continue; } r -= I_OUT;
          if (r < I_G) { transpose_item(Pp->in[22] + (size_t)layer * D * FF, D, FF, (bf16_t*)(ws + WS_WGU) + (size_t)layer * GU * D, scr, r, lane, MapGU{0}); continue; } r -= I_G;
          if (r < I_G) { transpose_item(Pp->in[23] + (size_t)layer * D * FF, D, FF, (bf16_t*)(ws + WS_WGU) + (size_t)layer * GU * D, scr, r, lane, MapGU{1}); continue; } r -= I_G;
          transpose_item(Pp->in[24] + (size_t)layer * FF * D, FF, D, (bf16_t*)(ws + WS_WD) + (size_t)layer * D * FF, scr, r, lane, MapId{}); } }
}

__device__ __forceinline__ void p0b(int G, const int wave_s) {
    FRESH_IDS; FRESH_KP;
    unsigned char* ws = Pp->ws; const int gt = blockIdx.x * NTHR + tid, NGT = G * NTHR;
    const float* MODP = (const float*)(ws + WS_MODP); float* MOD = (float*)(ws + WS_MOD);
    constexpr int NTOT = DEPTH * 3 * 6 * D;
    for (int i = gt; i < NTOT; i += NGT) { const int layer = i / (3 * 6 * D), n = i % (6 * D); float s = Pp->in[7][(size_t)layer * 6 * D + n];
#pragma unroll
        for (int kc = 0; kc < MOD_KC; ++kc) { const int rest = i % (3 * 6 * D); s += MODP[((size_t)(kc * DEPTH + layer) * 3) * 6 * D + rest]; }
        MOD[i] = s; }
}

__device__ __forceinline__ void p0c(LAS unsigned char* lds, int G, const int wave_s) {
    FRESH_IDS; FRESH_KP;
    unsigned char* ws = Pp->ws;
    const int gw = blockIdx.x * NWAVES + wave, NGW = G * NWAVES;
    const int gt = blockIdx.x * NTHR + tid, NGT = G * NTHR;
    const float* MOD = (const float*)(ws + WS_MOD);
    { float* GMV = (float*)(ws + WS_GMV);
      for (int i = gt; i < DEPTH * 2 * 3 * D; i += NGT) { const int c = i % D, v = (i / D) % 3, which = (i / (3 * D)) % 2, layer = i / (6 * D);
          const float g = which ? Pp->in[5][layer * D + c] : Pp->in[4][layer * D + c];
          GMV[i] = g * (1.0f + MOD[((size_t)layer * 3 + v) * 6 * D + (which ? 4 : 1) * D + c]); } }
    { constexpr int PER = (INW + GU) / 32;
      for (int it = gw; it < DEPTH * PER; it += NGW) { const int layer = it / PER, r0 = (it % PER) * 32; const bool isin = r0 < INW;
          const bf16_t* wbase = isin ? (const bf16_t*)(ws + WS_WIN) + ((size_t)layer * INW + r0) * D : (const bf16_t*)(ws + WS_WGU) + ((size_t)layer * GU + (r0 - INW)) * D;
          const float* sh = MOD + (size_t)layer * 3 * 6 * D + (isin ? 0 : 3) * D;
          float k0 = 0.f, k1 = 0.f, k2 = 0.f;
#pragma nounroll
          for (int rr = 0; rr < 32; ++rr) { const bf16_t* wrow = wbase + (size_t)rr * D;
              float a0 = 0.f, a1 = 0.f, a2 = 0.f;
#pragma unroll
              for (int j = 0; j < 4; ++j) { const int k = lane * 8 + 512 * j; const u32x4 w = *(const u32x4*)(wrow + k);
                  const float wf[8] = {bf_lo(w.x), bf_hi(w.x), bf_lo(w.y), bf_hi(w.y), bf_lo(w.z), bf_hi(w.z), bf_lo(w.w), bf_hi(w.w)};
#pragma unroll
                  for (int e = 0; e < 8; ++e) { a0 += wf[e] * sh[k + e]; a1 += wf[e] * sh[6 * D + k + e]; a2 += wf[e] * sh[12 * D + k + e]; } }
              a0 = wave_sum(a0); a1 = wave_sum(a1); a2 = wave_sum(a2);
              if (lane == rr) { k0 = a0; k1 = a1; k2 = a2; } }
          if (lane < 32) { float* o = isin ? (float*)(ws + WS_SHWIN) + (size_t)layer * 3 * INW + r0 + lane : (float*)(ws + WS_SHWGU) + (size_t)layer * 3 * GU + (r0 - INW) + lane;
              const int st = isin ? INW : GU; o[0] = k0; o[st] = k1; o[2 * st] = k2; } } }
    { const float* X = (const float*)(ws + WS_X); bf16_t* AN = (bf16_t*)(ws + WS_AN); float* SSQ = (float*)(ws + WS_SSQ);
      for (int row = gw; row < MT; row += NGW) { const int v = vec_of_row(row); const float* xr = X + (size_t)row * D; float s = 0.f;
#pragma unroll
          for (int j = 0; j < 4; ++j) { const int c = lane * 8 + 512 * j; const f32x4 a = *(const f32x4*)(xr + c), b = *(const f32x4*)(xr + c + 4);
              s += (a[0] * a[0] + a[1] * a[1]) + (a[2] * a[2] + a[3] * a[3]) + (b[0] * b[0] + b[1] * b[1]) + (b[2] * b[2] + b[3] * b[3]);
              float gm[8];
#pragma unroll
              for (int e = 0; e < 8; ++e) gm[e] = Pp->in[4][c + e] * (1.0f + MOD[(size_t)v * 6 * D + 1 * D + c + e]);
              u32x4 w; w.x = pk2(a[0] * gm[0], a[1] * gm[1]); w.y = pk2(a[2] * gm[2], a[3] * gm[3]); w.z = pk2(b[0] * gm[4], b[1] * gm[5]); w.w = pk2(b[2] * gm[6], b[3] * gm[7]);
              *(u32x4*)(AN + (size_t)row * D + c) = w; }
          s = wave_sum(s);
          if (lane < 32) SSQ[((size_t)(lane >> 2) * MT + row) * 4 + (lane & 3)] = lane == 0 ? s : 0.f; } }
    { constexpr int CB = HY / 8, IT_L = (SEQ / 512) * CB, IT_C = CB, PER = IT_L + IT_C;
      for (int it = blockIdx.x; it < DEPTH * PER; it += G) {
          const int layer = it / PER; int r = it % PER; const bool isc = r >= IT_L; if (isc) r -= IT_L;
          const int cb = r % CB, lb = r / CB, c0 = cb * 8, L = isc ? CTX : SEQ, l = lb * 512 + tid;
          const float* w3 = Pp->in[15] + (size_t)layer * FH * 4096 + c0;
          if (l < L) {
              const float* hp = (isc ? (const float*)(ws + WS_HIDC) + ((size_t)layer * CTX + l) * FH : (const float*)(ws + WS_HIDL) + ((size_t)layer * SEQ + l) * FH);
              float acc[4][8];
#pragma unroll
              for (int od = 0; od < 4; ++od)
#pragma unroll
                  for (int e = 0; e < 8; ++e) acc[od][e] = 0.f;
#pragma nounroll
              for (int k4 = 0; k4 < 16; ++k4) { const f32x4 h4 = *(const f32x4*)(hp + 4 * k4);
#pragma unroll
                  for (int kk = 0; kk < 4; ++kk) { const float* wk = w3 + (size_t)(4 * k4 + kk) * 4096;
#pragma unroll
                      for (int od = 0; od < 4; ++od)
#pragma unroll
                          for (int e = 0; e < 8; ++e) acc[od][e] += h4[kk] * wk[od * 1024 + e]; } }
              const float t = (float)l / (float)(L - 1);
              f32x2* tf = isc ? (f32x2*)(ws + WS_FLTC) + (size_t)layer * HY * CTX : (f32x2*)(ws + WS_FLT) + (size_t)layer * HY * SEQ;
              f32x2* tb = isc ? (f32x2*)(ws + WS_FLTC) + (size_t)(DEPTH + layer) * HY * CTX : (f32x2*)(ws + WS_FLT) + (size_t)(DEPTH + layer) * HY * SEQ;
#pragma unroll
              for (int e = 0; e < 8; ++e) { const int c = c0 + e;
                  const float dmin = -3.0701134573253945f, dmax = -15.350567286626973f;
                  const float delta = fabsf(dmin + (float)c * ((dmax - dmin) / 1023.f));
                  const float wdw = expf(-t * delta);
                  tf[(size_t)c * L + l] = (f32x2){acc[0][e] * wdw, acc[2][e] * wdw};
                  tb[(size_t)c * L + l] = l == 0 ? (f32x2){0.f, 0.f} : (f32x2){acc[1][e] * wdw, acc[3][e] * wdw}; }
          } } }
}

__device__ __forceinline__ void attn_simple(LAS unsigned char* lds, int layer, int G, int nrows, const int wave_s) {
    FRESH_IDS; FRESH_KP;
    unsigned char* ws = Pp->ws;
    const bf16_t* Q = (const bf16_t*)(ws + WS_Q); const bf16_t* Kb = (const bf16_t*)(ws + WS_K); const bf16_t* Vb = (const bf16_t*)(ws + WS_V);
    bf16_t* YM = (bf16_t*)(ws + WS_YM);
    LAS float* qs = (LAS float*)lds + wave * HD;
    LAS float* ps = (LAS float*)(lds + 4096) + wave * 640;
    LAS float* red = (LAS float*)(lds + 4096 + 8 * 640 * 4);
    const int h = wave, kv = h >> 2;
    const float sk = Pp->in[18][layer * NH + h] * LOG2E;
    const float* gat = Pp->in[20] + layer * ATTW; const float* ghy = Pp->in[19] + layer * HY; const float* ZT = (const float*)(ws + WS_SSHY);
    for (int row = blockIdx.x; row < nrows; row += G) {
        { const unsigned w = *(const unsigned*)(Q + (size_t)row * ATTW + h * HD + 2 * lane); qs[2 * lane] = bf_lo(w); qs[2 * lane + 1] = bf_hi(w); }
        int b, j0 = 0, nwin = 0;
        if (row < ML) { b = row / SEQ; const int l = row % SEQ; j0 = l - WINDOW < 0 ? 0 : l - WINDOW; const int j1 = l + WINDOW > SEQ - 1 ? SEQ - 1 : l + WINDOW; nwin = j1 - j0 + 1; }
        else b = (row - ML) / CTX;
        const int nk = nwin + CTX;
        float mx = -3.0e38f;
        for (int j = lane; j < nk; j += 64) {
            const int krow = j < nwin ? b * SEQ + j0 + j : ML + b * CTX + (j - nwin);
            const bf16_t* kr = Kb + (size_t)krow * KVW + kv * HD;
            float s = 0.f;
#pragma unroll
            for (int d = 0; d < HD; d += 8) { const u32x4 w = *(const u32x4*)(kr + d);
                s += qs[d] * bf_lo(w.x) + qs[d + 1] * bf_hi(w.x) + qs[d + 2] * bf_lo(w.y) + qs[d + 3] * bf_hi(w.y) + qs[d + 4] * bf_lo(w.z) + qs[d + 5] * bf_hi(w.z) + qs[d + 6] * bf_lo(w.w) + qs[d + 7] * bf_hi(w.w); }
            ps[j] = s; mx = fmaxf(mx, s);
        }
        mx = fmaxf(wave_max(mx), sk);
        float sum = 0.f;
        for (int j = lane; j < nk; j += 64) { const float e = __builtin_amdgcn_exp2f(ps[j] - mx); ps[j] = e; sum += e; }
        sum = wave_sum(sum) + __builtin_amdgcn_exp2f(sk - mx);
        float o0 = 0.f, o1 = 0.f;
        for (int j = 0; j < nk; ++j) {
            const int krow = j < nwin ? b * SEQ + j0 + j : ML + b * CTX + (j - nwin);
            const unsigned w = *(const unsigned*)(Vb + (size_t)krow * KVW + kv * HD + 2 * lane);
            const float pj = ps[j]; o0 += pj * bf_lo(w); o1 += pj * bf_hi(w);
        }
        const float inv = 1.f / sum; o0 *= inv; o1 *= inv;
        const float part = wave_sum(o0 * o0 + o1 * o1);
        const float z0 = ZT[(size_t)(2 * tid) * MT + row], z1 = ZT[(size_t)(2 * tid + 1) * MT + row];
        const float parth = wave_sum(z0 * z0 + z1 * z1);
        __syncthreads();
        if (lane == 0) { red[wave] = part; red[8 + wave] = parth; }
        __syncthreads();
        float tot = 0.f, toth = 0.f;
#pragma unroll
        for (int i = 0; i < 8; ++i) { tot += red[i]; toth += red[8 + i]; }
        const float r = 1.0f / sqrtf(tot * (1.0f / ATTW) + EPS), rh = 1.0f / sqrtf(toth * (1.0f / HY) + EPS);
        const int c = h * HD + 2 * lane;
        *(unsigned*)(YM + (size_t)row * D + HY + c) = pk2(o0 * r * gat[c], o1 * r * gat[c + 1]);
        *(unsigned*)(YM + (size_t)row * D + 2 * tid) = pk2(z0 * rh * ghy[2 * tid], z1 * rh * ghy[2 * tid + 1]);
    }
    __syncthreads();
}

__device__ __forceinline__ float phy_at(const bf16_t* PHY, int row, int ch) { return bf1(PHY[((size_t)(ch >> 2) * MT + row) * 4 + (ch & 3)]); }
__device__ __forceinline__ float sconv(const bf16_t* PHY, const float* cw, const float* cb, int row, int ch, int l, int L) {
    float a = cb[ch] + cw[3 * HY + ch] * phy_at(PHY, row, ch);
    if (l > 0) a += cw[ch] * phy_at(PHY, row - 1, ch);
    if (l < L - 1) a += cw[2 * 3 * HY + ch] * phy_at(PHY, row + 1, ch);
    return a;
}
template <int L>
__device__ __forceinline__ void hyena_direct(LAS unsigned char* lds, int layer, int G, int row_base, const int wave_s) {
    FRESH_IDS; FRESH_KP;
    unsigned char* ws = Pp->ws;
    constexpr int TPB = L < NTHR ? L : NTHR, NI = L / TPB;
    const bf16_t* PHY = (const bf16_t*)(ws + WS_PHY); float* ZT = (float*)(ws + WS_SSHY);
    const f32x2* TF = L == SEQ ? (const f32x2*)(ws + WS_FLT) + (size_t)layer * HY * SEQ : (const f32x2*)(ws + WS_FLTC) + (size_t)layer * HY * CTX;
    const f32x2* TB = L == SEQ ? (const f32x2*)(ws + WS_FLT) + (size_t)(DEPTH + layer) * HY * SEQ : (const f32x2*)(ws + WS_FLTC) + (size_t)(DEPTH + layer) * HY * CTX;
    const float* cw = Pp->in[9] + (size_t)layer * 3 * 3 * HY; const float* cb = Pp->in[10] + (size_t)layer * 3 * HY;
    const float* fbias = Pp->in[17] + (size_t)layer * 2 * HY;
    LAS float* G0 = (LAS float*)lds; LAS float* G1 = G0 + 2 * L; LAS float* z = G1 + 2 * L;
    for (int it = blockIdx.x; it < HY * BATCH; it += G) {
        const int c = it % HY, seq = it / HY, row0 = row_base + seq * L;
        __syncthreads();
#pragma nounroll
        for (int d = tid; d < L; d += NTHR) {
            { const f32x2 f = TF[(size_t)c * L + d]; G0[L - 1 + d] = f.x; G1[L - 1 + d] = f.y; }
            if (d > 0) { const f32x2 bk = TB[(size_t)c * L + d]; G0[L - 1 - d] = bk.x; G1[L - 1 - d] = bk.y; }
            z[d] = sconv(PHY, cw, cb, row0 + d, 2 * HY + c, d, L);
        }
        __syncthreads();
#pragma unroll
        for (int o = 0; o < 2; ++o) {
            LAS float* Gg = o ? G1 : G0;
            float acc[NI], zn[NI];
#pragma unroll
            for (int i = 0; i < NI; ++i) acc[i] = 0.f;
            if (tid < TPB) {
                for (int s = 0; s < L; ++s) { const float zs = z[s];
#pragma unroll
                    for (int i = 0; i < NI; ++i) acc[i] += zs * Gg[tid + TPB * i - s + L - 1]; }
                const float fb = fbias[o * HY + c];
#pragma nounroll
                for (int i = 0; i < NI; ++i) { const int t = tid + TPB * i; zn[i] = sconv(PHY, cw, cb, row0 + t, o * HY + c, t, L) * (acc[i] + fb * z[t]); }
            }
            __syncthreads();
            if (tid < TPB) {
#pragma unroll
                for (int i = 0; i < NI; ++i) z[tid + TPB * i] = zn[i];
            }
            __syncthreads();
        }
        if (tid < TPB) {
#pragma unroll
            for (int i = 0; i < NI; ++i) { const int t = tid + TPB * i; ZT[(size_t)c * MT + row0 + t] = z[t]; } }
    }
    __syncthreads();
}

constexpr int FN = 8192, FPAD = FN + FN / 32;
__device__ __forceinline__ int fpad(int p) { return p + (p >> 5); }
__device__ __forceinline__ f32x2 cmul(f32x2 a, f32x2 b) { return (f32x2){a.x * b.x - a.y * b.y, a.x * b.y + a.y * b.x}; }
__device__ __forceinline__ f32x2 cmulc(f32x2 a, f32x2 b) { return (f32x2){a.x * b.x + a.y * b.y, a.y * b.x - a.x * b.y}; }
template <bool INV> __device__ __forceinline__ f32x2 cmul_tw(f32x2 a, f32x2 w) { return INV ? cmulc(a, w) : cmul(a, w); }
template <bool INV> __device__ __forceinline__ void dft4(f32x2& x0, f32x2& x1, f32x2& x2, f32x2& x3) {
    const f32x2 t0 = x0 + x2, t1 = x0 - x2, t2 = x1 + x3, t3 = x1 - x3;
    const f32x2 jt3 = INV ? (f32x2){-t3.y, t3.x} : (f32x2){t3.y, -t3.x};
    x0 = t0 + t2; x2 = t0 - t2; x1 = t1 + jt3; x3 = t1 - jt3;
}
template <bool INV> __device__ __forceinline__ void dft16(f32x2 (&x)[16]) {
    constexpr float C1 = 0.92387953251128674f, S1 = 0.38268343236508977f, C2 = 0.70710678118654752f;
#pragma unroll
    for (int b = 0; b < 4; ++b) dft4<INV>(x[b], x[4 + b], x[8 + b], x[12 + b]);
    const f32x2 w1 = {C1, -S1}, w2 = {C2, -C2}, w3 = {S1, -C1}, w4 = {0.f, -1.f}, w6 = {-C2, -C2}, w9 = {-C1, S1};
    x[4 * 1 + 1] = cmul_tw<INV>(x[5], w1); x[4 * 1 + 2] = cmul_tw<INV>(x[6], w2); x[4 * 1 + 3] = cmul_tw<INV>(x[7], w3);
    x[4 * 2 + 1] = cmul_tw<INV>(x[9], w2); x[4 * 2 + 2] = cmul_tw<INV>(x[10], w4); x[4 * 2 + 3] = cmul_tw<INV>(x[11], w6);
    x[4 * 3 + 1] = cmul_tw<INV>(x[13], w3); x[4 * 3 + 2] = cmul_tw<INV>(x[14], w6); x[4 * 3 + 3] = cmul_tw<INV>(x[15], w9);
#pragma unroll
    for (int c = 0; c < 4; ++c) dft4<INV>(x[4 * c], x[4 * c + 1], x[4 * c + 2], x[4 * c + 3]);
    f32x2 y[16];
#pragma unroll
    for (int k = 0; k < 16; ++k) y[k] = x[4 * (k & 3) + (k >> 2)];
#pragma unroll
    for (int k = 0; k < 16; ++k) x[k] = y[k];
}
template <bool INV> __device__ __forceinline__ void dft32(f32x2 (&x)[32]) {
    constexpr float CS[16] = {1.f, 0.98078528040323043f, 0.92387953251128674f, 0.83146961230254524f, 0.70710678118654752f, 0.55557023301960218f, 0.38268343236508977f, 0.19509032201612825f,
                              0.f, -0.19509032201612825f, -0.38268343236508977f, -0.55557023301960218f, -0.70710678118654752f, -0.83146961230254524f, -0.92387953251128674f, -0.98078528040323043f};
    constexpr float SN[16] = {0.f, 0.19509032201612825f, 0.38268343236508977f, 0.55557023301960218f, 0.70710678118654752f, 0.83146961230254524f, 0.92387953251128674f, 0.98078528040323043f,
                              1.f, 0.98078528040323043f, 0.92387953251128674f, 0.83146961230254524f, 0.70710678118654752f, 0.55557023301960218f, 0.38268343236508977f, 0.19509032201612825f};
    f32x2 a[16], b[16];
#pragma unroll
    for (int j = 0; j < 16; ++j) { a[j] = x[j] + x[j + 16]; const f32x2 d = x[j] - x[j + 16]; b[j] = cmul_tw<INV>(d, (f32x2){CS[j], -SN[j]}); }
    dft16<INV>(a); dft16<INV>(b);
#pragma unroll
    for (int k = 0; k < 16; ++k) { x[2 * k] = a[k]; x[2 * k + 1] = b[k]; }
}
__device__ __forceinline__ void tw_powers(f32x2 w1, f32x2 (&w)[16]) {
    w[1] = w1; w[2] = cmul(w1, w1); w[3] = cmul(w[2], w1); w[4] = cmul(w[2], w[2]); w[5] = cmul(w[4], w1); w[6] = cmul(w[3], w[3]); w[7] = cmul(w[4], w[3]);
    w[8] = cmul(w[4], w[4]); w[9] = cmul(w[8], w1); w[10] = cmul(w[5], w[5]); w[11] = cmul(w[8], w[3]); w[12] = cmul(w[6], w[6]); w[13] = cmul(w[8], w[5]); w[14] = cmul(w[7], w[7]); w[15] = cmul(w[8], w[7]);
}
__device__ __forceinline__ f32x2 tw_base(float turns) { asm volatile("" : "+v"(turns)); return (f32x2){__builtin_amdgcn_cosf(turns), -__builtin_amdgcn_sinf(turns)}; }
__device__ __forceinline__ void fft_fwd1(f32x2 (&x)[16], LAS f32x2* B, int n2) {
    asm volatile("" : "+v"(n2));
    dft16<false>(x); f32x2 w[16]; tw_powers(tw_base((float)n2 * (1.0f / 8192.f)), w);
    B[fpad(n2)] = x[0];
#pragma unroll
    for (int k = 1; k < 16; ++k) B[fpad(512 * k + n2)] = cmul(x[k], w[k]);
}
__device__ __forceinline__ void fft_fwd2(LAS f32x2* B, int tid) {
    asm volatile("" : "+v"(tid));
    const int b = tid >> 5, n2 = tid & 31, base = 512 * b + n2; f32x2 x[16];
#pragma unroll
    for (int r = 0; r < 16; ++r) x[r] = B[fpad(base + 32 * r)];
    dft16<false>(x); f32x2 w[16]; tw_powers(tw_base((float)n2 * (1.0f / 512.f)), w);
    B[fpad(base)] = x[0];
#pragma unroll
    for (int k = 1; k < 16; ++k) B[fpad(base + 32 * k)] = cmul(x[k], w[k]);
}
__device__ __forceinline__ void fft_fwd3(LAS f32x2* B, int tid) {
    asm volatile("" : "+v"(tid));
    if (tid < 256) { f32x2 x[32]; LAS f32x2* p = B + 33 * tid;
#pragma unroll
        for (int j = 0; j < 32; ++j) x[j] = p[j];
        dft32<false>(x);
#pragma unroll
        for (int j = 0; j < 32; ++j) p[j] = x[j]; }
}
template <int ORD> __device__ __forceinline__ void fft_mid(LAS f32x2* B, const LAS f32x2* F, int tid) {
    asm volatile("" : "+v"(tid));
    if (tid < 256) { f32x2 x[32]; LAS f32x2* p = B + 33 * tid;
#pragma unroll
        for (int j = 0; j < 32; ++j) x[j] = p[j];
        __builtin_amdgcn_sched_barrier(0); dft32<false>(x); __builtin_amdgcn_sched_barrier(0);
        const int k1 = tid >> 4, k2 = tid & 15, kb1 = (16 - k1) & 15, b1 = k1 != 0 ? 1 : 0, kb2 = (16 - k2 - b1) & 15, b2 = (k2 != 0 || b1) ? 1 : 0;
        const LAS f32x2* fa = F + 33 * tid; const LAS f32x2* fb = F + 33 * (16 * kb1 + kb2); const LAS f32x2* fbq = fb + (1 - b2);
        constexpr float SC = 1.0f / (2.0f * (float)FN);
#pragma unroll
        for (int j = 0; j < 32; ++j) { const f32x2 A = fa[j], Bm = j == 0 ? (b2 ? fb[31] : fa[0]) : fbq[31 - j];
            const f32x2 H = ORD == 0 ? (f32x2){(A.x + Bm.x) * SC, (A.y - Bm.y) * SC} : (f32x2){(A.y + Bm.y) * SC, (Bm.x - A.x) * SC};
            x[j] = cmul(x[j], H); if ((j & 7) == 7) __builtin_amdgcn_sched_barrier(0); }
        dft32<true>(x); __builtin_amdgcn_sched_barrier(0);
#pragma unroll
        for (int j = 0; j < 32; ++j) p[j] = x[j]; }
}
__device__ __forceinline__ void fft_inv2(LAS f32x2* B, int tid) {
    asm volatile("" : "+v"(tid));
    const int b = tid >> 5, n2 = tid & 31, base = 512 * b + n2; f32x2 x[16]; f32x2 w[16]; tw_powers(tw_base((float)n2 * (1.0f / 512.f)), w);
    x[0] = B[fpad(base)];
#pragma unroll
    for (int k = 1; k < 16; ++k) x[k] = cmulc(B[fpad(base + 32 * k)], w[k]);
    dft16<true>(x);
#pragma unroll
    for (int r = 0; r < 16; ++r) B[fpad(base + 32 * r)] = x[r];
}
__device__ __forceinline__ void fft_inv1(f32x2 (&x)[16], const LAS f32x2* B, int n2) {
    asm volatile("" : "+v"(n2));
    f32x2 w[16]; tw_powers(tw_base((float)n2 * (1.0f / 8192.f)), w);
    x[0] = B[fpad(n2)];
#pragma unroll
    for (int k = 1; k < 16; ++k) x[k] = cmulc(B[fpad(512 * k + n2)], w[k]);
    dft16<true>(x);
}
#define WG_SYNC() do { asm volatile("s_waitcnt lgkmcnt(0)" ::: "memory"); __builtin_amdgcn_s_barrier(); asm volatile("" ::: "memory"); } while (0)
__device__ __forceinline__ void hy_stage(LAS float* plane, const bf16_t* PHY, int cg, int jc, int tid) {
    asm volatile("" : "+v"(tid));
    const u32x4* src = (const u32x4*)(PHY + (size_t)cg * MT * 4);
#pragma unroll
    for (int k = 0; k < 8; ++k) { const int i = tid + 512 * k; const u32x4 v = src[i];
        const unsigned w0 = (jc & 2) ? v.y : v.x, w1 = (jc & 2) ? v.w : v.z;
        f32x2 o; o.x = (jc & 1) ? bf_hi(w0) : bf_lo(w0); o.y = (jc & 1) ? bf_hi(w1) : bf_lo(w1);
        *(LAS f32x2*)(plane + 2 * i) = o; }
}
__device__ __forceinline__ void hy_sconv(const LAS float* plane, float w0, float w1, float w2, float cb, int n2, float (&u)[8][2]) {
    asm volatile("" : "+v"(n2));
#pragma unroll
    for (int r = 0; r < 8; ++r)
#pragma unroll
        for (int b = 0; b < 2; ++b) { const int t = n2 + 512 * r, row = b * SEQ + t;
            float a = cb + w1 * plane[row];
            if (t > 0) a += w0 * plane[row - 1];
            if (t < SEQ - 1) a += w2 * plane[row + 1];
            u[r][b] = a; }
}
__device__ __forceinline__ void hyena_fft(LAS unsigned char* lds, int layer, int G, const int wave_s) {
    FRESH_IDS; FRESH_KP;
    unsigned char* ws = Pp->ws;
    const bf16_t* PHY = (const bf16_t*)(ws + WS_PHY); float* ZT = (float*)(ws + WS_SSHY);
    const f32x2* TF = (const f32x2*)(ws + WS_FLT) + (size_t)layer * HY * SEQ; const f32x2* TB = (const f32x2*)(ws + WS_FLT) + (size_t)(DEPTH + layer) * HY * SEQ;
    const float* cw = Pp->in[9] + (size_t)layer * 3 * 3 * HY; const float* cb = Pp->in[10] + (size_t)layer * 3 * HY; const float* fbias = Pp->in[17] + (size_t)layer * 2 * HY;
    LAS f32x2* Db = (LAS f32x2*)lds; LAS f32x2* Fb = Db + FPAD;
    LAS float* pl0 = (LAS float*)lds; LAS float* pl1 = pl0 + 2 * SEQ;
    const int n2 = tid;
    for (int unit = blockIdx.x; unit < HY / 4; unit += G) {
#pragma nounroll
        for (int jc = 0; jc < 4; ++jc) { const int c = 4 * unit + jc;
            WG_SYNC();
            { f32x2 x[16]; const f32x2* tf = TF + (size_t)c * SEQ; const f32x2* tb = TB + (size_t)c * SEQ;
#pragma unroll
              for (int r = 0; r < 8; ++r) x[r] = tf[n2 + 512 * r];
#pragma unroll
              for (int r = 8; r < 16; ++r) { const int l = FN - 512 * r - n2; x[r] = l < SEQ ? tb[l] : (f32x2){0.f, 0.f}; }
              __builtin_amdgcn_sched_barrier(0); fft_fwd1(x, Fb, n2); __builtin_amdgcn_sched_barrier(0); }
            hy_stage(pl0, PHY, 2 * (HY / 4) + unit, jc, tid); __builtin_amdgcn_sched_barrier(0); hy_stage(pl1, PHY, unit, jc, tid); __builtin_amdgcn_sched_barrier(0);
            WG_SYNC();
            float uz[8][2], ux[8][2];
            hy_sconv(pl0, cw[2 * HY + c], cw[3 * HY + 2 * HY + c], cw[6 * HY + 2 * HY + c], cb[2 * HY + c], n2, uz);
            __builtin_amdgcn_sched_barrier(0); hy_sconv(pl1, cw[c], cw[3 * HY + c], cw[6 * HY + c], cb[c], n2, ux); __builtin_amdgcn_sched_barrier(0);
            fft_fwd2(Fb, tid); __builtin_amdgcn_sched_barrier(0);
            WG_SYNC();
            fft_fwd3(Fb, tid); __builtin_amdgcn_sched_barrier(0);
            f32x2 x[16];
#pragma unroll
            for (int r = 0; r < 8; ++r) { x[r] = (f32x2){uz[r][0], uz[r][1]}; x[r + 8] = (f32x2){0.f, 0.f}; }
            fft_fwd1(x, Db, n2); WG_SYNC(); fft_fwd2(Db, tid); WG_SYNC(); fft_mid<0>(Db, Fb, tid); WG_SYNC(); fft_inv2(Db, tid); WG_SYNC(); fft_inv1(x, Db, n2);
            { const float fb0 = fbias[c];
#pragma unroll
              for (int r = 0; r < 8; ++r) { uz[r][0] = ux[r][0] * (x[r].x + fb0 * uz[r][0]); uz[r][1] = ux[r][1] * (x[r].y + fb0 * uz[r][1]); } }
            WG_SYNC();
            hy_stage(pl0, PHY, (HY / 4) + unit, jc, tid);
            WG_SYNC();
            hy_sconv(pl0, cw[HY + c], cw[3 * HY + HY + c], cw[6 * HY + HY + c], cb[HY + c], n2, ux);
            WG_SYNC();
#pragma unroll
            for (int r = 0; r < 8; ++r) { x[r] = (f32x2){uz[r][0], uz[r][1]}; x[r + 8] = (f32x2){0.f, 0.f}; }
            fft_fwd1(x, Db, n2); WG_SYNC(); fft_fwd2(Db, tid); WG_SYNC(); fft_mid<1>(Db, Fb, tid); WG_SYNC(); fft_inv2(Db, tid); WG_SYNC(); fft_inv1(x, Db, n2);
            { const float fb1 = fbias[HY + c]; float* zo = ZT + (size_t)c * MT;
#pragma unroll
              for (int r = 0; r < 8; ++r) { const int t = n2 + 512 * r;
                  zo[t] = ux[r][0] * (x[r].x + fb1 * uz[r][0]); zo[SEQ + t] = ux[r][1] * (x[r].y + fb1 * uz[r][1]); } }
        }
    }
    WG_SYNC();
}

__device__ __forceinline__ void final_norm(int G, const int wave_s) {
    FRESH_IDS; FRESH_KP;
    unsigned char* ws = Pp->ws; const int gw = blockIdx.x * NWAVES + wave, NGW = G * NWAVES;
    const float* X = (const float*)(ws + WS_X); const float* SSQ = (const float*)(ws + WS_SSQ); const float* g = Pp->in[25];
    for (int row = gw; row < ML; row += NGW) {
        const float s = wave_sum(lane < 32 ? SSQ[((size_t)(lane >> 2) * MT + row) * 4 + (lane & 3)] : 0.f);
        const float r = 1.0f / sqrtf(s * (1.0f / D) + EPS);
#pragma unroll
        for (int j = 0; j < 8; ++j) { const int c = lane * 4 + 256 * j; const f32x4 x = *(const f32x4*)(X + (size_t)row * D + c), gg = *(const f32x4*)(g + c);
            *(f32x4*)(Pp->out + (size_t)row * D + c) = x * r * gg; }
    }
}

constexpr int NPHASE = 3 + 6 * DEPTH + 1;
__global__ void __launch_bounds__(NTHR, 2) mk_fwd(Params P) {
    extern __shared__ __attribute__((aligned(16))) unsigned char lds_raw[];
    LAS unsigned char* lds = (LAS unsigned char*)lds_raw;
    const int tid = threadIdx.x, G = gridDim.x, wave_s = __builtin_amdgcn_readfirstlane(tid >> 6);
    unsigned char* ws; int lo, hi; { FRESH_KP; ws = Pp->ws; lo = Pp->ph_lo; hi = Pp->ph_hi; }
    volatile LAS unsigned* MISC = (volatile LAS unsigned*)(lds + MISC_OFF);
    for (int u = tid; u < (LDS_BYTES - RING_BYTES) / 4; u += NTHR) ((LAS unsigned*)(lds + RING_BYTES))[u] = 0u;
    __syncthreads();
    XcdBarrier bar = xcd_barrier_post((unsigned*)(ws + WS_CTL) + CW_BAR, MISC + 8);
#define IN(k) (lo <= (k) && (k) < hi)
#define SEAM(k) do { if (IN(k) && IN((k) + 1)) xcd_barrier(bar, wave_s); } while (0)

    if (IN(0)) { p0a(lds, G, wave_s); } SEAM(0);
    if (IN(1)) { p0b(G, wave_s); } SEAM(1);
    if (IN(2)) { p0c(lds, G, wave_s); } SEAM(2);

    for (int layer = 0; layer < DEPTH; ++layer) {
        const int pb = 3 + 6 * layer;
#define WSL FRESH_KP; unsigned char* w = Pp->ws; const float* MODL = (const float*)(w + WS_MOD) + (size_t)layer * 3 * 6 * D; (void)MODL
        if (IN(pb)) {
            WSL;
            pg8::Gemm g{(const bf16_t*)(w + WS_AN), (const bf16_t*)(w + WS_WIN) + (size_t)layer * INW * D, MT, INW, D, D, D};
            pg8::StaticOrder S; S.init(MT, INW, G, (int)blockIdx.x);
            EpiIn E{(const float*)(w + WS_SSQ), (const float*)(w + WS_SHWIN) + (size_t)layer * 3 * INW, (bf16_t*)(w + WS_PHY), (bf16_t*)(w + WS_Q), (bf16_t*)(w + WS_K), (bf16_t*)(w + WS_V), (const float*)(w + WS_ROPE)};
            pg8::gemm_phase<EpiIn, pg8::StaticOrder, true, true>(lds, g, S, E, wave_s);
        }
        SEAM(pb);
        if (IN(pb + 1)) {
            hyena_fft(lds, layer, G, wave_s);
            if (layer != DEPTH - 1) hyena_direct<CTX>(lds, layer, G, ML, wave_s);
        }
        SEAM(pb + 1);
        if (IN(pb + 2)) {
            attn_simple(lds, layer, G, layer == DEPTH - 1 ? ML : MT, wave_s);
        }
        SEAM(pb + 2);
        if (IN(pb + 3)) {
            WSL;
            pg8::Gemm g{(const bf16_t*)(w + WS_YM), (const bf16_t*)(w + WS_WOUT) + (size_t)layer * D * D, MT, D, D, D, D};
            pg8::StaticOrder S; S.init(MT, D, G, (int)blockIdx.x);
            EpiResid E{(float*)(w + WS_X), MODL + 2 * D, (const float*)(w + WS_GMV) + ((size_t)layer * 2 + 1) * 3 * D, (bf16_t*)(w + WS_AN), (float*)(w + WS_SSQ)};
            pg8::gemm_phase<EpiResid, pg8::StaticOrder, true, true>(lds, g, S, E, wave_s);
        }
        SEAM(pb + 3);
        if (IN(pb + 4)) {
            WSL;
            pg8::Gemm g{(const bf16_t*)(w + WS_AN), (const bf16_t*)(w + WS_WGU) + (size_t)layer * GU * D, MT, GU, D, D, D};
            pg8::StaticOrder S; S.init(MT, GU, G, (int)blockIdx.x);
            EpiGU E{(const float*)(w + WS_SSQ), (const float*)(w + WS_SHWGU) + (size_t)layer * 3 * GU, (bf16_t*)(w + WS_HB)};
            pg8::gemm_phase<EpiGU, pg8::StaticOrder, true, true>(lds, g, S, E, wave_s);
        }
        SEAM(pb + 4);
        if (IN(pb + 5)) {
            WSL;
            pg8::Gemm g{(const bf16_t*)(w + WS_HB), (const bf16_t*)(w + WS_WD) + (size_t)layer * D * FF, MT, D, FF, FF, FF};
            pg8::StaticOrder S; S.init(MT, D, G, (int)blockIdx.x);
            EpiResid E{(float*)(w + WS_X), MODL + 5 * D, layer + 1 < DEPTH ? (const float*)(w + WS_GMV) + ((size_t)(layer + 1) * 2 + 0) * 3 * D : nullptr, (bf16_t*)(w + WS_AN), (float*)(w + WS_SSQ)};
            pg8::gemm_phase<EpiResid, pg8::StaticOrder, true, true>(lds, g, S, E, wave_s);
        }
        SEAM(pb + 5);
    }
    if (IN(NPHASE - 1)) final_norm(G, wave_s);
#undef IN
#undef SEAM
}
}

#ifndef MK_N_LAUNCHES
#define MK_N_LAUNCHES 1
#endif
extern "C" void kernel_launch(void* const* d_in, const int* in_sizes, int n_in, void* d_out, int out_size, void* d_ws, size_t ws_size, hipStream_t stream) {
    using namespace mk;
    static int grid = 0;
    if (grid == 0) {
        if (n_in != 26 || ws_size < WS_END) { fprintf(stderr, "kernel_launch: need 26 inputs and %zu bytes of workspace (got %d, %zu)\n", (size_t)WS_END, n_in, ws_size); grid = -1; return; }
        int dev = 0, cus = 0, per_cu = 0;
        if (hipGetDevice(&dev) != hipSuccess || hipDeviceGetAttribute(&cus, hipDeviceAttributeMultiprocessorCount, dev) != hipSuccess) { grid = -1; return; }
        if (hipFuncSetAttribute((const void*)mk_fwd, hipFuncAttributeMaxDynamicSharedMemorySize, LDS_BYTES) != hipSuccess) { fprintf(stderr, "kernel_launch: hipFuncSetAttribute failed\n"); grid = -1; return; }
        if (hipOccupancyMaxActiveBlocksPerMultiprocessor(&per_cu, (const void*)mk_fwd, NTHR, LDS_BYTES) != hipSuccess || per_cu < 1) { fprintf(stderr, "kernel_launch: occupancy query says %d\n", per_cu); }
        (void)hipGetLastError();
        grid = cus;
    }
    if (grid < 0) return;
    (void)hipMemsetAsync((char*)d_ws + WS_CTL, 0, CTL_BYTES, stream);
    Params p{};
    for (int i = 0; i < 26; ++i) p.in[i] = (const float*)d_in[i];
    p.out = (float*)d_out; p.ws = (unsigned char*)d_ws;
#if MK_N_LAUNCHES == 1
    p.ph_lo = 0; p.ph_hi = NPHASE;
    hipLaunchKernelGGL(mk_fwd, dim3(grid), dim3(NTHR), LDS_BYTES, stream, p);
#else
    for (int ph = 0; ph < NPHASE; ++ph) { p.ph_lo = ph; p.ph_hi = ph + 1; hipLaunchKernelGGL(mk_fwd, dim3(grid), dim3(NTHR), LDS_BYTES, stream, p); }
#endif
}
```

```cpp
#include <hip/hip_runtime.h>
#include <cstdint>
#include <cstdio>
#define LAS __attribute__((address_space(3)))
#define GAS __attribute__((address_space(1)))
#define MK_LANE_ASM(l) asm volatile("v_mbcnt_lo_u32_b32 %0, -1, 0\n\tv_mbcnt_hi_u32_b32 %0, -1, %0" : "=v"(l))
namespace pg8 {
#define PG8_LAS __attribute__((address_space(3)))
typedef unsigned short bf16_t;
typedef short bf16x8 __attribute__((ext_vector_type(8)));
typedef float f32x4 __attribute__((ext_vector_type(4)));
typedef unsigned u32x4 __attribute__((ext_vector_type(4)));
constexpr int BM = 256, BK = 64, HALF = 128, HTB = HALF * BK * 2  , STAGE_BYTES = 8 * HTB, NXCD = 8, WGM = 8;

__host__ __device__ __forceinline__ int lds_byte(int r, int c) { const int st = (r >> 4) * 2 + (c >> 5), rr = r & 15, cc = c & 31, ob = rr * 64 + cc * 2; return st * 1024 + (ob ^ (((ob >> 9) & 1) << 5)); }
__host__ __device__ __forceinline__ void stage_rc(int b, int& R, int& C) { const int st = b / 1024, sb = b % 1024, swz = sb ^ (((sb >> 9) & 1) << 5); R = (st >> 1) * 16 + swz / 64; C = (st & 1) * 32 + (swz % 64) / 2; }
__host__ __device__ __forceinline__ int perm32(int rho) { const int n = rho >> 4, i = rho & 15; return 8 * (i >> 2) + 4 * n + (i & 3); }

struct Unit { int pm, pn; };
struct Gemm { const bf16_t* A; const bf16_t* Bt; int M, N, K, lda, ldb; };

struct StaticOrder {
    int nM, nN, nwg, G, c;
    __host__ __device__ void init(int M, int N, int G_, int c_) { nM = M / BM; nN = N / BM; nwg = nM * nN; G = G_; c = c_; }
    __host__ __device__ bool next(int i, Unit& u) const {
        const long L = (long)i * G + c; if (L >= nwg) return false;
        int wgid = (int)L; { const int q = nwg / NXCD, r = nwg % NXCD, xcd = wgid % NXCD, off = wgid / NXCD; wgid = (xcd < r ? xcd * (q + 1) : r * (q + 1) + (xcd - r) * q) + off; }
        const int nig = WGM * nN, gid = wgid / nig, fm = gid * WGM, gsz = (nM - fm) < WGM ? (nM - fm) : WGM;
        u.pm = fm + ((wgid % nig) % gsz); u.pn = (wgid % nig) / gsz; return true;
    }
    __device__ __forceinline__ void a_ready(const Unit&) const {}
    __device__ __forceinline__ void done(const Unit&) const {}
};

template <class Epi, class Sched, bool ALIGN_EPI = false, bool SP2 = false>
__device__ __forceinline__ void gemm_phase(PG8_LAS unsigned char* lds, const Gemm g, const Sched& S, const Epi& E, const int wave_s) {
    int lane_; MK_LANE_ASM(lane_); int wv_ = wave_s; asm volatile("" : "+s"(wv_)); const int wid = wv_, lane = lane_, tid = wid * 64 + lane, wr = wid >> 2, wc = wid & 3, fr = lane & 15, fq = lane >> 4;
    const int K = g.K, nt = K / BK;
    unsigned voffA[2], voffB[2];
#pragma unroll
    for (int i = 0; i < 2; ++i) { int R, C; stage_rc(tid * 16 + i * 8192, R, C); const int Rb = Epi::PERM ? ((R & ~31) + perm32(R & 31)) : R;
        voffA[i] = (unsigned)(R * g.lda + C) * 2u; voffB[i] = (unsigned)(Rb * g.ldb + C) * 2u; }
    const size_t kstep = (size_t)(BK * 2);
    const size_t hstepA = (size_t)HALF * g.lda * 2, hstepB = (size_t)HALF * g.ldb * 2;
    const size_t tstepA = 2 * hstepA, tstepB = 2 * hstepB;
    const unsigned ldsw = (unsigned)wid * 1024u;
    const int aoff = lds_byte(wr * 64 + fr, fq * 8), boff = lds_byte(wc * 32 + fr, fq * 8);
#define PG8_SA(b, h) (((b) * 2 + (h)) * HTB)
#define PG8_SB(b, h) ((4 + (b) * 2 + (h)) * HTB)
#define PG8_STAGE(bufoff, gbase, voff) do { _Pragma("unroll") for (int _i = 0; _i < 2; ++_i) \
        __builtin_amdgcn_global_load_lds((const unsigned*)((const char*)(gbase) + (voff)[_i]), (PG8_LAS unsigned*)(lds + (bufoff) + ldsw + _i * 8192), 16, 0, 0); } while (0)
#define PG8_LDA(dst, b, h) do { _Pragma("unroll") for (int m = 0; m < 4; ++m) _Pragma("unroll") for (int k = 0; k < 2; ++k) dst[m][k] = *(const PG8_LAS bf16x8*)(lds + PG8_SA(b, h) + aoff + m * 2048 + k * 1024); } while (0)
#define PG8_LDB(dst, b, h) do { _Pragma("unroll") for (int n = 0; n < 2; ++n) _Pragma("unroll") for (int k = 0; k < 2; ++k) dst[n][k] = *(const PG8_LAS bf16x8*)(lds + PG8_SB(b, h) + boff + n * 2048 + k * 1024); } while (0)
#define PG8_MMA(ai, bj, At, Bt) do { __builtin_amdgcn_s_setprio(1); _Pragma("unroll") for (int m = 0; m < 4; ++m) _Pragma("unroll") for (int n = 0; n < 2; ++n) _Pragma("unroll") for (int k = 0; k < 2; ++k) \
        acc[ai][bj][m][n] = __builtin_amdgcn_mfma_f32_16x16x32_bf16(Bt[n][k], At[m][k], acc[ai][bj][m][n], 0, 0, 0); __builtin_amdgcn_s_setprio(0); } while (0)
#define PG8_WAIT_V(n) asm volatile("s_waitcnt vmcnt(" #n ")" ::: "memory")
#define PG8_WAIT_L(n) asm volatile("s_waitcnt lgkmcnt(" #n ")" ::: "memory")
#define PG8_BAR __builtin_amdgcn_s_barrier()
#define PG8_SCHED __builtin_amdgcn_sched_barrier(0)
    Unit cur, nxt; int ui = 0;
    (void)S.next(0, cur);
    f32x4 acc[2][2][4][2];
#pragma unroll
    for (int a = 0; a < 2; ++a)
#pragma unroll
        for (int b = 0; b < 2; ++b)
#pragma unroll
            for (int m = 0; m < 4; ++m)
#pragma unroll
                for (int n = 0; n < 2; ++n) acc[a][b][m][n] = (f32x4){0.f, 0.f, 0.f, 0.f};
    bf16x8 At[4][2], B0[2][2], B1[2][2];
    const char* cA = (const char*)g.A + (size_t)cur.pm * tstepA; const char* cB = (const char*)g.Bt + (size_t)cur.pn * tstepB;
    S.a_ready(cur);
    if constexpr (SP2) {
        PG8_STAGE(PG8_SB(0, 0), cB, voffB); PG8_STAGE(PG8_SB(0, 1), cB + hstepB, voffB); PG8_STAGE(PG8_SA(0, 0), cA, voffA); PG8_STAGE(PG8_SA(0, 1), cA + hstepA, voffA);
        if (wr == 1) PG8_BAR;
        PG8_WAIT_V(2); PG8_BAR;
        PG8_STAGE(PG8_SB(1, 0), cB + kstep, voffB); PG8_STAGE(PG8_SA(1, 0), cA + kstep, voffA); PG8_STAGE(PG8_SB(1, 1), cB + hstepB + kstep, voffB);
        PG8_WAIT_V(6); PG8_BAR;
    } else {
        PG8_STAGE(PG8_SB(0, 0), cB, voffB); PG8_STAGE(PG8_SA(0, 0), cA, voffA); PG8_STAGE(PG8_SB(0, 1), cB + hstepB, voffB); PG8_STAGE(PG8_SA(0, 1), cA + hstepA, voffA);
        if (wr == 1) PG8_BAR;
        PG8_WAIT_V(4); PG8_BAR;
        PG8_STAGE(PG8_SB(1, 0), cB + kstep, voffB); PG8_STAGE(PG8_SA(1, 0), cA + kstep, voffA); PG8_STAGE(PG8_SB(1, 1), cB + hstepB + kstep, voffB);
        PG8_WAIT_V(6); PG8_BAR;
    }
    for (;;) {
        const bool has_next = S.next(ui + 1, nxt);
        const char* nA = has_next ? (const char*)g.A + (size_t)nxt.pm * tstepA : cA; const char* nB = has_next ? (const char*)g.Bt + (size_t)nxt.pn * tstepB : cB;
        for (int t = 0; t < nt; t += 2) {
            const bool last = (t == nt - 2);
            const char* a1 = cA + (size_t)(t + 1) * kstep;
            const char* a2 = last ? nA : cA + (size_t)(t + 2) * kstep; const char* b2 = last ? nB : cB + (size_t)(t + 2) * kstep;
            const char* a3 = a2 + kstep; const char* b3 = b2 + kstep;
            if (last && has_next) S.a_ready(nxt);
            if constexpr (SP2) {
            PG8_LDB(B0, 0, 0); PG8_LDB(B1, 0, 1); PG8_SCHED; PG8_LDA(At, 0, 0); PG8_STAGE(PG8_SA(1, 1), a1 + hstepA, voffA);
            PG8_WAIT_V(8); PG8_WAIT_L(0); PG8_BAR; PG8_MMA(0, 0, At, B0); PG8_MMA(0, 1, At, B1); PG8_BAR; PG8_SCHED;
            PG8_LDA(At, 0, 1); PG8_STAGE(PG8_SB(0, 0), b2, voffB); PG8_STAGE(PG8_SB(0, 1), b2 + hstepB, voffB); PG8_STAGE(PG8_SA(0, 0), a2, voffA);
            PG8_WAIT_V(8); PG8_WAIT_L(0); PG8_BAR; PG8_MMA(1, 0, At, B0); PG8_MMA(1, 1, At, B1); PG8_BAR; PG8_SCHED;
            PG8_LDB(B0, 1, 0); PG8_LDB(B1, 1, 1); PG8_SCHED; PG8_LDA(At, 1, 0); PG8_STAGE(PG8_SA(0, 1), a2 + hstepA, voffA);
            PG8_WAIT_V(8); PG8_WAIT_L(0); PG8_BAR; PG8_MMA(0, 0, At, B0); PG8_MMA(0, 1, At, B1); PG8_BAR; PG8_SCHED;
            PG8_LDA(At, 1, 1); PG8_STAGE(PG8_SB(1, 0), b3, voffB); PG8_STAGE(PG8_SB(1, 1), b3 + hstepB, voffB); PG8_STAGE(PG8_SA(1, 0), a3, voffA);
            PG8_WAIT_V(8); PG8_WAIT_L(0); PG8_BAR; PG8_MMA(1, 0, At, B0); PG8_MMA(1, 1, At, B1); PG8_BAR; PG8_SCHED;
            } else {
            PG8_LDB(B0, 0, 0); PG8_SCHED; PG8_LDA(At, 0, 0); PG8_STAGE(PG8_SA(1, 1), a1 + hstepA, voffA);
            PG8_WAIT_L(8); PG8_BAR; PG8_WAIT_L(0); PG8_MMA(0, 0, At, B0); PG8_BAR; PG8_SCHED;
            PG8_LDB(B1, 0, 1); PG8_STAGE(PG8_SB(0, 0), b2, voffB);
            PG8_BAR; PG8_WAIT_L(0); PG8_MMA(0, 1, At, B1); PG8_BAR;
            PG8_LDA(At, 0, 1); PG8_STAGE(PG8_SA(0, 0), a2, voffA);
            PG8_BAR; PG8_WAIT_L(0); PG8_MMA(1, 0, At, B0); PG8_BAR; PG8_SCHED;
            PG8_STAGE(PG8_SB(0, 1), b2 + hstepB, voffB);
            PG8_WAIT_V(6); PG8_BAR; PG8_MMA(1, 1, At, B1); PG8_BAR;
            PG8_LDB(B0, 1, 0); PG8_SCHED; PG8_LDA(At, 1, 0); PG8_STAGE(PG8_SA(0, 1), a2 + hstepA, voffA);
            PG8_WAIT_L(8); PG8_BAR; PG8_WAIT_L(0); PG8_MMA(0, 0, At, B0); PG8_BAR; PG8_SCHED;
            PG8_LDB(B1, 1, 1); PG8_STAGE(PG8_SB(1, 0), b3, voffB);
            PG8_BAR; PG8_WAIT_L(0); PG8_MMA(0, 1, At, B1); PG8_BAR;
            PG8_LDA(At, 1, 1); PG8_STAGE(PG8_SA(1, 0), a3, voffA);
            PG8_BAR; PG8_WAIT_L(0); PG8_MMA(1, 0, At, B0); PG8_BAR; PG8_SCHED;
            PG8_STAGE(PG8_SB(1, 1), b3 + hstepB, voffB);
            PG8_WAIT_V(6); PG8_BAR; PG8_MMA(1, 1, At, B1); PG8_BAR;
            }
        }
        if constexpr (ALIGN_EPI) { if (wr == 0) PG8_BAR; }
        if constexpr (!Epi::AFTER_DRAIN) { E(acc, cur, wr, wc, fr, fq); S.done(cur); }
        if (!has_next) break;
#pragma unroll
        for (int a = 0; a < 2; ++a)
#pragma unroll
            for (int b = 0; b < 2; ++b)
#pragma unroll
                for (int m = 0; m < 4; ++m)
#pragma unroll
                    for (int n = 0; n < 2; ++n) acc[a][b][m][n] = (f32x4){0.f, 0.f, 0.f, 0.f};
        cur = nxt; cA = nA; cB = nB; ++ui;
        if constexpr (ALIGN_EPI) { if (wr == 1) PG8_BAR; }
    }
    PG8_WAIT_V(0);
    if constexpr (!ALIGN_EPI) { if (wr == 0) PG8_BAR; }
    PG8_BAR;
    if constexpr (Epi::AFTER_DRAIN) { E.fused(acc, cur, wr, wc, fr, fq, lds, wid, lane); S.done(cur); }
#undef PG8_SA
#undef PG8_SB
#undef PG8_STAGE
#undef PG8_LDA
#undef PG8_LDB
#undef PG8_MMA
#undef PG8_WAIT_V
#undef PG8_WAIT_L
#undef PG8_BAR
#undef PG8_SCHED
}
}

#define XB_TMO      128
#define XB_XCNT(j)  (256  + 64 * (j))
#define XB_XSUB(j)  (1280 + 64 * (j))
#define XB_XGEN(j)  (2304 + 64 * (j))
#define XB_TOP      3328
#define XB_TOPGEN   3392
#define XCD_BAR_WORDS 3456
#define XB_SPIN_CAP (1u << 18)

__device__ __forceinline__ unsigned xb_ld(unsigned* p)              { return __hip_atomic_load(p, __ATOMIC_RELAXED, __HIP_MEMORY_SCOPE_AGENT); }
__device__ __forceinline__ unsigned xb_add(unsigned* p, unsigned v) { return __hip_atomic_fetch_add(p, v, __ATOMIC_RELAXED, __HIP_MEMORY_SCOPE_AGENT); }
__device__ __forceinline__ unsigned xb_xcc_id() { return (unsigned)__builtin_amdgcn_s_getreg((3 << 11) | 20) & 0xFu; }
#define XB_SPIN(cond, bar) do { unsigned _sp = 0; while (cond) { __builtin_amdgcn_s_sleep(1); \
    if ((++_sp & 255u) == 0u) { if (xb_ld(&(bar)[XB_TMO])) break; if (_sp > XB_SPIN_CAP) { atomicAdd(&(bar)[XB_TMO], 1u); break; } } } } while (0)

struct XcdBarrier {
    unsigned* bar; unsigned x;
    volatile LAS unsigned* st;
};

__device__ __forceinline__ XcdBarrier xcd_barrier_post(unsigned* bar, volatile LAS unsigned* st) {
    XcdBarrier b; b.bar = bar; b.x = xb_xcc_id(); b.st = st;
    if (threadIdx.x == 0) (void)xb_add(&bar[XB_XCNT(b.x)], 1u);
    return b;
}
__device__ __forceinline__ void xcd_barrier_complete(unsigned* bar, unsigned x, unsigned& nloc, unsigned& nx) {
    const unsigned G = gridDim.x * gridDim.y * gridDim.z;
    unsigned sum, cnt, mine, sp = 0u;
    for (;;) {
        sum = 0u; cnt = 0u; mine = 0u;
#pragma unroll
        for (unsigned j = 0; j < 16; ++j) { const unsigned c = xb_ld(&bar[XB_XCNT(j)]); sum += c; cnt += (c > 0u) ? 1u : 0u; mine = (j == x) ? c : mine; }
        if (sum == G) break;
        __builtin_amdgcn_s_sleep(1);
        if ((++sp & 255u) == 0u) { if (xb_ld(&bar[XB_TMO])) break; if (sp > XB_SPIN_CAP) { atomicAdd(&bar[XB_TMO], 1u); break; } }
    }
    nloc = mine > 0u ? mine : 1u; nx = cnt > 0u ? cnt : 1u;
}

__device__ __forceinline__ void xcd_barrier(const XcdBarrier& b, const int wave_s) {
    int xb_lane_; MK_LANE_ASM(xb_lane_); const bool xb_t0 = (wave_s == 0) && (xb_lane_ == 0);
    asm volatile("s_waitcnt vmcnt(0)" ::: "memory");
    __syncthreads();
    if (xb_t0) {
        unsigned* bar = b.bar;
        __builtin_amdgcn_s_waitcnt(0);
        unsigned nloc = b.st[0], nx = b.st[1];
        if (nloc == 0u) { xcd_barrier_complete(bar, b.x, nloc, nx); b.st[0] = nloc; b.st[1] = nx; }
        const unsigned old = xb_add(&bar[XB_XSUB(b.x)], 1u);
        const unsigned gen = old / nloc;
        if (old + 1u == (gen + 1u) * nloc) {
            __builtin_amdgcn_fence(__ATOMIC_RELEASE, "agent");
            asm volatile("s_waitcnt vmcnt(0)" ::: "memory");
            const unsigned og = xb_add(&bar[XB_TOP], 1u);
            const unsigned tg = og / nx;
            if (og + 1u == (tg + 1u) * nx) xb_add(&bar[XB_TOPGEN], 1u);
            else XB_SPIN(xb_ld(&bar[XB_TOPGEN]) == tg, bar);
            __builtin_amdgcn_fence(__ATOMIC_ACQUIRE, "agent");
            xb_add(&bar[XB_XGEN(b.x)], 1u);
            asm volatile("s_waitcnt vmcnt(0)" ::: "memory");
        } else {
            XB_SPIN(xb_ld(&bar[XB_XGEN(b.x)]) == gen, bar);
            __builtin_amdgcn_fence(__ATOMIC_ACQUIRE, "agent");
            asm volatile("s_waitcnt vmcnt(0)" ::: "memory");
        }
    }
    __syncthreads();
}


namespace mk {
using pg8::bf16_t; using pg8::f32x4; using pg8::Unit; using pg8::BM; using pg8::HALF;
typedef unsigned u32x4 __attribute__((ext_vector_type(4)));
typedef unsigned u32x2 __attribute__((ext_vector_type(2)));
typedef float f32x2 __attribute__((ext_vector_type(2)));

constexpr int D = 2048, BATCH = 2, SEQ = 4096, DEPTH = 4, CTX = 256;
constexpr int HY = 1024, NH = 8, NKV = 2, HD = 128, ATTW = 1024, KVW = 256;
constexpr int INW = 4608, FF = 5632, GU = 2 * FF, FH = 64, FE = 33;
constexpr int ML = BATCH * SEQ, MC = BATCH * CTX, MT = ML + MC;
constexpr float EPS = 1e-6f;
constexpr float LOG2E = 1.4426950408889634f;
constexpr float QSCALE = 0.08838834764831845f * LOG2E;
constexpr int WINDOW = 128;
constexpr int NWAVES = 8, NTHR = 512;
constexpr int MOD_KC = 8;

constexpr size_t al(size_t x) { return (x + 255) & ~(size_t)255; }
constexpr size_t WS_CTL = 0, CTL_BYTES = 1u << 20;
constexpr size_t WS_X = CTL_BYTES;
constexpr size_t WS_AN = WS_X + al((size_t)MT * D * 4);
constexpr size_t WS_SSQ = WS_AN + al((size_t)MT * D * 2);
constexpr size_t WS_PHY = WS_SSQ + al((size_t)MT * 32 * 4);
constexpr size_t WS_Q = WS_PHY + al((size_t)3 * HY * MT * 2);
constexpr size_t WS_K = WS_Q + al((size_t)MT * ATTW * 2);
constexpr size_t WS_V = WS_K + al((size_t)MT * KVW * 2);
constexpr size_t WS_YM = WS_V + al((size_t)MT * KVW * 2);
constexpr size_t WS_SSHY = WS_YM + al((size_t)MT * D * 2);
constexpr size_t WS_HB = WS_SSHY + al((size_t)HY * MT * 4);
constexpr size_t WS_MODP = WS_HB + al((size_t)MT * FF * 2);
constexpr size_t WS_MOD = WS_MODP + al((size_t)MOD_KC * DEPTH * 3 * 6 * D * 4);
constexpr size_t WS_GMV = WS_MOD + al((size_t)DEPTH * 3 * 6 * D * 4);
constexpr size_t WS_SHWIN = WS_GMV + al((size_t)DEPTH * 2 * 3 * D * 4);
constexpr size_t WS_SHWGU = WS_SHWIN + al((size_t)DEPTH * 3 * INW * 4);
constexpr size_t WS_HIDL = WS_SHWGU + al((size_t)DEPTH * 3 * GU * 4);
constexpr size_t WS_HIDC = WS_HIDL + al((size_t)DEPTH * SEQ * FH * 4);
constexpr size_t WS_ROPE = WS_HIDC + al((size_t)DEPTH * CTX * FH * 4);
constexpr size_t WS_FLT = WS_ROPE + al((size_t)64 * 32 * 2 * 4);
constexpr size_t WS_FLTC = WS_FLT + al((size_t)DEPTH * 4 * HY * SEQ * 4);
constexpr size_t WS_WIN = WS_FLTC + al((size_t)DEPTH * 4 * HY * CTX * 4);
constexpr size_t WS_WOUT = WS_WIN + al((size_t)DEPTH * INW * D * 2);
constexpr size_t WS_WGU = WS_WOUT + al((size_t)DEPTH * D * D * 2);
constexpr size_t WS_WD = WS_WGU + al((size_t)DEPTH * GU * D * 2);
constexpr size_t WS_END = WS_WD + al((size_t)DEPTH * D * FF * 2);
constexpr int CW_BAR = 4096;

constexpr int RING_BYTES = 135168  , MISC_OFF = RING_BYTES + 320, LDS_BYTES = RING_BYTES + 4096;

__device__ __forceinline__ unsigned f2bf(float f) { unsigned u = __builtin_bit_cast(unsigned, f); return (u + 0x7fffu + ((u >> 16) & 1u)) >> 16; }
__device__ __forceinline__ unsigned pk2(float lo, float hi) { return f2bf(lo) | (f2bf(hi) << 16); }
__device__ __forceinline__ float bf_lo(unsigned w) { return __builtin_bit_cast(float, w << 16); }
__device__ __forceinline__ float bf_hi(unsigned w) { return __builtin_bit_cast(float, w & 0xffff0000u); }
__device__ __forceinline__ float bf1(bf16_t b) { return __builtin_bit_cast(float, (unsigned)b << 16); }
__device__ __forceinline__ float wave_sum(float v) {
#pragma unroll
    for (int o = 1; o < 64; o <<= 1) v += __shfl_xor(v, o);
    return v;
}
__device__ __forceinline__ float wave_max(float v) {
#pragma unroll
    for (int o = 1; o < 64; o <<= 1) v = fmaxf(v, __shfl_xor(v, o));
    return v;
}
__device__ __forceinline__ int vec_of_panel(int pm) { return pm < 16 ? 0 : (pm < 32 ? 1 : 2); }
__device__ __forceinline__ int vec_of_row(int row) { return row < SEQ ? 0 : (row < ML ? 1 : 2); }
__host__ __device__ __forceinline__ int qk_dim(int j) { const int wc = j >> 5, fq = (j >> 3) & 3, n = (j >> 2) & 1, e = j & 3, idx = wc * 16 + fq * 4 + e; return (idx < 32 ? idx : idx + 32) + 32 * n; }

#define FRESH_IDS int lane_; MK_LANE_ASM(lane_); int wv_ = wave_s; asm volatile("" : "+s"(wv_)); const int lane = lane_, wave = wv_, tid = wv_ * 64 + lane_; (void)lane; (void)wave; (void)tid
struct Params {
    const float* in[26];
    float* out;
    unsigned char* ws;
    int ph_lo, ph_hi;
};
typedef __attribute__((address_space(4))) const Params* KP;
#define FRESH_KP KP Pp; { unsigned long long ki_ = (unsigned long long)__builtin_amdgcn_kernarg_segment_ptr(); asm volatile("" : "+s"(ki_)); Pp = (KP)ki_; }

__device__ __forceinline__ void load_rstd8(const float* ssq, int row0, int fq, float (&rs)[2][4]) {
#pragma unroll
    for (int ai = 0; ai < 2; ++ai)
#pragma unroll
        for (int m = 0; m < 4; ++m) {
            const int row = row0 + ai * HALF + m * 16;
            const f32x4 a = *(const f32x4*)(ssq + ((size_t)(2 * fq) * MT + row) * 4), b = *(const f32x4*)(ssq + ((size_t)(2 * fq + 1) * MT + row) * 4);
            float s = ((a[0] + a[1]) + (a[2] + a[3])) + ((b[0] + b[1]) + (b[2] + b[3]));
            s += __shfl_xor(s, 16); s += __shfl_xor(s, 32);
            rs[ai][m] = 1.0f / sqrtf(s * (1.0f / D) + EPS);
        }
}

struct EpiIn {
    static constexpr bool PERM = true, AFTER_DRAIN = false;
    const float* ssq; const float* shw;
    bf16_t* PHY; bf16_t* Q; bf16_t* Kb; bf16_t* Vb; const float* rope;
    __device__ __forceinline__ void operator()(const f32x4 (&acc)[2][2][4][2], const Unit& u, int wr, int wc, int fr_, int fq_) const {
        int fr = fr_, fq = fq_; asm volatile("" : "+v"(fr), "+v"(fq));
        const int row0 = u.pm * BM + wr * 64 + fr, v = vec_of_panel(u.pm);
        float rs[2][4]; load_rstd8(ssq, row0, fq, rs);
        const int cpos = wc * 32 + 8 * fq;
        const int colb = u.pn * BM + cpos;
        f32x4 sh[2][2];
#pragma unroll
        for (int bj = 0; bj < 2; ++bj)
#pragma unroll
            for (int n = 0; n < 2; ++n) sh[bj][n] = *(const f32x4*)(shw + (size_t)v * INW + colb + bj * HALF + 4 * n);
        if (u.pn < 12) {
#pragma unroll
            for (int ai = 0; ai < 2; ++ai)
#pragma unroll
                for (int m = 0; m < 4; ++m) { const int row = row0 + ai * HALF + m * 16; const float r = rs[ai][m];
#pragma unroll
                    for (int bj = 0; bj < 2; ++bj)
#pragma unroll
                        for (int n = 0; n < 2; ++n) { const f32x4 x = acc[ai][bj][m][n] * r + sh[bj][n];
                            u32x2 w; w.x = pk2(x[0], x[1]); w.y = pk2(x[2], x[3]);
                            const int cg = (colb + bj * HALF) / 4 + n;
                            *(u32x2*)(PHY + ((size_t)cg * MT + row) * 4) = w; } }
        } else if (u.pn < 17) {
            const bool isq = u.pn < 16, latent = u.pm < 32;
            const int axis = wc >> 1, p0 = (wc * 16 + fq * 4) & 31;
            const float qs = isq ? QSCALE : 1.0f;
#pragma unroll
            for (int ai = 0; ai < 2; ++ai)
#pragma unroll
                for (int m = 0; m < 4; ++m) { const int row = row0 + ai * HALF + m * 16; const float r = rs[ai][m];
                    const int l = row & (SEQ - 1), pos = axis ? (l & 63) : (l >> 6);
                    f32x4 t0 = (f32x4){1.f, 0.f, 1.f, 0.f}, t1 = t0;
                    if (latent) { const f32x4* tp = (const f32x4*)(rope + ((size_t)pos * 32 + p0) * 2); t0 = tp[0]; t1 = tp[1]; }
                    const float cs[4] = {t0[0], t0[2], t1[0], t1[2]}, sn[4] = {t0[1], t0[3], t1[1], t1[3]};
#pragma unroll
                    for (int bj = 0; bj < 2; ++bj) { const f32x4 a = acc[ai][bj][m][0] * r + sh[bj][0], b = acc[ai][bj][m][1] * r + sh[bj][1];
                        float ra[4], rb[4];
#pragma unroll
                        for (int e = 0; e < 4; ++e) { ra[e] = (a[e] * cs[e] - b[e] * sn[e]) * qs; rb[e] = (a[e] * sn[e] + b[e] * cs[e]) * qs; }
                        u32x4 w; w.x = pk2(ra[0], ra[1]); w.y = pk2(ra[2], ra[3]); w.z = pk2(rb[0], rb[1]); w.w = pk2(rb[2], rb[3]);
                        bf16_t* dst = isq ? Q + (size_t)row * ATTW + (u.pn - 12) * BM + bj * HALF + cpos : Kb + (size_t)row * KVW + bj * HALF + cpos;
                        *(u32x4*)dst = w; } }
        } else {
#pragma unroll
            for (int ai = 0; ai < 2; ++ai)
#pragma unroll
                for (int m = 0; m < 4; ++m) { const int row = row0 + ai * HALF + m * 16; const float r = rs[ai][m];
#pragma unroll
                    for (int bj = 0; bj < 2; ++bj) { const f32x4 a = acc[ai][bj][m][0] * r + sh[bj][0], b = acc[ai][bj][m][1] * r + sh[bj][1];
                        u32x4 w; w.x = pk2(a[0], a[1]); w.y = pk2(a[2], a[3]); w.z = pk2(b[0], b[1]); w.w = pk2(b[2], b[3]);
                        *(u32x4*)(Vb + (size_t)row * KVW + bj * HALF + cpos) = w; } }
        }
    }
};

struct EpiOutA {
    static constexpr bool PERM = true, AFTER_DRAIN = false;
    float* X; const float* gate;
    const float* sshy;
    __device__ __forceinline__ void operator()(const f32x4 (&acc)[2][2][4][2], const Unit& u, int wr, int wc, int fr_, int fq_) const {
        int fr = fr_, fq = fq_; asm volatile("" : "+v"(fr), "+v"(fq));
        const int row0 = u.pm * BM + wr * 64 + fr, v = vec_of_panel(u.pm);
        const int colb = u.pn * BM + wc * 32 + 8 * fq;
        f32x4 gt[2][2];
#pragma unroll
        for (int bj = 0; bj < 2; ++bj)
#pragma unroll
            for (int n = 0; n < 2; ++n) gt[bj][n] = *(const f32x4*)(gate + (size_t)v * 6 * D + colb + bj * HALF + 4 * n);
#pragma unroll
        for (int ai = 0; ai < 2; ++ai)
#pragma unroll
            for (int m = 0; m < 4; ++m) { const int row = row0 + ai * HALF + m * 16;
                const float r = 1.0f / sqrtf(sshy[row] * (1.0f / HY) + EPS);
                float* xr = X + (size_t)row * D + colb;
#pragma unroll
                for (int bj = 0; bj < 2; ++bj)
#pragma unroll
                    for (int n = 0; n < 2; ++n) { f32x4* px = (f32x4*)(xr + bj * HALF + 4 * n); *px = *px + gt[bj][n] * (acc[ai][bj][m][n] * r); } }
    }
};

struct EpiResid {
    static constexpr bool PERM = true, AFTER_DRAIN = false;
    float* X; const float* gate; const float* gnext  ; bf16_t* AN; float* ssq;
    __device__ __forceinline__ void operator()(const f32x4 (&acc)[2][2][4][2], const Unit& u, int wr, int wc, int fr_, int fq_) const {
        int fr = fr_, fq = fq_; asm volatile("" : "+v"(fr), "+v"(fq));
        const int row0 = u.pm * BM + wr * 64 + fr, v = vec_of_panel(u.pm);
        const int colb = u.pn * BM + wc * 32 + 8 * fq;
        f32x4 gt[2][2], gn[2][2];
#pragma unroll
        for (int bj = 0; bj < 2; ++bj)
#pragma unroll
            for (int n = 0; n < 2; ++n) { gt[bj][n] = *(const f32x4*)(gate + (size_t)v * 6 * D + colb + bj * HALF + 4 * n);
                gn[bj][n] = gnext ? *(const f32x4*)(gnext + (size_t)v * D + colb + bj * HALF + 4 * n) : (f32x4){0.f, 0.f, 0.f, 0.f}; }
#pragma unroll
        for (int ai = 0; ai < 2; ++ai)
#pragma unroll
            for (int m = 0; m < 4; ++m) { const int row = row0 + ai * HALF + m * 16;
                float* xr = X + (size_t)row * D + colb; float s = 0.f;
#pragma unroll
                for (int bj = 0; bj < 2; ++bj) { f32x4 x[2];
#pragma unroll
                    for (int n = 0; n < 2; ++n) { f32x4* px = (f32x4*)(xr + bj * HALF + 4 * n); x[n] = *px + gt[bj][n] * acc[ai][bj][m][n]; *px = x[n];
                        s += (x[n][0] * x[n][0] + x[n][1] * x[n][1]) + (x[n][2] * x[n][2] + x[n][3] * x[n][3]); }
                    if (gnext) { const f32x4 a = x[0] * gn[bj][0], b = x[1] * gn[bj][1];
                        u32x4 w; w.x = pk2(a[0], a[1]); w.y = pk2(a[2], a[3]); w.z = pk2(b[0], b[1]); w.w = pk2(b[2], b[3]);
                        *(u32x4*)(AN + (size_t)row * D + colb + bj * HALF) = w; } }
                s += __shfl_xor(s, 16); s += __shfl_xor(s, 32);
                if (fq == 0) ssq[((size_t)u.pn * MT + row) * 4 + wc] = s; }
    }
};

struct EpiGU {
    static constexpr bool PERM = true, AFTER_DRAIN = false;
    const float* ssq; const float* shw;
    bf16_t* HB;
    __device__ __forceinline__ void operator()(const f32x4 (&acc)[2][2][4][2], const Unit& u, int wr, int wc, int fr_, int fq_) const {
        int fr = fr_, fq = fq_; asm volatile("" : "+v"(fr), "+v"(fq));
        const int row0 = u.pm * BM + wr * 64 + fr, v = vec_of_panel(u.pm);
        float rs[2][4]; load_rstd8(ssq, row0, fq, rs);
        const int colb = u.pn * BM + wc * 32 + 8 * fq;
        f32x4 sh[2][2];
#pragma unroll
        for (int bj = 0; bj < 2; ++bj)
#pragma unroll
            for (int n = 0; n < 2; ++n) sh[bj][n] = *(const f32x4*)(shw + (size_t)v * GU + colb + bj * HALF + 4 * n);
#pragma unroll
        for (int ai = 0; ai < 2; ++ai)
#pragma unroll
            for (int m = 0; m < 4; ++m) { const int row = row0 + ai * HALF + m * 16; const float r = rs[ai][m];
#pragma unroll
                for (int bj = 0; bj < 2; ++bj) { const f32x4 g = acc[ai][bj][m][0] * r + sh[bj][0], up = acc[ai][bj][m][1] * r + sh[bj][1];
                    float h[4];
#pragma unroll
                    for (int e = 0; e < 4; ++e) h[e] = g[e] * __builtin_amdgcn_rcpf(1.0f + __builtin_amdgcn_exp2f(-g[e] * LOG2E)) * up[e];
                    u32x2 w; w.x = pk2(h[0], h[1]); w.y = pk2(h[2], h[3]);
                    const int ff = (colb + bj * HALF) >> 1;
                    *(u32x2*)(HB + (size_t)row * FF + ff) = w; } }
    }
};

template <class RowMap>
__device__ __forceinline__ void transpose_item(const float* W, int K, int N, bf16_t* WT, LAS float* scr, int item, int lane, const RowMap& rm) {
    const int nblk = N / 32, kb = item / nblk, nb = item % nblk, k0 = 64 * kb, n0 = 32 * nb;
#pragma unroll 8
    for (int i = 0; i < 32; ++i) { const int kk = 2 * i + (lane >> 5); scr[kk * 33 + (lane & 31)] = W[(size_t)(k0 + kk) * N + n0 + (lane & 31)]; }
    asm volatile("s_waitcnt lgkmcnt(0)" ::: "memory");
    const int c = lane & 7;
#pragma unroll
    for (int j = 0; j < 4; ++j) { const int n = (lane >> 3) + 8 * j; const LAS float* s = scr + (8 * c) * 33 + n;
        u32x4 o; o.x = pk2(s[0 * 33], s[1 * 33]); o.y = pk2(s[2 * 33], s[3 * 33]); o.z = pk2(s[4 * 33], s[5 * 33]); o.w = pk2(s[6 * 33], s[7 * 33]);
        *(u32x4*)(WT + (size_t)rm(n0 + n) * K + k0 + 8 * c) = o; }
    asm volatile("s_waitcnt lgkmcnt(0)" ::: "memory");
}
struct MapId { __device__ __forceinline__ int operator()(int n) const { return n; } };
struct MapIn { __device__ __forceinline__ int operator()(int n) const {
    if (n < 3 * HY || n >= 3 * HY + ATTW + KVW) return n;
    const int h0 = (n - 3 * HY) & ~127, d = (n - 3 * HY) & 127;
    const int nn = (d >> 5) & 1, base = d - 32 * nn, idx = base < 32 ? base : base - 32, wc = idx >> 4, fq = (idx >> 2) & 3, e = idx & 3;
    return 3 * HY + h0 + 32 * wc + 8 * fq + 4 * nn + e; } };
struct MapGU { int up; __device__ __forceinline__ int operator()(int n) const { return (n >> 2) * 8 + up * 4 + (n & 3); } };

__device__ __forceinline__ float silu_acc(float v) { return v / (1.f + expf(-v)); }

__device__ __forceinline__ void p0a(LAS unsigned char* lds, int G, const int wave_s) {
    FRESH_IDS; FRESH_KP;
    unsigned char* ws = Pp->ws;
    const int gw = blockIdx.x * NWAVES + wave, NGW = G * NWAVES;
    const int gt = blockIdx.x * NTHR + tid, NGT = G * NTHR;
    { const f32x4* xs = (const f32x4*)Pp->in[0]; const f32x4* cs = (const f32x4*)Pp->in[2]; f32x4* X = (f32x4*)(ws + WS_X);
      const int nl = ML * D / 4, nt = MT * D / 4;
      for (int i = gt; i < nt; i += NGT) X[i] = i < nl ? xs[i] : cs[i - nl]; }
    { float* rope = (float*)(ws + WS_ROPE);
      for (int i = gt; i < 64 * 32; i += NGT) { const int pos = i >> 5, p = i & 31; const float inv = powf(10000.f, -(float)p / 32.f); const float ang = (float)pos * inv; rope[2 * i] = cosf(ang); rope[2 * i + 1] = sinf(ang); }
    }
    LAS float* SV = (LAS float*)(lds + 98304);
    for (int i = tid; i < 3 * D; i += NTHR) SV[i] = silu_acc(i < 2 * D ? Pp->in[1][i] : Pp->in[3][i - 2 * D]);
    __syncthreads();
    { float* MODP = (float*)(ws + WS_MODP);
      constexpr int KCH = D / MOD_KC, NCH = 6 * D / 256, NIT = DEPTH * NCH * MOD_KC;
      for (int it = gw; it < NIT; it += NGW) {
          const int kc = it % MOD_KC, nc = (it / MOD_KC) % NCH, layer = it / (MOD_KC * NCH);
          const float* W = Pp->in[6] + (size_t)layer * D * 6 * D + (size_t)(kc * KCH) * 6 * D + nc * 256 + lane * 4;
          f32x4 a0 = {0.f, 0.f, 0.f, 0.f}, a1 = a0, a2 = a0;
#pragma unroll 8
          for (int k = 0; k < KCH; ++k) { const f32x4 w = *(const f32x4*)(W + (size_t)k * 6 * D); const int kk = kc * KCH + k;
              a0 += w * SV[kk]; a1 += w * SV[D + kk]; a2 += w * SV[2 * D + kk]; }
          float* o = MODP + ((size_t)(kc * DEPTH + layer) * 3) * 6 * D + nc * 256 + lane * 4;
          *(f32x4*)o = a0; *(f32x4*)(o + 6 * D) = a1; *(f32x4*)(o + 12 * D) = a2; } }
    { for (int it = gw; it < DEPTH * (SEQ + CTX); it += NGW) {
          const int layer = it / (SEQ + CTX), r = it % (SEQ + CTX); const bool isc = r >= SEQ; const int l = isc ? r - SEQ : r, L = isc ? CTX : SEQ;
          const float* w1 = Pp->in[11] + (size_t)layer * FE * FH; const float* b1 = Pp->in[12] + layer * FH; const float* w2 = Pp->in[13] + (size_t)layer * FH * FH; const float* b2 = Pp->in[14] + layer * FH; const float* fr = Pp->in[16] + layer * FH;
          float emb = 0.f;
          if (lane < FE) { const float t = (float)l / (float)(L - 1); const float w = (2.0f * 3.14159265358979323846f / (float)L) * (float)l;
              if (lane == 0) emb = t; else { const int bi = (lane - 1) & 15; const float band = 1e-4f + (float)bi * ((15.0f - 1e-4f) / 15.0f); emb = lane <= 16 ? cosf(band * w) : -sinf(band * w); } }
          float a = b1[lane];
          for (int j = 0; j < FE; ++j) a += __shfl(emb, j) * w1[j * FH + lane];
          const float h1 = sinf(fr[lane] * a);
          float c = b2[lane];
          for (int j = 0; j < FH; ++j) c += __shfl(h1, j) * w2[j * FH + lane];
          float* dst = isc ? (float*)(ws + WS_HIDC) + ((size_t)layer * CTX + l) * FH : (float*)(ws + WS_HIDL) + ((size_t)layer * SEQ + l) * FH;
          dst[lane] = sinf(fr[lane] * c); } }
    { LAS float* scr = (LAS float*)(lds + wave * 8704);
      constexpr int I_IN = (D / 64) * (INW / 32), I_OUT = (D / 64) * (D / 32), I_G = (D / 64) * (FF / 32), I_D = (FF / 64) * (D / 32);
      constexpr int PER = I_IN + I_OUT + 2 * I_G + I_D;
      for (int it = gw; it < DEPTH * PER; it += NGW) {
          const int layer = it / PER; int r = it % PER;
          if (r < I_IN) { transpose_item(Pp->in[8] + (size_t)layer * D * INW, D, INW, (bf16_t*)(ws + WS_WIN) + (size_t)layer * INW * D, scr, r, lane, MapIn{}); continue; } r -= I_IN;
          if (r < I_OUT) { transpose_item(Pp->in[21] + (size_t)layer * D * D, D, D, (bf16_t*)(ws + WS_WOUT) + (size_t)layer * D * D, scr, r, lane, MapId{}); continue; } r -= I_OUT;
          if (r < I_G) { transpose_item(Pp->in[22] + (size_t)layer * D * FF, D, FF, (bf16_t*)(ws + WS_WGU) + (size_t)layer * GU * D, scr, r, lane, MapGU{0}); continue; } r -= I_G;
          if (r < I_G) { transpose_item(Pp->in[23] + (size_t)layer * D * FF, D, FF, (bf16_t*)(ws + WS_WGU) + (size_t)layer * GU * D, scr, r, lane, MapGU{1}); continue; } r -= I_G;
          transpose_item(Pp->in[24] + (size_t)layer * FF * D, FF, D, (bf16_t*)(ws + WS_WD) + (size_t)layer * D * FF, scr, r, lane, MapId{}); } }
}

__device__ __forceinline__ void p0b(int G, const int wave_s) {
    FRESH_IDS; FRESH_KP;
    unsigned char* ws = Pp->ws; const int gt = blockIdx.x * NTHR + tid, NGT = G * NTHR;
    const float* MODP = (const float*)(ws + WS_MODP); float* MOD = (float*)(ws + WS_MOD);
    constexpr int NTOT = DEPTH * 3 * 6 * D;
    for (int i = gt; i < NTOT; i += NGT) { const int layer = i / (3 * 6 * D), n = i % (6 * D); float s = Pp->in[7][(size_t)layer * 6 * D + n];
#pragma unroll
        for (int kc = 0; kc < MOD_KC; ++kc) { const int rest = i % (3 * 6 * D); s += MODP[((size_t)(kc * DEPTH + layer) * 3) * 6 * D + rest]; }
        MOD[i] = s; }
}

__device__ __forceinline__ void p0c(LAS unsigned char* lds, int G, const int wave_s) {
    FRESH_IDS; FRESH_KP;
    unsigned char* ws = Pp->ws;
    const int gw = blockIdx.x * NWAVES + wave, NGW = G * NWAVES;
    const int gt = blockIdx.x * NTHR + tid, NGT = G * NTHR;
    const float* MOD = (const float*)(ws + WS_MOD);
    { float* GMV = (float*)(ws + WS_GMV);
      for (int i = gt; i < DEPTH * 2 * 3 * D; i += NGT) { const int c = i % D, v = (i / D) % 3, which = (i / (3 * D)) % 2, layer = i / (6 * D);
          const float g = which ? Pp->in[5][layer * D + c] : Pp->in[4][layer * D + c];
          GMV[i] = g * (1.0f + MOD[((size_t)layer * 3 + v) * 6 * D + (which ? 4 : 1) * D + c]); } }
    { constexpr int PER = (INW + GU) / 32;
      for (int it = gw; it < DEPTH * PER; it += NGW) { const int layer = it / PER, r0 = (it % PER) * 32; const bool isin = r0 < INW;
          const bf16_t* wbase = isin ? (const bf16_t*)(ws + WS_WIN) + ((size_t)layer * INW + r0) * D : (const bf16_t*)(ws + WS_WGU) + ((size_t)layer * GU + (r0 - INW)) * D;
          const float* sh = MOD + (size_t)layer * 3 * 6 * D + (isin ? 0 : 3) * D;
          float k0 = 0.f, k1 = 0.f, k2 = 0.f;
#pragma nounroll
          for (int rr = 0; rr < 32; ++rr) { const bf16_t* wrow = wbase + (size_t)rr * D;
              float a0 = 0.f, a1 = 0.f, a2 = 0.f;
#pragma unroll
              for (int j = 0; j < 4; ++j) { const int k = lane * 8 + 512 * j; const u32x4 w = *(const u32x4*)(wrow + k);
                  const float wf[8] = {bf_lo(w.x), bf_hi(w.x), bf_lo(w.y), bf_hi(w.y), bf_lo(w.z), bf_hi(w.z), bf_lo(w.w), bf_hi(w.w)};
#pragma unroll
                  for (int e = 0; e < 8; ++e) { a0 += wf[e] * sh[k + e]; a1 += wf[e] * sh[6 * D + k + e]; a2 += wf[e] * sh[12 * D + k + e]; } }
              a0 = wave_sum(a0); a1 = wave_sum(a1); a2 = wave_sum(a2);
              if (lane == rr) { k0 = a0; k1 = a1; k2 = a2; } }
          if (lane < 32) { float* o = isin ? (float*)(ws + WS_SHWIN) + (size_t)layer * 3 * INW + r0 + lane : (float*)(ws + WS_SHWGU) + (size_t)layer * 3 * GU + (r0 - INW) + lane;
              const int st = isin ? INW : GU; o[0] = k0; o[st] = k1; o[2 * st] = k2; } } }
    { const float* X = (const float*)(ws + WS_X); bf16_t* AN = (bf16_t*)(ws + WS_AN); float* SSQ = (float*)(ws + WS_SSQ);
      for (int row = gw; row < MT; row += NGW) { const int v = vec_of_row(row); const float* xr = X + (size_t)row * D; float s = 0.f;
#pragma unroll
          for (int j = 0; j < 4; ++j) { const int c = lane * 8 + 512 * j; const f32x4 a = *(const f32x4*)(xr + c), b = *(const f32x4*)(xr + c + 4);
              s += (a[0] * a[0] + a[1] * a[1]) + (a[2] * a[2] + a[3] * a[3]) + (b[0] * b[0] + b[1] * b[1]) + (b[2] * b[2] + b[3] * b[3]);
              float gm[8];
#pragma unroll
              for (int e = 0; e < 8; ++e) gm[e] = Pp->in[4][c + e] * (1.0f + MOD[(size_t)v * 6 * D + 1 * D + c + e]);
              u32x4 w; w.x = pk2(a[0] * gm[0], a[1] * gm[1]); w.y = pk2(a[2] * gm[2], a[3] * gm[3]); w.z = pk2(b[0] * gm[4], b[1] * gm[5]); w.w = pk2(b[2] * gm[6], b[3] * gm[7]);
              *(u32x4*)(AN + (size_t)row * D + c) = w; }
          s = wave_sum(s);
          if (lane < 32) SSQ[((size_t)(lane >> 2) * MT + row) * 4 + (lane & 3)] = lane == 0 ? s : 0.f; } }
    { constexpr int CB = HY / 8, IT_L = (SEQ / 512) * CB, IT_C = CB, PER = IT_L + IT_C;
      for (int it = blockIdx.x; it < DEPTH * PER; it += G) {
          const int layer = it / PER; int r = it % PER; const bool isc = r >= IT_L; if (isc) r -= IT_L;
          const int cb = r % CB, lb = r / CB, c0 = cb * 8, L = isc ? CTX : SEQ, l = lb * 512 + tid;
          const float* w3 = Pp->in[15] + (size_t)layer * FH * 4096 + c0;
          if (l < L) {
              const float* hp = (isc ? (const float*)(ws + WS_HIDC) + ((size_t)layer * CTX + l) * FH : (const float*)(ws + WS_HIDL) + ((size_t)layer * SEQ + l) * FH);
              float acc[4][8];
#pragma unroll
              for (int od = 0; od < 4; ++od)
#pragma unroll
                  for (int e = 0; e < 8; ++e) acc[od][e] = 0.f;
#pragma nounroll
              for (int k4 = 0; k4 < 16; ++k4) { const f32x4 h4 = *(const f32x4*)(hp + 4 * k4);
#pragma unroll
                  for (int kk = 0; kk < 4; ++kk) { const float* wk = w3 + (size_t)(4 * k4 + kk) * 4096;
#pragma unroll
                      for (int od = 0; od < 4; ++od)
#pragma unroll
                          for (int e = 0; e < 8; ++e) acc[od][e] += h4[kk] * wk[od * 1024 + e]; } }
              const float t = (float)l / (float)(L - 1);
              f32x2* tf = isc ? (f32x2*)(ws + WS_FLTC) + (size_t)layer * HY * CTX : (f32x2*)(ws + WS_FLT) + (size_t)layer * HY * SEQ;
              f32x2* tb = isc ? (f32x2*)(ws + WS_FLTC) + (size_t)(DEPTH + layer) * HY * CTX : (f32x2*)(ws + WS_FLT) + (size_t)(DEPTH + layer) * HY * SEQ;
#pragma unroll
              for (int e = 0; e < 8; ++e) { const int c = c0 + e;
                  const float dmin = -3.0701134573253945f, dmax = -15.350567286626973f;
                  const float delta = fabsf(dmin + (float)c * ((dmax - dmin) / 1023.f));
                  const float wdw = expf(-t * delta);
                  tf[(size_t)c * L + l] = (f32x2){acc[0][e] * wdw, acc[2][e] * wdw};
                  tb[(size_t)c * L + l] = l == 0 ? (f32x2){0.f, 0.f} : (f32x2){acc[1][e] * wdw, acc[3][e] * wdw}; }
          } } }
}

__device__ __forceinline__ void attn_simple(LAS unsigned char* lds, int layer, int G, int nrows, const int wave_s) {
    FRESH_IDS; FRESH_KP;
    unsigned char* ws = Pp->ws;
    const bf16_t* Q = (const bf16_t*)(ws + WS_Q); const bf16_t* Kb = (const bf16_t*)(ws + WS_K); const bf16_t* Vb = (const bf16_t*)(ws + WS_V);
    bf16_t* YM = (bf16_t*)(ws + WS_YM);
    LAS float* qs = (LAS float*)lds + wave * HD;
    LAS float* ps = (LAS float*)(lds + 4096) + wave * 640;
    LAS float* red = (LAS float*)(lds + 4096 + 8 * 640 * 4);
    const int h = wave, kv = h >> 2;
    const float sk = Pp->in[18][layer * NH + h] * LOG2E;
    const float* gat = Pp->in[20] + layer * ATTW; const float* ghy = Pp->in[19] + layer * HY; const float* ZT = (const float*)(ws + WS_SSHY);
    for (int row = blockIdx.x; row < nrows; row += G) {
        { const unsigned w = *(const unsigned*)(Q + (size_t)row * ATTW + h * HD + 2 * lane); qs[2 * lane] = bf_lo(w); qs[2 * lane + 1] = bf_hi(w); }
        int b, j0 = 0, nwin = 0;
        if (row < ML) { b = row / SEQ; const int l = row % SEQ; j0 = l - WINDOW < 0 ? 0 : l - WINDOW; const int j1 = l + WINDOW > SEQ - 1 ? SEQ - 1 : l + WINDOW; nwin = j1 - j0 + 1; }
        else b = (row - ML) / CTX;
        const int nk = nwin + CTX;
        float mx = -3.0e38f;
        for (int j = lane; j < nk; j += 64) {
            const int krow = j < nwin ? b * SEQ + j0 + j : ML + b * CTX + (j - nwin);
            const bf16_t* kr = Kb + (size_t)krow * KVW + kv * HD;
            float s = 0.f;
#pragma unroll
            for (int d = 0; d < HD; d += 8) { const u32x4 w = *(const u32x4*)(kr + d);
                s += qs[d] * bf_lo(w.x) + qs[d + 1] * bf_hi(w.x) + qs[d + 2] * bf_lo(w.y) + qs[d + 3] * bf_hi(w.y) + qs[d + 4] * bf_lo(w.z) + qs[d + 5] * bf_hi(w.z) + qs[d + 6] * bf_lo(w.w) + qs[d + 7] * bf_hi(w.w); }
            ps[j] = s; mx = fmaxf(mx, s);
        }
        mx = fmaxf(wave_max(mx), sk);
        float sum = 0.f;
        for (int j = lane; j < nk; j += 64) { const float e = __builtin_amdgcn_exp2f(ps[j] - mx); ps[j] = e; sum += e; }
        sum = wave_sum(sum) + __builtin_amdgcn_exp2f(sk - mx);
        float o0 = 0.f, o1 = 0.f;
        for (int j = 0; j < nk; ++j) {
            const int krow = j < nwin ? b * SEQ + j0 + j : ML + b * CTX + (j - nwin);
            const unsigned w = *(const unsigned*)(Vb + (size_t)krow * KVW + kv * HD + 2 * lane);
            const float pj = ps[j]; o0 += pj * bf_lo(w); o1 += pj * bf_hi(w);
        }
        const float inv = 1.f / sum; o0 *= inv; o1 *= inv;
        const float part = wave_sum(o0 * o0 + o1 * o1);
        const float z0 = ZT[(size_t)(2 * tid) * MT + row], z1 = ZT[(size_t)(2 * tid + 1) * MT + row];
        const float parth = wave_sum(z0 * z0 + z1 * z1);
        __syncthreads();
        if (lane == 0) { red[wave] = part; red[8 + wave] = parth; }
        __syncthreads();
        float tot = 0.f, toth = 0.f;
#pragma unroll
        for (int i = 0; i < 8; ++i) { tot += red[i]; toth += red[8 + i]; }
        const float r = 1.0f / sqrtf(tot * (1.0f / ATTW) + EPS), rh = 1.0f / sqrtf(toth * (1.0f / HY) + EPS);
        const int c = h * HD + 2 * lane;
        *(unsigned*)(YM + (size_t)row * D + HY + c) = pk2(o0 * r * gat[c], o1 * r * gat[c + 1]);
        *(unsigned*)(YM + (size_t)row * D + 2 * tid) = pk2(z0 * rh * ghy[2 * tid], z1 * rh * ghy[2 * tid + 1]);
    }
    __syncthreads();
}

__device__ __forceinline__ float phy_at(const bf16_t* PHY, int row, int ch) { return bf1(PHY[((size_t)(ch >> 2) * MT + row) * 4 + (ch & 3)]); }
__device__ __forceinline__ float sconv(const bf16_t* PHY, const float* cw, const float* cb, int row, int ch, int l, int L) {
    float a = cb[ch] + cw[3 * HY + ch] * phy_at(PHY, row, ch);
    if (l > 0) a += cw[ch] * phy_at(PHY, row - 1, ch);
    if (l < L - 1) a += cw[2 * 3 * HY + ch] * phy_at(PHY, row + 1, ch);
    return a;
}
template <int L>
__device__ __forceinline__ void hyena_direct(LAS unsigned char* lds, int layer, int G, int row_base, const int wave_s) {
    FRESH_IDS; FRESH_KP;
    unsigned char* ws = Pp->ws;
    constexpr int TPB = L < NTHR ? L : NTHR, NI = L / TPB;
    const bf16_t* PHY = (const bf16_t*)(ws + WS_PHY); float* ZT = (float*)(ws + WS_SSHY);
    const f32x2* TF = L == SEQ ? (const f32x2*)(ws + WS_FLT) + (size_t)layer * HY * SEQ : (const f32x2*)(ws + WS_FLTC) + (size_t)layer * HY * CTX;
    const f32x2* TB = L == SEQ ? (const f32x2*)(ws + WS_FLT) + (size_t)(DEPTH + layer) * HY * SEQ : (const f32x2*)(ws + WS_FLTC) + (size_t)(DEPTH + layer) * HY * CTX;
    const float* cw = Pp->in[9] + (size_t)layer * 3 * 3 * HY; const float* cb = Pp->in[10] + (size_t)layer * 3 * HY;
    const float* fbias = Pp->in[17] + (size_t)layer * 2 * HY;
    LAS float* G0 = (LAS float*)lds; LAS float* G1 = G0 + 2 * L; LAS float* z = G1 + 2 * L;
    for (int it = blockIdx.x; it < HY * BATCH; it += G) {
        const int c = it % HY, seq = it / HY, row0 = row_base + seq * L;
        __syncthreads();
#pragma nounroll
        for (int d = tid; d < L; d += NTHR) {
            { const f32x2 f = TF[(size_t)c * L + d]; G0[L - 1 + d] = f.x; G1[L - 1 + d] = f.y; }
            if (d > 0) { const f32x2 bk = TB[(size_t)c * L + d]; G0[L - 1 - d] = bk.x; G1[L - 1 - d] = bk.y; }
            z[d] = sconv(PHY, cw, cb, row0 + d, 2 * HY + c, d, L);
        }
        __syncthreads();
#pragma unroll
        for (int o = 0; o < 2; ++o) {
            LAS float* Gg = o ? G1 : G0;
            float acc[NI], zn[NI];
#pragma unroll
            for (int i = 0; i < NI; ++i) acc[i] = 0.f;
            if (tid < TPB) {
                for (int s = 0; s < L; ++s) { const float zs = z[s];
#pragma unroll
                    for (int i = 0; i < NI; ++i) acc[i] += zs * Gg[tid + TPB * i - s + L - 1]; }
                const float fb = fbias[o * HY + c];
#pragma nounroll
                for (int i = 0; i < NI; ++i) { const int t = tid + TPB * i; zn[i] = sconv(PHY, cw, cb, row0 + t, o * HY + c, t, L) * (acc[i] + fb * z[t]); }
            }
            __syncthreads();
            if (tid < TPB) {
#pragma unroll
                for (int i = 0; i < NI; ++i) z[tid + TPB * i] = zn[i];
            }
            __syncthreads();
        }
        if (tid < TPB) {
#pragma unroll
            for (int i = 0; i < NI; ++i) { const int t = tid + TPB * i; ZT[(size_t)c * MT + row0 + t] = z[t]; } }
    }
    __syncthreads();
}

constexpr int FN = 8192, FPAD = FN + FN / 32;
__device__ __forceinline__ int fpad(int p) { return p + (p >> 5); }
__device__ __forceinline__ f32x2 cmul(f32x2 a, f32x2 b) { return (f32x2){a.x * b.x - a.y * b.y, a.x * b.y + a.y * b.x}; }
__device__ __forceinline__ f32x2 cmulc(f32x2 a, f32x2 b) { return (f32x2){a.x * b.x + a.y * b.y, a.y * b.x - a.x * b.y}; }
template <bool INV> __device__ __forceinline__ f32x2 cmul_tw(f32x2 a, f32x2 w) { return INV ? cmulc(a, w) : cmul(a, w); }
template <bool INV> __device__ __forceinline__ void dft4(f32x2& x0, f32x2& x1, f32x2& x2, f32x2& x3) {
    const f32x2 t0 = x0 + x2, t1 = x0 - x2, t2 = x1 + x3, t3 = x1 - x3;
    const f32x2 jt3 = INV ? (f32x2){-t3.y, t3.x} : (f32x2){t3.y, -t3.x};
    x0 = t0 + t2; x2 = t0 - t2; x1 = t1 + jt3; x3 = t1 - jt3;
}
template <bool INV> __device__ __forceinline__ void dft16(f32x2 (&x)[16]) {
    constexpr float C1 = 0.92387953251128674f, S1 = 0.38268343236508977f, C2 = 0.70710678118654752f;
#pragma unroll
    for (int b = 0; b < 4; ++b) dft4<INV>(x[b], x[4 + b], x[8 + b], x[12 + b]);
    const f32x2 w1 = {C1, -S1}, w2 = {C2, -C2}, w3 = {S1, -C1}, w4 = {0.f, -1.f}, w6 = {-C2, -C2}, w9 = {-C1, S1};
    x[4 * 1 + 1] = cmul_tw<INV>(x[5], w1); x[4 * 1 + 2] = cmul_tw<INV>(x[6], w2); x[4 * 1 + 3] = cmul_tw<INV>(x[7], w3);
    x[4 * 2 + 1] = cmul_tw<INV>(x[9], w2); x[4 * 2 + 2] = cmul_tw<INV>(x[10], w4); x[4 * 2 + 3] = cmul_tw<INV>(x[11], w6);
    x[4 * 3 + 1] = cmul_tw<INV>(x[13], w3); x[4 * 3 + 2] = cmul_tw<INV>(x[14], w6); x[4 * 3 + 3] = cmul_tw<INV>(x[15], w9);
#pragma unroll
    for (int c = 0; c < 4; ++c) dft4<INV>(x[4 * c], x[4 * c + 1], x[4 * c + 2], x[4 * c + 3]);
    f32x2 y[16];
#pragma unroll
    for (int k = 0; k < 16; ++k) y[k] = x[4 * (k & 3) + (k >> 2)];
#pragma unroll
    for (int k = 0; k < 16; ++k) x[k] = y[k];
}
template <bool INV> __device__ __forceinline__ void dft32(f32x2 (&x)[32]) {
    constexpr float CS[16] = {1.f, 0.98078528040323043f, 0.92387953251128674f, 0.83146961230254524f, 0.70710678118654752f, 0.55557023301960218f, 0.38268343236508977f, 0.19509032201612825f,
                              0.f, -0.19509032201612825f, -0.38268343236508977f, -0.55557023301960218f, -0.70710678118654752f, -0.83146961230254524f, -0.92387953251128674f, -0.98078528040323043f};
    constexpr float SN[16] = {0.f, 0.19509032201612825f, 0.38268343236508977f, 0.55557023301960218f, 0.70710678118654752f, 0.83146961230254524f, 0.92387953251128674f, 0.98078528040323043f,
                              1.f, 0.98078528040323043f, 0.92387953251128674f, 0.83146961230254524f, 0.70710678118654752f, 0.55557023301960218f, 0.38268343236508977f, 0.19509032201612825f};
    f32x2 a[16], b[16];
#pragma unroll
    for (int j = 0; j < 16; ++j) { a[j] = x[j] + x[j + 16]; const f32x2 d = x[j] - x[j + 16]; b[j] = cmul_tw<INV>(d, (f32x2){CS[j], -SN[j]}); }
    dft16<INV>(a); dft16<INV>(b);
#pragma unroll
    for (int k = 0; k < 16; ++k) { x[2 * k] = a[k]; x[2 * k + 1] = b[k]; }
}
__device__ __forceinline__ void tw_powers(f32x2 w1, f32x2 (&w)[16]) {
    w[1] = w1; w[2] = cmul(w1, w1); w[3] = cmul(w[2], w1); w[4] = cmul(w[2], w[2]); w[5] = cmul(w[4], w1); w[6] = cmul(w[3], w[3]); w[7] = cmul(w[4], w[3]);
    w[8] = cmul(w[4], w[4]); w[9] = cmul(w[8], w1); w[10] = cmul(w[5], w[5]); w[11] = cmul(w[8], w[3]); w[12] = cmul(w[6], w[6]); w[13] = cmul(w[8], w[5]); w[14] = cmul(w[7], w[7]); w[15] = cmul(w[8], w[7]);
}
__device__ __forceinline__ f32x2 tw_base(float turns) { asm volatile("" : "+v"(turns)); return (f32x2){__builtin_amdgcn_cosf(turns), -__builtin_amdgcn_sinf(turns)}; }
__device__ __forceinline__ void fft_fwd1(f32x2 (&x)[16], LAS f32x2* B, int n2) {
    asm volatile("" : "+v"(n2));
    dft16<false>(x); f32x2 w[16]; tw_powers(tw_base((float)n2 * (1.0f / 8192.f)), w);
    B[fpad(n2)] = x[0];
#pragma unroll
    for (int k = 1; k < 16; ++k) B[fpad(512 * k + n2)] = cmul(x[k], w[k]);
}
__device__ __forceinline__ void fft_fwd2(LAS f32x2* B, int tid) {
    asm volatile("" : "+v"(tid));
    const int b = tid >> 5, n2 = tid & 31, base = 512 * b + n2; f32x2 x[16];
#pragma unroll
    for (int r = 0; r < 16; ++r) x[r] = B[fpad(base + 32 * r)];
    dft16<false>(x); f32x2 w[16]; tw_powers(tw_base((float)n2 * (1.0f / 512.f)), w);
    B[fpad(base)] = x[0];
#pragma unroll
    for (int k = 1; k < 16; ++k) B[fpad(base + 32 * k)] = cmul(x[k], w[k]);
}
__device__ __forceinline__ void fft_fwd3(LAS f32x2* B, int tid) {
    asm volatile("" : "+v"(tid));
    if (tid < 256) { f32x2 x[32]; LAS f32x2* p = B + 33 * tid;
#pragma unroll
        for (int j = 0; j < 32; ++j) x[j] = p[j];
        dft32<false>(x);
#pragma unroll
        for (int j = 0; j < 32; ++j) p[j] = x[j]; }
}
template <int ORD> __device__ __forceinline__ void fft_mid(LAS f32x2* B, const LAS f32x2* F, int tid) {
    asm volatile("" : "+v"(tid));
    if (tid < 256) { f32x2 x[32]; LAS f32x2* p = B + 33 * tid;
#pragma unroll
        for (int j = 0; j < 32; ++j) x[j] = p[j];
        __builtin_amdgcn_sched_barrier(0); dft32<false>(x); __builtin_amdgcn_sched_barrier(0);
        const int k1 = tid >> 4, k2 = tid & 15, kb1 = (16 - k1) & 15, b1 = k1 != 0 ? 1 : 0, kb2 = (16 - k2 - b1) & 15, b2 = (k2 != 0 || b1) ? 1 : 0;
        const LAS f32x2* fa = F + 33 * tid; const LAS f32x2* fb = F + 33 * (16 * kb1 + kb2); const LAS f32x2* fbq = fb + (1 - b2);
        constexpr float SC = 1.0f / (2.0f * (float)FN);
#pragma unroll
        for (int j = 0; j < 32; ++j) { const f32x2 A = fa[j], Bm = j == 0 ? (b2 ? fb[31] : fa[0]) : fbq[31 - j];
            const f32x2 H = ORD == 0 ? (f32x2){(A.x + Bm.x) * SC, (A.y - Bm.y) * SC} : (f32x2){(A.y + Bm.y) * SC, (Bm.x - A.x) * SC};
            x[j] = cmul(x[j], H); if ((j & 7) == 7) __builtin_amdgcn_sched_barrier(0); }
        dft32<true>(x); __builtin_amdgcn_sched_barrier(0);
#pragma unroll
        for (int j = 0; j < 32; ++j) p[j] = x[j]; }
}
__device__ __forceinline__ void fft_inv2(LAS f32x2* B, int tid) {
    asm volatile("" : "+v"(tid));
    const int b = tid >> 5, n2 = tid & 31, base = 512 * b + n2; f32x2 x[16]; f32x2 w[16]; tw_powers(tw_base((float)n2 * (1.0f / 512.f)), w);
    x[0] = B[fpad(base)];
#pragma unroll
    for (int k = 1; k < 16; ++k) x[k] = cmulc(B[fpad(base + 32 * k)], w[k]);
    dft16<true>(x);
#pragma unroll
    for (int r = 0; r < 16; ++r) B[fpad(base + 32 * r)] = x[r];
}
__device__ __forceinline__ void fft_inv1(f32x2 (&x)[16], const LAS f32x2* B, int n2) {
    asm volatile("" : "+v"(n2));
    f32x2 w[16]; tw_powers(tw_base((float)n2 * (1.0f / 8192.f)), w);
    x[0] = B[fpad(n2)];
#pragma unroll
    for (int k = 1; k < 16; ++k) x[k] = cmulc(B[fpad(512 * k + n2)], w[k]);
    dft16<true>(x);
}
#define WG_SYNC() do { asm volatile("s_waitcnt lgkmcnt(0)" ::: "memory"); __builtin_amdgcn_s_barrier(); asm volatile("" ::: "memory"); } while (0)
__device__ __forceinline__ void hy_stage(LAS float* plane, const bf16_t* PHY, int cg, int jc, int tid) {
    asm volatile("" : "+v"(tid));
    const u32x4* src = (const u32x4*)(PHY + (size_t)cg * MT * 4);
#pragma unroll
    for (int k = 0; k < 8; ++k) { const int i = tid + 512 * k; const u32x4 v = src[i];
        const unsigned w0 = (jc & 2) ? v.y : v.x, w1 = (jc & 2) ? v.w : v.z;
        f32x2 o; o.x = (jc & 1) ? bf_hi(w0) : bf_lo(w0); o.y = (jc & 1) ? bf_hi(w1) : bf_lo(w1);
        *(LAS f32x2*)(plane + 2 * i) = o; }
}
__device__ __forceinline__ void hy_sconv(const LAS float* plane, float w0, float w1, float w2, float cb, int n2, float (&u)[8][2]) {
    asm volatile("" : "+v"(n2));
#pragma unroll
    for (int r = 0; r < 8; ++r)
#pragma unroll
        for (int b = 0; b < 2; ++b) { const int t = n2 + 512 * r, row = b * SEQ + t;
            float a = cb + w1 * plane[row];
            if (t > 0) a += w0 * plane[row - 1];
            if (t < SEQ - 1) a += w2 * plane[row + 1];
            u[r][b] = a; }
}
__device__ __forceinline__ void hyena_fft(LAS unsigned char* lds, int layer, int G, const int wave_s) {
    FRESH_IDS; FRESH_KP;
    unsigned char* ws = Pp->ws;
    const bf16_t* PHY = (const bf16_t*)(ws + WS_PHY); float* ZT = (float*)(ws + WS_SSHY);
    const f32x2* TF = (const f32x2*)(ws + WS_FLT) + (size_t)layer * HY * SEQ; const f32x2* TB = (const f32x2*)(ws + WS_FLT) + (size_t)(DEPTH + layer) * HY * SEQ;
    const float* cw = Pp->in[9] + (size_t)layer * 3 * 3 * HY; const float* cb = Pp->in[10] + (size_t)layer * 3 * HY; const float* fbias = Pp->in[17] + (size_t)layer * 2 * HY;
    LAS f32x2* Db = (LAS f32x2*)lds; LAS f32x2* Fb = Db + FPAD;
    LAS float* pl0 = (LAS float*)lds; LAS float* pl1 = pl0 + 2 * SEQ;
    const int n2 = tid;
    for (int unit = blockIdx.x; unit < HY / 4; unit += G) {
#pragma nounroll
        for (int jc = 0; jc < 4; ++jc) { const int c = 4 * unit + jc;
            WG_SYNC();
            { f32x2 x[16]; const f32x2* tf = TF + (size_t)c * SEQ; const f32x2* tb = TB + (size_t)c * SEQ;
#pragma unroll
              for (int r = 0; r < 8; ++r) x[r] = tf[n2 + 512 * r];
#pragma unroll
              for (int r = 8; r < 16; ++r) { const int l = FN - 512 * r - n2; x[r] = l < SEQ ? tb[l] : (f32x2){0.f, 0.f}; }
              __builtin_amdgcn_sched_barrier(0); fft_fwd1(x, Fb, n2); __builtin_amdgcn_sched_barrier(0); }
            hy_stage(pl0, PHY, 2 * (HY / 4) + unit, jc, tid); __builtin_amdgcn_sched_barrier(0); hy_stage(pl1, PHY, unit, jc, tid); __builtin_amdgcn_sched_barrier(0);
            WG_SYNC();
            float uz[8][2], ux[8][2];
            hy_sconv(pl0, cw[2 * HY + c], cw[3 * HY + 2 * HY + c], cw[6 * HY + 2 * HY + c], cb[2 * HY + c], n2, uz);
            __builtin_amdgcn_sched_barrier(0); hy_sconv(pl1, cw[c], cw[3 * HY + c], cw[6 * HY + c], cb[c], n2, ux); __builtin_amdgcn_sched_barrier(0);
            fft_fwd2(Fb, tid); __builtin_amdgcn_sched_barrier(0);
            WG_SYNC();
            fft_fwd3(Fb, tid); __builtin_amdgcn_sched_barrier(0);
            f32x2 x[16];
#pragma unroll
            for (int r = 0; r < 8; ++r) { x[r] = (f32x2){uz[r][0], uz[r][1]}; x[r + 8] = (f32x2){0.f, 0.f}; }
            fft_fwd1(x, Db, n2); WG_SYNC(); fft_fwd2(Db, tid); WG_SYNC(); fft_mid<0>(Db, Fb, tid); WG_SYNC(); fft_inv2(Db, tid); WG_SYNC(); fft_inv1(x, Db, n2);
            { const float fb0 = fbias[c];
#pragma unroll
              for (int r = 0; r < 8; ++r) { uz[r][0] = ux[r][0] * (x[r].x + fb0 * uz[r][0]); uz[r][1] = ux[r][1] * (x[r].y + fb0 * uz[r][1]); } }
            WG_SYNC();
            hy_stage(pl0, PHY, (HY / 4) + unit, jc, tid);
            WG_SYNC();
            hy_sconv(pl0, cw[HY + c], cw[3 * HY + HY + c], cw[6 * HY + HY + c], cb[HY + c], n2, ux);
            WG_SYNC();
#pragma unroll
            for (int r = 0; r < 8; ++r) { x[r] = (f32x2){uz[r][0], uz[r][1]}; x[r + 8] = (f32x2){0.f, 0.f}; }
            fft_fwd1(x, Db, n2); WG_SYNC(); fft_fwd2(Db, tid); WG_SYNC(); fft_mid<1>(Db, Fb, tid); WG_SYNC(); fft_inv2(Db, tid); WG_SYNC(); fft_inv1(x, Db, n2);
            { const float fb1 = fbias[HY + c]; float* zo = ZT + (size_t)c * MT;
#pragma unroll
              for (int r = 0; r < 8; ++r) { const int t = n2 + 512 * r;
                  zo[t] = ux[r][0] * (x[r].x + fb1 * uz[r][0]); zo[SEQ + t] = ux[r][1] * (x[r].y + fb1 * uz[r][1]); } }
        }
    }
    WG_SYNC();
}

using f32x16 = __attribute__((ext_vector_type(16))) float;
using s16x4 = __attribute__((ext_vector_type(4))) short;
using bf16x8 = pg8::bf16x8;
#define AT_KSWZ(row, colB) ((row) * 256 + ((colB) ^ (((row) & 7) << 4)))
__device__ __forceinline__ int crow(int r, int hi) { return (r & 3) + 8 * (r >> 2) + 4 * hi; }
__device__ __forceinline__ unsigned cvtpk(float lo, float hi) { unsigned r; asm volatile("v_cvt_pk_bf16_f32 %0, %1, %2" : "=v"(r) : "v"(lo), "v"(hi)); return r; }
__device__ __forceinline__ int v_st(int k, int c) { const int kk = (k & ~0xC) | ((k & 4) << 1) | ((k & 8) >> 1); return ((kk >> 3) * 4 + (c >> 5)) * 512 + ((kk & 7) * 32 + (c & 31)) * 2; }
__device__ __forceinline__ int v_rd_base(int lane) { return ((lane & 3) << 3) | (((lane >> 2) & 3) << 6) | (((lane >> 4) & 1) << 5) | (((lane >> 5) & 1) << 8); }
constexpr int v_rd_off(int d0, int ks, int half) { return d0 * 512 + ks * 4096 + half * 2048; }
template <int OFF> __device__ __forceinline__ s16x4 tr_read(int vb) { s16x4 r; asm volatile("ds_read_b64_tr_b16 %0, %1 offset:%2" : "=&v"(r) : "v"(vb), "i"(OFF) : "memory"); return r; }
template <int D0> __device__ __forceinline__ void pv_one(f32x16& od, int vb, bf16x8 pa0, bf16x8 pa1) {
    const s16x4 l0 = tr_read<v_rd_off(D0, 0, 0)>(vb), h0 = tr_read<v_rd_off(D0, 0, 1)>(vb), l1 = tr_read<v_rd_off(D0, 1, 0)>(vb), h1 = tr_read<v_rd_off(D0, 1, 1)>(vb);
    asm volatile("s_waitcnt lgkmcnt(0)" ::: "memory"); __builtin_amdgcn_sched_barrier(0);
#define AT_PK(L, H) (bf16x8){L[0], L[1], L[2], L[3], H[0], H[1], H[2], H[3]}
    od = __builtin_amdgcn_mfma_f32_32x32x16_bf16(pa0, AT_PK(l0, h0), od, 0, 0, 0);
    od = __builtin_amdgcn_mfma_f32_32x32x16_bf16(pa1, AT_PK(l1, h1), od, 0, 0, 0);
#undef AT_PK
}
constexpr int AT_BUF = 32768;
constexpr int AT_SCR = 8 * 32 * 272;
constexpr int AT_XA = AT_SCR + 2048;
constexpr int AT_XH = AT_XA + 1024;
constexpr int AT_OST = 0;
__device__ __forceinline__ void attn_mfma(LAS unsigned char* lds, int layer, int G, const int wave_s) {
    FRESH_IDS; FRESH_KP;
    unsigned char* ws = Pp->ws;
    const bf16_t* Q = (const bf16_t*)(ws + WS_Q); const bf16_t* Kb = (const bf16_t*)(ws + WS_K); const bf16_t* Vb = (const bf16_t*)(ws + WS_V);
    bf16_t* YM = (bf16_t*)(ws + WS_YM); const float* ZT = (const float*)(ws + WS_SSHY);
    const float* gat = Pp->in[20] + layer * ATTW; const float* ghy = Pp->in[19] + layer * HY;
    const int r32 = lane & 31, hi = lane >> 5, h = wave, kv = h >> 2;
    const float sk = Pp->in[18][layer * NH + h] * LOG2E;
    const unsigned lbase = (unsigned)(uintptr_t)lds;
    LAS float* al_l = (LAS float*)(lds + AT_SCR) + wave * 64; LAS float* li_l = al_l + 32;
    LAS float* xa = (LAS float*)(lds + AT_XA); LAS float* xh = (LAS float*)(lds + AT_XH);
    const int sr = tid >> 4, sc = (tid & 15) * 8;
    const int vst = v_st(sr, sc), kst = AT_KSWZ(sr, sc * 2);
    const int nunits = layer == DEPTH - 1 ? ML / 32 : MT / 32;
    for (int unit = blockIdx.x; unit < nunits; unit += G) {
        const bool isc = unit >= ML / 32;
        int b, q0, rowbase;
        if (!isc) { b = unit >> 7; q0 = (unit & 127) * 32; rowbase = b * SEQ + q0; } else { const int u = unit - ML / 32; b = u >> 3; q0 = (u & 7) * 32; rowbase = ML + b * CTX + q0; }
        int t_lo = 0, nw = 0;
        if (!isc) { t_lo = q0 < 128 ? (128 - q0) / 32 : 0; const int t_hi = (SEQ + 96 - q0) / 32 < 8 ? (SEQ + 96 - q0) / 32 : 8; nw = t_hi - t_lo + 1; }
        const int NT = nw + CTX / 32;
        bf16x8 qr[8];
        { const bf16_t* qp = Q + (size_t)(rowbase + r32) * ATTW + h * HD + hi * 8;
#pragma unroll
          for (int d0 = 0; d0 < 8; ++d0) qr[d0] = *(const bf16x8*)(qp + d0 * 16); }
        float m_reg = sk, l_reg = 1.0f; f32x16 o[4];
#pragma unroll
        for (int d = 0; d < 4; ++d)
#pragma unroll
            for (int r = 0; r < 16; ++r) o[d][r] = 0.f;
        bf16x8 s_k0, s_k1, s_v0, s_v1;
#define AT_KEYROW(i) ((i) < nw ? b * SEQ + q0 - 128 + 32 * (t_lo + (i)) : ML + b * CTX + 32 * ((i) - nw))
#define AT_SLOAD(i) do { const size_t kr_ = (size_t)(AT_KEYROW(i) + sr) * KVW + sc; s_k0 = *(const bf16x8*)(Kb + kr_); s_k1 = *(const bf16x8*)(Kb + kr_ + HD); s_v0 = *(const bf16x8*)(Vb + kr_); s_v1 = *(const bf16x8*)(Vb + kr_ + HD); } while (0)
#define AT_SWRITE(bf) do { LAS unsigned char* sb_ = lds + (bf) * AT_BUF; *(LAS bf16x8*)(sb_ + kst) = s_k0; *(LAS bf16x8*)(sb_ + 8192 + kst) = s_k1; *(LAS bf16x8*)(sb_ + 16384 + vst) = s_v0; *(LAS bf16x8*)(sb_ + 24576 + vst) = s_v1; } while (0)
        __syncthreads();
        AT_SLOAD(0); AT_SWRITE(0);
        __syncthreads();
#pragma nounroll
        for (int i = 0; i < NT; ++i) {
            const int bf = i & 1;
            if (i + 1 < NT) AT_SLOAD(i + 1);
            f32x16 p0;
#pragma unroll
            for (int r = 0; r < 16; ++r) p0[r] = 0.f;
            { const LAS unsigned char* Ks = lds + bf * AT_BUF + kv * 8192;
#pragma unroll
              for (int d0 = 0; d0 < 8; ++d0) { const int cb = (d0 * 16 + hi * 8) * 2; const bf16x8 kf = *(const LAS bf16x8*)(Ks + AT_KSWZ(r32, cb));
                  p0 = __builtin_amdgcn_mfma_f32_32x32x16_bf16(kf, qr[d0], p0, 0, 0, 0); } }
            if (i < nw) { const int t = t_lo + i;
                if (t == 0) {
#pragma unroll
                    for (int r = 0; r < 16; ++r) if (crow(r, hi) < r32) p0[r] = -1.0e30f; }
                else if (t == 8) {
#pragma unroll
                    for (int r = 0; r < 16; ++r) if (crow(r, hi) > r32) p0[r] = -1.0e30f; } }
            float pmax = p0[0];
#pragma unroll
            for (int r = 1; r < 16; ++r) pmax = fmaxf(pmax, p0[r]);
            { auto rr = __builtin_amdgcn_permlane32_swap(__float_as_uint(pmax), __float_as_uint(pmax), false, false); pmax = fmaxf(__uint_as_float(rr[0]), __uint_as_float(rr[1])); }
            const float mn = fmaxf(m_reg, pmax), alpha = __builtin_amdgcn_exp2f(m_reg - mn); m_reg = mn;
            float ps = 0.f;
#pragma unroll
            for (int r = 0; r < 16; ++r) { p0[r] = __builtin_amdgcn_exp2f(p0[r] - mn); ps += p0[r]; }
            { auto rr = __builtin_amdgcn_permlane32_swap(__float_as_uint(ps), __float_as_uint(ps), false, false); ps = __uint_as_float(rr[0]) + __uint_as_float(rr[1]); }
            l_reg = l_reg * alpha + ps;
            if (__any(alpha < 1.f)) { if (hi == 0) al_l[r32] = alpha; asm volatile("s_waitcnt lgkmcnt(0)" ::: "memory");
#pragma unroll
                for (int d = 0; d < 4; ++d)
#pragma unroll
                    for (int r = 0; r < 16; ++r) o[d][r] *= al_l[crow(r, hi)]; }
            bf16x8 pa0, pa1;
#define AT_PK4(P, BASE, OUT) do { unsigned a0 = cvtpk(P[BASE + 0], P[BASE + 1]), a1 = cvtpk(P[BASE + 2], P[BASE + 3]); unsigned b0 = cvtpk(P[BASE + 4], P[BASE + 5]), b1 = cvtpk(P[BASE + 6], P[BASE + 7]); \
    auto r0 = __builtin_amdgcn_permlane32_swap(a0, b0, false, false); auto r1 = __builtin_amdgcn_permlane32_swap(a1, b1, false, false); u32x4 w = {r0[0], r1[0], r0[1], r1[1]}; OUT = *reinterpret_cast<bf16x8*>(&w); } while (0)
            AT_PK4(p0, 0, pa0); AT_PK4(p0, 8, pa1);
#undef AT_PK4
            { const int vb = (int)(lbase + bf * AT_BUF + 16384 + kv * 8192) + v_rd_base(lane);
              pv_one<0>(o[0], vb, pa0, pa1); pv_one<1>(o[1], vb, pa0, pa1); pv_one<2>(o[2], vb, pa0, pa1); pv_one<3>(o[3], vb, pa0, pa1); }
            if (i + 1 < NT) AT_SWRITE(bf ^ 1);
            __syncthreads();
        }
#undef AT_SLOAD
#undef AT_SWRITE
#undef AT_KEYROW
        if (hi == 0) li_l[r32] = l_reg; asm volatile("s_waitcnt lgkmcnt(0)" ::: "memory");
        float part[16];
#pragma unroll
        for (int r = 0; r < 16; ++r) { const float rl = __builtin_amdgcn_rcpf(li_l[crow(r, hi)]); float s = 0.f;
#pragma unroll
            for (int d = 0; d < 4; ++d) { o[d][r] *= rl; s += o[d][r] * o[d][r]; }
#pragma unroll
            for (int m = 1; m < 32; m <<= 1) s += __shfl_xor(s, m);
            part[r] = s; }
        if (r32 == 0) {
#pragma unroll
            for (int r = 0; r < 16; ++r) xa[wave * 32 + crow(r, hi)] = part[r]; }
        const int cgp = wave * 2 + hi, c0 = cgp * 64;
        float zv[64]; float sh = 0.f;
        { const float* zp = ZT + (size_t)c0 * MT + rowbase + r32;
#pragma unroll
          for (int j = 0; j < 64; ++j) { zv[j] = zp[(size_t)j * MT]; sh += zv[j] * zv[j]; } }
        xh[cgp * 32 + r32] = sh;
        __syncthreads();
        float ta = 0.f, th = 0.f;
#pragma unroll
        for (int w = 0; w < 8; ++w) ta += xa[w * 32 + r32];
#pragma unroll
        for (int g = 0; g < 16; ++g) th += xh[g * 32 + r32];
        const float ra = 1.0f / sqrtf(ta * (1.0f / ATTW) + EPS), rh = 1.0f / sqrtf(th * (1.0f / HY) + EPS);
        { bf16_t* yp = YM + (size_t)(rowbase + r32) * D + c0;
#pragma unroll
          for (int j = 0; j < 64; j += 8) { const f32x4 g0 = *(const f32x4*)(ghy + c0 + j), g1 = *(const f32x4*)(ghy + c0 + j + 4);
              u32x4 w; w.x = pk2(zv[j] * rh * g0[0], zv[j + 1] * rh * g0[1]); w.y = pk2(zv[j + 2] * rh * g0[2], zv[j + 3] * rh * g0[3]);
              w.z = pk2(zv[j + 4] * rh * g1[0], zv[j + 5] * rh * g1[1]); w.w = pk2(zv[j + 6] * rh * g1[2], zv[j + 7] * rh * g1[3]);
              *(u32x4*)(yp + j) = w; } }
        if (hi == 0) al_l[r32] = ra; asm volatile("s_waitcnt lgkmcnt(0)" ::: "memory");
        { LAS unsigned char* ost = lds + AT_OST + wave * (32 * 272);
          float gc[4];
#pragma unroll
          for (int d = 0; d < 4; ++d) gc[d] = gat[h * HD + 32 * d + r32];
#pragma unroll
          for (int r = 0; r < 16; ++r) { const int q = crow(r, hi); const float rq = al_l[q];
#pragma unroll
              for (int d = 0; d < 4; ++d) *(LAS bf16_t*)(ost + q * 272 + (32 * d + r32) * 2) = (bf16_t)f2bf(o[d][r] * rq * gc[d]); }
          asm volatile("s_waitcnt lgkmcnt(0)" ::: "memory");
#pragma unroll
          for (int k = 0; k < 8; ++k) { const int q = k * 4 + (lane >> 4), ch = lane & 15;
              const u32x4 v = *(const LAS u32x4*)(ost + q * 272 + ch * 16);
              *(u32x4*)(YM + (size_t)(rowbase + q) * D + HY + h * HD + ch * 8) = v; } }
    }
    __syncthreads();
}

__device__ __forceinline__ void final_norm(int G, const int wave_s) {
    FRESH_IDS; FRESH_KP;
    unsigned char* ws = Pp->ws; const int gw = blockIdx.x * NWAVES + wave, NGW = G * NWAVES;
    const float* X = (const float*)(ws + WS_X); const float* SSQ = (const float*)(ws + WS_SSQ); const float* g = Pp->in[25];
    for (int row = gw; row < ML; row += NGW) {
        const float s = wave_sum(lane < 32 ? SSQ[((size_t)(lane >> 2) * MT + row) * 4 + (lane & 3)] : 0.f);
        const float r = 1.0f / sqrtf(s * (1.0f / D) + EPS);
#pragma unroll
        for (int j = 0; j < 8; ++j) { const int c = lane * 4 + 256 * j; const f32x4 x = *(const f32x4*)(X + (size_t)row * D + c), gg = *(const f32x4*)(g + c);
            *(f32x4*)(Pp->out + (size_t)row * D + c) = x * r * gg; }
    }
}

constexpr int NPHASE = 3 + 6 * DEPTH + 1;
__global__ void __launch_bounds__(NTHR, 2) mk_fwd(Params P) {
    extern __shared__ __attribute__((aligned(16))) unsigned char lds_raw[];
    LAS unsigned char* lds = (LAS unsigned char*)lds_raw;
    const int tid = threadIdx.x, G = gridDim.x, wave_s = __builtin_amdgcn_readfirstlane(tid >> 6);
    unsigned char* ws; int lo, hi; { FRESH_KP; ws = Pp->ws; lo = Pp->ph_lo; hi = Pp->ph_hi; }
    volatile LAS unsigned* MISC = (volatile LAS unsigned*)(lds + MISC_OFF);
    for (int u = tid; u < (LDS_BYTES - RING_BYTES) / 4; u += NTHR) ((LAS unsigned*)(lds + RING_BYTES))[u] = 0u;
    __syncthreads();
    XcdBarrier bar = xcd_barrier_post((unsigned*)(ws + WS_CTL) + CW_BAR, MISC + 8);
#define IN(k) (lo <= (k) && (k) < hi)
#define SEAM(k) do { if (IN(k) && IN((k) + 1)) xcd_barrier(bar, wave_s); } while (0)

    if (IN(0)) { p0a(lds, G, wave_s); } SEAM(0);
    if (IN(1)) { p0b(G, wave_s); } SEAM(1);
    if (IN(2)) { p0c(lds, G, wave_s); } SEAM(2);

    for (int layer = 0; layer < DEPTH; ++layer) {
        const int pb = 3 + 6 * layer;
#define WSL FRESH_KP; unsigned char* w = Pp->ws; const float* MODL = (const float*)(w + WS_MOD) + (size_t)layer * 3 * 6 * D; (void)MODL
        if (IN(pb)) {
            WSL;
            pg8::Gemm g{(const bf16_t*)(w + WS_AN), (const bf16_t*)(w + WS_WIN) + (size_t)layer * INW * D, MT, INW, D, D, D};
            pg8::StaticOrder S; S.init(MT, INW, G, (int)blockIdx.x);
            EpiIn E{(const float*)(w + WS_SSQ), (const float*)(w + WS_SHWIN) + (size_t)layer * 3 * INW, (bf16_t*)(w + WS_PHY), (bf16_t*)(w + WS_Q), (bf16_t*)(w + WS_K), (bf16_t*)(w + WS_V), (const float*)(w + WS_ROPE)};
            pg8::gemm_phase<EpiIn, pg8::StaticOrder, true, true>(lds, g, S, E, wave_s);
        }
        SEAM(pb);
        if (IN(pb + 1)) {
            hyena_fft(lds, layer, G, wave_s);
            if (layer != DEPTH - 1) hyena_direct<CTX>(lds, layer, G, ML, wave_s);
        }
        SEAM(pb + 1);
        if (IN(pb + 2)) {
            attn_mfma(lds, layer, G, wave_s);
        }
        SEAM(pb + 2);
        if (IN(pb + 3)) {
            WSL;
            pg8::Gemm g{(const bf16_t*)(w + WS_YM), (const bf16_t*)(w + WS_WOUT) + (size_t)layer * D * D, MT, D, D, D, D};
            pg8::StaticOrder S; S.init(MT, D, G, (int)blockIdx.x);
            EpiResid E{(float*)(w + WS_X), MODL + 2 * D, (const float*)(w + WS_GMV) + ((size_t)layer * 2 + 1) * 3 * D, (bf16_t*)(w + WS_AN), (float*)(w + WS_SSQ)};
            pg8::gemm_phase<EpiResid, pg8::StaticOrder, true, true>(lds, g, S, E, wave_s);
        }
        SEAM(pb + 3);
        if (IN(pb + 4)) {
            WSL;
            pg8::Gemm g{(const bf16_t*)(w + WS_AN), (const bf16_t*)(w + WS_WGU) + (size_t)layer * GU * D, MT, GU, D, D, D};
            pg8::StaticOrder S; S.init(MT, GU, G, (int)blockIdx.x);
            EpiGU E{(const float*)(w + WS_SSQ), (const float*)(w + WS_SHWGU) + (size_t)layer * 3 * GU, (bf16_t*)(w + WS_HB)};
            pg8::gemm_phase<EpiGU, pg8::StaticOrder, true, true>(lds, g, S, E, wave_s);
        }
        SEAM(pb + 4);
        if (IN(pb + 5)) {
            WSL;
            pg8::Gemm g{(const bf16_t*)(w + WS_HB), (const bf16_t*)(w + WS_WD) + (size_t)layer * D * FF, MT, D, FF, FF, FF};
            pg8::StaticOrder S; S.init(MT, D, G, (int)blockIdx.x);
            EpiResid E{(float*)(w + WS_X), MODL + 5 * D, layer + 1 < DEPTH ? (const float*)(w + WS_GMV) + ((size_t)(layer + 1) * 2 + 0) * 3 * D : nullptr, (bf16_t*)(w + WS_AN), (float*)(w + WS_SSQ)};
            pg8::gemm_phase<EpiResid, pg8::StaticOrder, true, true>(lds, g, S, E, wave_s);
        }
        SEAM(pb + 5);
    }
    if (IN(NPHASE - 1)) final_norm(G, wave_s);
#undef IN
#undef SEAM
}
}

#ifndef MK_N_LAUNCHES
#define MK_N_LAUNCHES 1
#endif
extern "C" void kernel_launch(void* const* d_in, const int* in_sizes, int n_in, void* d_out, int out_size, void* d_ws, size_t ws_size, hipStream_t stream) {
    using namespace mk;
    static int grid = 0;
    if (grid == 0) {
        if (n_in != 26 || ws_size < WS_END) { fprintf(stderr, "kernel_launch: need 26 inputs and %zu bytes of workspace (got %d, %zu)\n", (size_t)WS_END, n_in, ws_size); grid = -1; return; }
        int dev = 0, cus = 0, per_cu = 0;
        if (hipGetDevice(&dev) != hipSuccess || hipDeviceGetAttribute(&cus, hipDeviceAttributeMultiprocessorCount, dev) != hipSuccess) { grid = -1; return; }
        if (hipFuncSetAttribute((const void*)mk_fwd, hipFuncAttributeMaxDynamicSharedMemorySize, LDS_BYTES) != hipSuccess) { fprintf(stderr, "kernel_launch: hipFuncSetAttribute failed\n"); grid = -1; return; }
        if (hipOccupancyMaxActiveBlocksPerMultiprocessor(&per_cu, (const void*)mk_fwd, NTHR, LDS_BYTES) != hipSuccess || per_cu < 1) { fprintf(stderr, "kernel_launch: occupancy query says %d\n", per_cu); }
        (void)hipGetLastError();
        grid = cus;
    }
    if (grid < 0) return;
    (void)hipMemsetAsync((char*)d_ws + WS_CTL, 0, CTL_BYTES, stream);
    Params p{};
    for (int i = 0; i < 26; ++i) p.in[i] = (const float*)d_in[i];
    p.out = (float*)d_out; p.ws = (unsigned char*)d_ws;
#if MK_N_LAUNCHES == 1
    p.ph_lo = 0; p.ph_hi = NPHASE;
    hipLaunchKernelGGL(mk_fwd, dim3(grid), dim3(NTHR), LDS_BYTES, stream, p);
#else
    for (int ph = 0; ph < NPHASE; ++ph) { p.ph_lo = ph; p.ph_hi = ph + 1; hipLaunchKernelGGL(mk_fwd, dim3(grid), dim3(NTHR), LDS_BYTES, stream, p); }
#endif
}
```

```cpp
#include <hip/hip_runtime.h>
#include <cstdint>
#include <cstdio>
#define LAS __attribute__((address_space(3)))
#define GAS __attribute__((address_space(1)))
#define MK_LANE_ASM(l) asm volatile("v_mbcnt_lo_u32_b32 %0, -1, 0\n\tv_mbcnt_hi_u32_b32 %0, -1, %0" : "=v"(l))
namespace pg8 {
#define PG8_LAS __attribute__((address_space(3)))
typedef unsigned short bf16_t;
typedef short bf16x8 __attribute__((ext_vector_type(8)));
typedef float f32x4 __attribute__((ext_vector_type(4)));
typedef unsigned u32x4 __attribute__((ext_vector_type(4)));
constexpr int BM = 256, BK = 64, HALF = 128, HTB = HALF * BK * 2  , STAGE_BYTES = 8 * HTB, NXCD = 8, WGM = 8;

__host__ __device__ __forceinline__ int lds_byte(int r, int c) { const int st = (r >> 4) * 2 + (c >> 5), rr = r & 15, cc = c & 31, ob = rr * 64 + cc * 2; return st * 1024 + (ob ^ (((ob >> 9) & 1) << 5)); }
__host__ __device__ __forceinline__ void stage_rc(int b, int& R, int& C) { const int st = b / 1024, sb = b % 1024, swz = sb ^ (((sb >> 9) & 1) << 5); R = (st >> 1) * 16 + swz / 64; C = (st & 1) * 32 + (swz % 64) / 2; }
__host__ __device__ __forceinline__ int perm32(int rho) { const int n = rho >> 4, i = rho & 15; return 8 * (i >> 2) + 4 * n + (i & 3); }

struct Unit { int pm, pn; };
struct Gemm { const bf16_t* A; const bf16_t* Bt; int M, N, K, lda, ldb; };

struct StaticOrder {
    int nM, nN, nwg, G, c;
    __host__ __device__ void init(int M, int N, int G_, int c_) { nM = M / BM; nN = N / BM; nwg = nM * nN; G = G_; c = c_; }
    __host__ __device__ bool next(int i, Unit& u) const {
        const long L = (long)i * G + c; if (L >= nwg) return false;
        int wgid = (int)L; { const int q = nwg / NXCD, r = nwg % NXCD, xcd = wgid % NXCD, off = wgid / NXCD; wgid = (xcd < r ? xcd * (q + 1) : r * (q + 1) + (xcd - r) * q) + off; }
        const int nig = WGM * nN, gid = wgid / nig, fm = gid * WGM, gsz = (nM - fm) < WGM ? (nM - fm) : WGM;
        u.pm = fm + ((wgid % nig) % gsz); u.pn = (wgid % nig) / gsz; return true;
    }
    __device__ __forceinline__ void a_ready(const Unit&) const {}
    __device__ __forceinline__ void done(const Unit&) const {}
};

template <class Epi, class Sched, bool ALIGN_EPI = false, bool SP2 = false>
__device__ __forceinline__ void gemm_phase(PG8_LAS unsigned char* lds, const Gemm g, const Sched& S, const Epi& E, const int wave_s) {
    int lane_; MK_LANE_ASM(lane_); int wv_ = wave_s; asm volatile("" : "+s"(wv_)); const int wid = wv_, lane = lane_, tid = wid * 64 + lane, wr = wid >> 2, wc = wid & 3, fr = lane & 15, fq = lane >> 4;
    const int K = g.K, nt = K / BK;
    unsigned voffA[2], voffB[2];
#pragma unroll
    for (int i = 0; i < 2; ++i) { int R, C; stage_rc(tid * 16 + i * 8192, R, C); const int Rb = Epi::PERM ? ((R & ~31) + perm32(R & 31)) : R;
        voffA[i] = (unsigned)(R * g.lda + C) * 2u; voffB[i] = (unsigned)(Rb * g.ldb + C) * 2u; }
    const size_t kstep = (size_t)(BK * 2);
    const size_t hstepA = (size_t)HALF * g.lda * 2, hstepB = (size_t)HALF * g.ldb * 2;
    const size_t tstepA = 2 * hstepA, tstepB = 2 * hstepB;
    const unsigned ldsw = (unsigned)wid * 1024u;
    const int aoff = lds_byte(wr * 64 + fr, fq * 8), boff = lds_byte(wc * 32 + fr, fq * 8);
#define PG8_SA(b, h) (((b) * 2 + (h)) * HTB)
#define PG8_SB(b, h) ((4 + (b) * 2 + (h)) * HTB)
#define PG8_STAGE(bufoff, gbase, voff) do { _Pragma("unroll") for (int _i = 0; _i < 2; ++_i) \
        __builtin_amdgcn_global_load_lds((const unsigned*)((const char*)(gbase) + (voff)[_i]), (PG8_LAS unsigned*)(lds + (bufoff) + ldsw + _i * 8192), 16, 0, 0); } while (0)
#define PG8_LDA(dst, b, h) do { _Pragma("unroll") for (int m = 0; m < 4; ++m) _Pragma("unroll") for (int k = 0; k < 2; ++k) dst[m][k] = *(const PG8_LAS bf16x8*)(lds + PG8_SA(b, h) + aoff + m * 2048 + k * 1024); } while (0)
#define PG8_LDB(dst, b, h) do { _Pragma("unroll") for (int n = 0; n < 2; ++n) _Pragma("unroll") for (int k = 0; k < 2; ++k) dst[n][k] = *(const PG8_LAS bf16x8*)(lds + PG8_SB(b, h) + boff + n * 2048 + k * 1024); } while (0)
#define PG8_MMA(ai, bj, At, Bt) do { __builtin_amdgcn_s_setprio(1); _Pragma("unroll") for (int m = 0; m < 4; ++m) _Pragma("unroll") for (int n = 0; n < 2; ++n) _Pragma("unroll") for (int k = 0; k < 2; ++k) \
        acc[ai][bj][m][n] = __builtin_amdgcn_mfma_f32_16x16x32_bf16(Bt[n][k], At[m][k], acc[ai][bj][m][n], 0, 0, 0); __builtin_amdgcn_s_setprio(0); } while (0)
#define PG8_WAIT_V(n) asm volatile("s_waitcnt vmcnt(" #n ")" ::: "memory")
#define PG8_WAIT_L(n) asm volatile("s_waitcnt lgkmcnt(" #n ")" ::: "memory")
#define PG8_BAR __builtin_amdgcn_s_barrier()
#define PG8_SCHED __builtin_amdgcn_sched_barrier(0)
    Unit cur, nxt; int ui = 0;
    (void)S.next(0, cur);
    f32x4 acc[2][2][4][2];
#pragma unroll
    for (int a = 0; a < 2; ++a)
#pragma unroll
        for (int b = 0; b < 2; ++b)
#pragma unroll
            for (int m = 0; m < 4; ++m)
#pragma unroll
                for (int n = 0; n < 2; ++n) acc[a][b][m][n] = (f32x4){0.f, 0.f, 0.f, 0.f};
    bf16x8 At[4][2], B0[2][2], B1[2][2];
    const char* cA = (const char*)g.A + (size_t)cur.pm * tstepA; const char* cB = (const char*)g.Bt + (size_t)cur.pn * tstepB;
    S.a_ready(cur);
    if constexpr (SP2) {
        PG8_STAGE(PG8_SB(0, 0), cB, voffB); PG8_STAGE(PG8_SB(0, 1), cB + hstepB, voffB); PG8_STAGE(PG8_SA(0, 0), cA, voffA); PG8_STAGE(PG8_SA(0, 1), cA + hstepA, voffA);
        if (wr == 1) PG8_BAR;
        PG8_WAIT_V(2); PG8_BAR;
        PG8_STAGE(PG8_SB(1, 0), cB + kstep, voffB); PG8_STAGE(PG8_SA(1, 0), cA + kstep, voffA); PG8_STAGE(PG8_SB(1, 1), cB + hstepB + kstep, voffB);
        PG8_WAIT_V(6); PG8_BAR;
    } else {
        PG8_STAGE(PG8_SB(0, 0), cB, voffB); PG8_STAGE(PG8_SA(0, 0), cA, voffA); PG8_STAGE(PG8_SB(0, 1), cB + hstepB, voffB); PG8_STAGE(PG8_SA(0, 1), cA + hstepA, voffA);
        if (wr == 1) PG8_BAR;
        PG8_WAIT_V(4); PG8_BAR;
        PG8_STAGE(PG8_SB(1, 0), cB + kstep, voffB); PG8_STAGE(PG8_SA(1, 0), cA + kstep, voffA); PG8_STAGE(PG8_SB(1, 1), cB + hstepB + kstep, voffB);
        PG8_WAIT_V(6); PG8_BAR;
    }
    for (;;) {
        const bool has_next = S.next(ui + 1, nxt);
        const char* nA = has_next ? (const char*)g.A + (size_t)nxt.pm * tstepA : cA; const char* nB = has_next ? (const char*)g.Bt + (size_t)nxt.pn * tstepB : cB;
        for (int t = 0; t < nt; t += 2) {
            const bool last = (t == nt - 2);
            const char* a1 = cA + (size_t)(t + 1) * kstep;
            const char* a2 = last ? nA : cA + (size_t)(t + 2) * kstep; const char* b2 = last ? nB : cB + (size_t)(t + 2) * kstep;
            const char* a3 = a2 + kstep; const char* b3 = b2 + kstep;
            if (last && has_next) S.a_ready(nxt);
            if constexpr (SP2) {
            PG8_LDB(B0, 0, 0); PG8_LDB(B1, 0, 1); PG8_SCHED; PG8_LDA(At, 0, 0); PG8_STAGE(PG8_SA(1, 1), a1 + hstepA, voffA);
            PG8_WAIT_V(8); PG8_WAIT_L(0); PG8_BAR; PG8_MMA(0, 0, At, B0); PG8_MMA(0, 1, At, B1); PG8_BAR; PG8_SCHED;
            PG8_LDA(At, 0, 1); PG8_STAGE(PG8_SB(0, 0), b2, voffB); PG8_STAGE(PG8_SB(0, 1), b2 + hstepB, voffB); PG8_STAGE(PG8_SA(0, 0), a2, voffA);
            PG8_WAIT_V(8); PG8_WAIT_L(0); PG8_BAR; PG8_MMA(1, 0, At, B0); PG8_MMA(1, 1, At, B1); PG8_BAR; PG8_SCHED;
            PG8_LDB(B0, 1, 0); PG8_LDB(B1, 1, 1); PG8_SCHED; PG8_LDA(At, 1, 0); PG8_STAGE(PG8_SA(0, 1), a2 + hstepA, voffA);
            PG8_WAIT_V(8); PG8_WAIT_L(0); PG8_BAR; PG8_MMA(0, 0, At, B0); PG8_MMA(0, 1, At, B1); PG8_BAR; PG8_SCHED;
            PG8_LDA(At, 1, 1); PG8_STAGE(PG8_SB(1, 0), b3, voffB); PG8_STAGE(PG8_SB(1, 1), b3 + hstepB, voffB); PG8_STAGE(PG8_SA(1, 0), a3, voffA);
            PG8_WAIT_V(8); PG8_WAIT_L(0); PG8_BAR; PG8_MMA(1, 0, At, B0); PG8_MMA(1, 1, At, B1); PG8_BAR; PG8_SCHED;
            } else {
            PG8_LDB(B0, 0, 0); PG8_SCHED; PG8_LDA(At, 0, 0); PG8_STAGE(PG8_SA(1, 1), a1 + hstepA, voffA);
            PG8_WAIT_L(8); PG8_BAR; PG8_WAIT_L(0); PG8_MMA(0, 0, At, B0); PG8_BAR; PG8_SCHED;
            PG8_LDB(B1, 0, 1); PG8_STAGE(PG8_SB(0, 0), b2, voffB);
            PG8_BAR; PG8_WAIT_L(0); PG8_MMA(0, 1, At, B1); PG8_BAR;
            PG8_LDA(At, 0, 1); PG8_STAGE(PG8_SA(0, 0), a2, voffA);
            PG8_BAR; PG8_WAIT_L(0); PG8_MMA(1, 0, At, B0); PG8_BAR; PG8_SCHED;
            PG8_STAGE(PG8_SB(0, 1), b2 + hstepB, voffB);
            PG8_WAIT_V(6); PG8_BAR; PG8_MMA(1, 1, At, B1); PG8_BAR;
            PG8_LDB(B0, 1, 0); PG8_SCHED; PG8_LDA(At, 1, 0); PG8_STAGE(PG8_SA(0, 1), a2 + hstepA, voffA);
            PG8_WAIT_L(8); PG8_BAR; PG8_WAIT_L(0); PG8_MMA(0, 0, At, B0); PG8_BAR; PG8_SCHED;
            PG8_LDB(B1, 1, 1); PG8_STAGE(PG8_SB(1, 0), b3, voffB);
            PG8_BAR; PG8_WAIT_L(0); PG8_MMA(0, 1, At, B1); PG8_BAR;
            PG8_LDA(At, 1, 1); PG8_STAGE(PG8_SA(1, 0), a3, voffA);
            PG8_BAR; PG8_WAIT_L(0); PG8_MMA(1, 0, At, B0); PG8_BAR; PG8_SCHED;
            PG8_STAGE(PG8_SB(1, 1), b3 + hstepB, voffB);
            PG8_WAIT_V(6); PG8_BAR; PG8_MMA(1, 1, At, B1); PG8_BAR;
            }
        }
        if constexpr (ALIGN_EPI) { if (wr == 0) PG8_BAR; }
        if constexpr (!Epi::AFTER_DRAIN) { E(acc, cur, wr, wc, fr, fq); S.done(cur); }
        if (!has_next) break;
#pragma unroll
        for (int a = 0; a < 2; ++a)
#pragma unroll
            for (int b = 0; b < 2; ++b)
#pragma unroll
                for (int m = 0; m < 4; ++m)
#pragma unroll
                    for (int n = 0; n < 2; ++n) acc[a][b][m][n] = (f32x4){0.f, 0.f, 0.f, 0.f};
        cur = nxt; cA = nA; cB = nB; ++ui;
        if constexpr (ALIGN_EPI) { if (wr == 1) PG8_BAR; }
    }
    PG8_WAIT_V(0);
    if constexpr (!ALIGN_EPI) { if (wr == 0) PG8_BAR; }
    PG8_BAR;
    if constexpr (Epi::AFTER_DRAIN) { E.fused(acc, cur, wr, wc, fr, fq, lds, wid, lane); S.done(cur); }
#undef PG8_SA
#undef PG8_SB
#undef PG8_STAGE
#undef PG8_LDA
#undef PG8_LDB
#undef PG8_MMA
#undef PG8_WAIT_V
#undef PG8_WAIT_L
#undef PG8_BAR
#undef PG8_SCHED
}
}

#define XB_TMO      128
#define XB_XCNT(j)  (256  + 64 * (j))
#define XB_XSUB(j)  (1280 + 64 * (j))
#define XB_XGEN(j)  (2304 + 64 * (j))
#define XB_TOP      3328
#define XB_TOPGEN   3392
#define XCD_BAR_WORDS 3456
#define XB_SPIN_CAP (1u << 18)

__device__ __forceinline__ unsigned xb_ld(unsigned* p)              { return __hip_atomic_load(p, __ATOMIC_RELAXED, __HIP_MEMORY_SCOPE_AGENT); }
__device__ __forceinline__ unsigned xb_add(unsigned* p, unsigned v) { return __hip_atomic_fetch_add(p, v, __ATOMIC_RELAXED, __HIP_MEMORY_SCOPE_AGENT); }
__device__ __forceinline__ unsigned xb_xcc_id() { return (unsigned)__builtin_amdgcn_s_getreg((3 << 11) | 20) & 0xFu; }
#define XB_SPIN(cond, bar) do { unsigned _sp = 0; while (cond) { __builtin_amdgcn_s_sleep(1); \
    if ((++_sp & 255u) == 0u) { if (xb_ld(&(bar)[XB_TMO])) break; if (_sp > XB_SPIN_CAP) { atomicAdd(&(bar)[XB_TMO], 1u); break; } } } } while (0)

struct XcdBarrier {
    unsigned* bar; unsigned x;
    volatile LAS unsigned* st;
};

__device__ __forceinline__ XcdBarrier xcd_barrier_post(unsigned* bar, volatile LAS unsigned* st) {
    XcdBarrier b; b.bar = bar; b.x = xb_xcc_id(); b.st = st;
    if (threadIdx.x == 0) (void)xb_add(&bar[XB_XCNT(b.x)], 1u);
    return b;
}
__device__ __forceinline__ void xcd_barrier_complete(unsigned* bar, unsigned x, unsigned& nloc, unsigned& nx) {
    const unsigned G = gridDim.x * gridDim.y * gridDim.z;
    unsigned sum, cnt, mine, sp = 0u;
    for (;;) {
        sum = 0u; cnt = 0u; mine = 0u;
#pragma unroll
        for (unsigned j = 0; j < 16; ++j) { const unsigned c = xb_ld(&bar[XB_XCNT(j)]); sum += c; cnt += (c > 0u) ? 1u : 0u; mine = (j == x) ? c : mine; }
        if (sum == G) break;
        __builtin_amdgcn_s_sleep(1);
        if ((++sp & 255u) == 0u) { if (xb_ld(&bar[XB_TMO])) break; if (sp > XB_SPIN_CAP) { atomicAdd(&bar[XB_TMO], 1u); break; } }
    }
    nloc = mine > 0u ? mine : 1u; nx = cnt > 0u ? cnt : 1u;
}

__device__ __forceinline__ void xcd_barrier(const XcdBarrier& b, const int wave_s) {
    int xb_lane_; MK_LANE_ASM(xb_lane_); const bool xb_t0 = (wave_s == 0) && (xb_lane_ == 0);
    asm volatile("s_waitcnt vmcnt(0)" ::: "memory");
    __syncthreads();
    if (xb_t0) {
        unsigned* bar = b.bar;
        __builtin_amdgcn_s_waitcnt(0);
        unsigned nloc = b.st[0], nx = b.st[1];
        if (nloc == 0u) { xcd_barrier_complete(bar, b.x, nloc, nx); b.st[0] = nloc; b.st[1] = nx; }
        const unsigned old = xb_add(&bar[XB_XSUB(b.x)], 1u);
        const unsigned gen = old / nloc;
        if (old + 1u == (gen + 1u) * nloc) {
            __builtin_amdgcn_fence(__ATOMIC_RELEASE, "agent");
            asm volatile("s_waitcnt vmcnt(0)" ::: "memory");
            const unsigned og = xb_add(&bar[XB_TOP], 1u);
            const unsigned tg = og / nx;
            if (og + 1u == (tg + 1u) * nx) xb_add(&bar[XB_TOPGEN], 1u);
            else XB_SPIN(xb_ld(&bar[XB_TOPGEN]) == tg, bar);
            __builtin_amdgcn_fence(__ATOMIC_ACQUIRE, "agent");
            xb_add(&bar[XB_XGEN(b.x)], 1u);
            asm volatile("s_waitcnt vmcnt(0)" ::: "memory");
        } else {
            XB_SPIN(xb_ld(&bar[XB_XGEN(b.x)]) == gen, bar);
            __builtin_amdgcn_fence(__ATOMIC_ACQUIRE, "agent");
            asm volatile("s_waitcnt vmcnt(0)" ::: "memory");
        }
    }
    __syncthreads();
}


namespace mk {
using pg8::bf16_t; using pg8::f32x4; using pg8::Unit; using pg8::BM; using pg8::HALF;
typedef unsigned u32x4 __attribute__((ext_vector_type(4)));
typedef unsigned u32x2 __attribute__((ext_vector_type(2)));
typedef float f32x2 __attribute__((ext_vector_type(2)));

constexpr int D = 2048, BATCH = 2, SEQ = 4096, DEPTH = 4, CTX = 256;
constexpr int HY = 1024, NH = 8, NKV = 2, HD = 128, ATTW = 1024, KVW = 256;
constexpr int INW = 4608, FF = 5632, GU = 2 * FF, FH = 64, FE = 33;
constexpr int ML = BATCH * SEQ, MC = BATCH * CTX, MT = ML + MC;
constexpr float EPS = 1e-6f;
constexpr float LOG2E = 1.4426950408889634f;
constexpr float QSCALE = 0.08838834764831845f * LOG2E;
constexpr int WINDOW = 128;
constexpr int NWAVES = 8, NTHR = 512;
constexpr int MOD_KC = 8;

constexpr size_t al(size_t x) { return (x + 255) & ~(size_t)255; }
constexpr size_t WS_CTL = 0, CTL_BYTES = 1u << 20;
constexpr size_t WS_X = CTL_BYTES;
constexpr size_t WS_AN = WS_X + al((size_t)MT * D * 4);
constexpr size_t WS_SSQ = WS_AN + al((size_t)MT * D * 2);
constexpr size_t WS_SSQC = WS_SSQ + al((size_t)MT * 32 * 4);
constexpr size_t WS_PHY = WS_SSQC + al((size_t)32 * MC * 4);
constexpr size_t WS_Q = WS_PHY + al((size_t)3 * HY * MT * 2);
constexpr size_t WS_K = WS_Q + al((size_t)MT * ATTW * 2);
constexpr size_t WS_V = WS_K + al((size_t)MT * KVW * 2);
constexpr size_t WS_YM = WS_V + al((size_t)MT * KVW * 2);
constexpr size_t WS_SSHY = WS_YM + al((size_t)MT * D * 2);
constexpr size_t WS_HB = WS_SSHY + al((size_t)HY * MT * 4);
constexpr size_t WS_MODP = WS_HB + al((size_t)MT * FF * 2);
constexpr size_t WS_MOD = WS_MODP + al((size_t)MOD_KC * DEPTH * 3 * 6 * D * 4);
constexpr size_t WS_GMV = WS_MOD + al((size_t)DEPTH * 3 * 6 * D * 4);
constexpr size_t WS_SHWIN = WS_GMV + al((size_t)DEPTH * 2 * 3 * D * 4);
constexpr size_t WS_SHWGU = WS_SHWIN + al((size_t)DEPTH * 3 * INW * 4);
constexpr size_t WS_HIDL = WS_SHWGU + al((size_t)DEPTH * 3 * GU * 4);
constexpr size_t WS_W3T = WS_HIDL + al((size_t)DEPTH * SEQ * FH * 2);
constexpr size_t WS_HIDC = WS_HIDL + al((size_t)DEPTH * SEQ * FH * 4);
constexpr size_t WS_ROPE = WS_HIDC + al((size_t)DEPTH * CTX * FH * 4);
constexpr size_t WS_FLT = WS_ROPE + al((size_t)64 * 32 * 2 * 4);
constexpr size_t WS_FLTC = WS_FLT + al((size_t)DEPTH * 4 * HY * SEQ * 4);
constexpr size_t WS_WIN = WS_FLTC + al((size_t)DEPTH * 4 * HY * CTX * 4);
constexpr size_t WS_WOUT = WS_WIN + al((size_t)DEPTH * INW * D * 2);
constexpr size_t WS_WGU = WS_WOUT + al((size_t)DEPTH * D * D * 2);
constexpr size_t WS_WD = WS_WGU + al((size_t)DEPTH * GU * D * 2);
constexpr size_t WS_END = WS_WD + al((size_t)DEPTH * D * FF * 2);
constexpr int CW_BAR = 4096;

constexpr int RING_BYTES = 135168  , MISC_OFF = RING_BYTES + 320, LDS_BYTES = RING_BYTES + 4096;

__device__ __forceinline__ unsigned f2bf(float f) { unsigned u = __builtin_bit_cast(unsigned, f); return (u + 0x7fffu + ((u >> 16) & 1u)) >> 16; }
__device__ __forceinline__ unsigned pk2(float lo, float hi) { return f2bf(lo) | (f2bf(hi) << 16); }
__device__ __forceinline__ float bf_lo(unsigned w) { return __builtin_bit_cast(float, w << 16); }
__device__ __forceinline__ float bf_hi(unsigned w) { return __builtin_bit_cast(float, w & 0xffff0000u); }
__device__ __forceinline__ float bf1(bf16_t b) { return __builtin_bit_cast(float, (unsigned)b << 16); }
__device__ __forceinline__ float wave_sum(float v) {
#pragma unroll
    for (int o = 1; o < 64; o <<= 1) v += __shfl_xor(v, o);
    return v;
}
__device__ __forceinline__ float wave_max(float v) {
#pragma unroll
    for (int o = 1; o < 64; o <<= 1) v = fmaxf(v, __shfl_xor(v, o));
    return v;
}
__device__ __forceinline__ int vec_of_panel(int pm) { return pm < 16 ? 0 : (pm < 32 ? 1 : 2); }
__device__ __forceinline__ int vec_of_row(int row) { return row < SEQ ? 0 : (row < ML ? 1 : 2); }
__host__ __device__ __forceinline__ int qk_dim(int j) { const int wc = j >> 5, fq = (j >> 3) & 3, n = (j >> 2) & 1, e = j & 3, idx = wc * 16 + fq * 4 + e; return (idx < 32 ? idx : idx + 32) + 32 * n; }

#define FRESH_IDS int lane_; MK_LANE_ASM(lane_); int wv_ = wave_s; asm volatile("" : "+s"(wv_)); const int lane = lane_, wave = wv_, tid = wv_ * 64 + lane_; (void)lane; (void)wave; (void)tid
struct Params {
    const float* in[26];
    float* out;
    unsigned char* ws;
    int ph_lo, ph_hi;
};
typedef __attribute__((address_space(4))) const Params* KP;
#define FRESH_KP KP Pp; { unsigned long long ki_ = (unsigned long long)__builtin_amdgcn_kernarg_segment_ptr(); asm volatile("" : "+s"(ki_)); Pp = (KP)ki_; }

__device__ __forceinline__ void load_rstd8(const float* ssq, const float* ssqc, int row0, int fq, float (&rs)[2][4]) {
    const bool isc = row0 >= ML;
#pragma unroll
    for (int ai = 0; ai < 2; ++ai)
#pragma unroll
        for (int m = 0; m < 4; ++m) {
            const int row = row0 + ai * HALF + m * 16;
            float s;
            if (!isc) { const f32x4 a = *(const f32x4*)(ssq + ((size_t)(2 * fq) * MT + row) * 4), b = *(const f32x4*)(ssq + ((size_t)(2 * fq + 1) * MT + row) * 4);
                s = ((a[0] + a[1]) + (a[2] + a[3])) + ((b[0] + b[1]) + (b[2] + b[3])); }
            else { s = 0.f;
#pragma unroll
                for (int j = 0; j < 8; ++j) s += ssqc[(size_t)(fq * 8 + j) * MC + (row - ML)]; }
            s += __shfl_xor(s, 16); s += __shfl_xor(s, 32);
            rs[ai][m] = 1.0f / sqrtf(s * (1.0f / D) + EPS);
        }
}

struct EpiIn {
    static constexpr bool PERM = true, AFTER_DRAIN = false;
    const float* ssq; const float* ssqc; const float* shw;
    bf16_t* PHY; bf16_t* Q; bf16_t* Kb; bf16_t* Vb; const float* rope;
    __device__ __forceinline__ void operator()(const f32x4 (&acc)[2][2][4][2], const Unit& u, int wr, int wc, int fr_, int fq_) const {
        int fr = fr_, fq = fq_; asm volatile("" : "+v"(fr), "+v"(fq));
        const int row0 = u.pm * BM + wr * 64 + fr, v = vec_of_panel(u.pm);
        float rs[2][4]; load_rstd8(ssq, ssqc, row0, fq, rs);
        const int cpos = wc * 32 + 8 * fq;
        const int colb = u.pn * BM + cpos;
        f32x4 sh[2][2];
#pragma unroll
        for (int bj = 0; bj < 2; ++bj)
#pragma unroll
            for (int n = 0; n < 2; ++n) sh[bj][n] = *(const f32x4*)(shw + (size_t)v * INW + colb + bj * HALF + 4 * n);
        if (u.pn < 12) {
#pragma unroll
            for (int ai = 0; ai < 2; ++ai)
#pragma unroll
                for (int m = 0; m < 4; ++m) { const int row = row0 + ai * HALF + m * 16; const float r = rs[ai][m];
#pragma unroll
                    for (int bj = 0; bj < 2; ++bj)
#pragma unroll
                        for (int n = 0; n < 2; ++n) { const f32x4 x = acc[ai][bj][m][n] * r + sh[bj][n];
                            u32x2 w; w.x = pk2(x[0], x[1]); w.y = pk2(x[2], x[3]);
                            const int cg = (colb + bj * HALF) / 4 + n;
                            *(u32x2*)(PHY + ((size_t)cg * MT + row) * 4) = w; } }
        } else if (u.pn < 17) {
            const bool isq = u.pn < 16, latent = u.pm < 32;
            const int axis = wc >> 1, p0 = (wc * 16 + fq * 4) & 31;
            const float qs = isq ? QSCALE : 1.0f;
#pragma unroll
            for (int ai = 0; ai < 2; ++ai)
#pragma unroll
                for (int m = 0; m < 4; ++m) { const int row = row0 + ai * HALF + m * 16; const float r = rs[ai][m];
                    const int l = row & (SEQ - 1), pos = axis ? (l & 63) : (l >> 6);
                    f32x4 t0 = (f32x4){1.f, 0.f, 1.f, 0.f}, t1 = t0;
                    if (latent) { const f32x4* tp = (const f32x4*)(rope + ((size_t)pos * 32 + p0) * 2); t0 = tp[0]; t1 = tp[1]; }
                    const float cs[4] = {t0[0], t0[2], t1[0], t1[2]}, sn[4] = {t0[1], t0[3], t1[1], t1[3]};
#pragma unroll
                    for (int bj = 0; bj < 2; ++bj) { const f32x4 a = acc[ai][bj][m][0] * r + sh[bj][0], b = acc[ai][bj][m][1] * r + sh[bj][1];
                        float ra[4], rb[4];
#pragma unroll
                        for (int e = 0; e < 4; ++e) { ra[e] = (a[e] * cs[e] - b[e] * sn[e]) * qs; rb[e] = (a[e] * sn[e] + b[e] * cs[e]) * qs; }
                        u32x4 w; w.x = pk2(ra[0], ra[1]); w.y = pk2(ra[2], ra[3]); w.z = pk2(rb[0], rb[1]); w.w = pk2(rb[2], rb[3]);
                        bf16_t* dst = isq ? Q + (size_t)row * ATTW + (u.pn - 12) * BM + bj * HALF + cpos : Kb + (size_t)row * KVW + bj * HALF + cpos;
                        *(u32x4*)dst = w; } }
        } else {
#pragma unroll
            for (int ai = 0; ai < 2; ++ai)
#pragma unroll
                for (int m = 0; m < 4; ++m) { const int row = row0 + ai * HALF + m * 16; const float r = rs[ai][m];
#pragma unroll
                    for (int bj = 0; bj < 2; ++bj) { const f32x4 a = acc[ai][bj][m][0] * r + sh[bj][0], b = acc[ai][bj][m][1] * r + sh[bj][1];
                        u32x4 w; w.x = pk2(a[0], a[1]); w.y = pk2(a[2], a[3]); w.z = pk2(b[0], b[1]); w.w = pk2(b[2], b[3]);
                        *(u32x4*)(Vb + (size_t)row * KVW + bj * HALF + cpos) = w; } }
        }
    }
};

struct EpiOutA {
    static constexpr bool PERM = true, AFTER_DRAIN = false;
    float* X; const float* gate;
    const float* sshy;
    __device__ __forceinline__ void operator()(const f32x4 (&acc)[2][2][4][2], const Unit& u, int wr, int wc, int fr_, int fq_) const {
        int fr = fr_, fq = fq_; asm volatile("" : "+v"(fr), "+v"(fq));
        const int row0 = u.pm * BM + wr * 64 + fr, v = vec_of_panel(u.pm);
        const int colb = u.pn * BM + wc * 32 + 8 * fq;
        f32x4 gt[2][2];
#pragma unroll
        for (int bj = 0; bj < 2; ++bj)
#pragma unroll
            for (int n = 0; n < 2; ++n) gt[bj][n] = *(const f32x4*)(gate + (size_t)v * 6 * D + colb + bj * HALF + 4 * n);
#pragma unroll
        for (int ai = 0; ai < 2; ++ai)
#pragma unroll
            for (int m = 0; m < 4; ++m) { const int row = row0 + ai * HALF + m * 16;
                const float r = 1.0f / sqrtf(sshy[row] * (1.0f / HY) + EPS);
                float* xr = X + (size_t)row * D + colb;
#pragma unroll
                for (int bj = 0; bj < 2; ++bj)
#pragma unroll
                    for (int n = 0; n < 2; ++n) { f32x4* px = (f32x4*)(xr + bj * HALF + 4 * n); *px = *px + gt[bj][n] * (acc[ai][bj][m][n] * r); } }
    }
};

struct EpiResid {
    static constexpr bool PERM = true, AFTER_DRAIN = false;
    float* X; const float* gate; const float* gnext  ; bf16_t* AN; float* ssq; int live;
    __device__ __forceinline__ void operator()(const f32x4 (&acc)[2][2][4][2], const Unit& u, int wr, int wc, int fr_, int fq_) const {
        int fr = fr_, fq = fq_; asm volatile("" : "+v"(fr), "+v"(fq));
        const int row0 = u.pm * BM + wr * 64 + fr, v = vec_of_panel(u.pm);
        const int colb = u.pn * BM + wc * 32 + 8 * fq;
        f32x4 gt[2][2], gn[2][2];
#pragma unroll
        for (int bj = 0; bj < 2; ++bj)
#pragma unroll
            for (int n = 0; n < 2; ++n) { gt[bj][n] = *(const f32x4*)(gate + (size_t)v * 6 * D + colb + bj * HALF + 4 * n);
                gn[bj][n] = gnext ? *(const f32x4*)(gnext + (size_t)v * D + colb + bj * HALF + 4 * n) : (f32x4){0.f, 0.f, 0.f, 0.f}; }
#pragma unroll
        for (int ai = 0; ai < 2; ++ai)
#pragma unroll
            for (int m = 0; m < 4; ++m) { const int row = row0 + ai * HALF + m * 16;
                float* xr = X + (size_t)row * D + colb; float s = 0.f;
#pragma unroll
                for (int bj = 0; bj < 2; ++bj) { f32x4 x[2];
#pragma unroll
                    for (int n = 0; n < 2; ++n) { f32x4* px = (f32x4*)(xr + bj * HALF + 4 * n); x[n] = *px + gt[bj][n] * acc[ai][bj][m][n]; if (live) *px = x[n];
                        s += (x[n][0] * x[n][0] + x[n][1] * x[n][1]) + (x[n][2] * x[n][2] + x[n][3] * x[n][3]); }
                    if (gnext && live) { const f32x4 a = x[0] * gn[bj][0], b = x[1] * gn[bj][1];
                        u32x4 w; w.x = pk2(a[0], a[1]); w.y = pk2(a[2], a[3]); w.z = pk2(b[0], b[1]); w.w = pk2(b[2], b[3]);
                        *(u32x4*)(AN + (size_t)row * D + colb + bj * HALF) = w; } }
                s += __shfl_xor(s, 16); s += __shfl_xor(s, 32);
                if (fq == 0 && live) ssq[((size_t)u.pn * MT + row) * 4 + wc] = s; }
    }
};

struct EpiGU {
    static constexpr bool PERM = true, AFTER_DRAIN = false;
    const float* ssq; const float* ssqc; const float* shw;
    bf16_t* HB;
    __device__ __forceinline__ void operator()(const f32x4 (&acc)[2][2][4][2], const Unit& u, int wr, int wc, int fr_, int fq_) const {
        int fr = fr_, fq = fq_; asm volatile("" : "+v"(fr), "+v"(fq));
        const int row0 = u.pm * BM + wr * 64 + fr, v = vec_of_panel(u.pm);
        float rs[2][4]; load_rstd8(ssq, ssqc, row0, fq, rs);
        const int colb = u.pn * BM + wc * 32 + 8 * fq;
        f32x4 sh[2][2];
#pragma unroll
        for (int bj = 0; bj < 2; ++bj)
#pragma unroll
            for (int n = 0; n < 2; ++n) sh[bj][n] = *(const f32x4*)(shw + (size_t)v * GU + colb + bj * HALF + 4 * n);
#pragma unroll
        for (int ai = 0; ai < 2; ++ai)
#pragma unroll
            for (int m = 0; m < 4; ++m) { const int row = row0 + ai * HALF + m * 16; const float r = rs[ai][m];
#pragma unroll
                for (int bj = 0; bj < 2; ++bj) { const f32x4 g = acc[ai][bj][m][0] * r + sh[bj][0], up = acc[ai][bj][m][1] * r + sh[bj][1];
                    float h[4];
#pragma unroll
                    for (int e = 0; e < 4; ++e) h[e] = g[e] * __builtin_amdgcn_rcpf(1.0f + __builtin_amdgcn_exp2f(-g[e] * LOG2E)) * up[e];
                    u32x2 w; w.x = pk2(h[0], h[1]); w.y = pk2(h[2], h[3]);
                    const int ff = (colb + bj * HALF) >> 1;
                    *(u32x2*)(HB + (size_t)row * FF + ff) = w; } }
    }
};

template <class RowMap>
__device__ __forceinline__ void transpose_item(const float* W, int K, int N, bf16_t* WT, LAS float* scr, int item, int lane, const RowMap& rm) {
    const int nblk = N / 32, kb = item / nblk, nb = item % nblk, k0 = 64 * kb, n0 = 32 * nb;
#pragma unroll 8
    for (int i = 0; i < 32; ++i) { const int kk = 2 * i + (lane >> 5); scr[kk * 33 + (lane & 31)] = W[(size_t)(k0 + kk) * N + n0 + (lane & 31)]; }
    asm volatile("s_waitcnt lgkmcnt(0)" ::: "memory");
    const int c = lane & 7;
#pragma unroll
    for (int j = 0; j < 4; ++j) { const int n = (lane >> 3) + 8 * j; const LAS float* s = scr + (8 * c) * 33 + n;
        u32x4 o; o.x = pk2(s[0 * 33], s[1 * 33]); o.y = pk2(s[2 * 33], s[3 * 33]); o.z = pk2(s[4 * 33], s[5 * 33]); o.w = pk2(s[6 * 33], s[7 * 33]);
        *(u32x4*)(WT + (size_t)rm(n0 + n) * K + k0 + 8 * c) = o; }
    asm volatile("s_waitcnt lgkmcnt(0)" ::: "memory");
}
struct MapId { __device__ __forceinline__ int operator()(int n) const { return n; } };
struct MapIn { __device__ __forceinline__ int operator()(int n) const {
    if (n < 3 * HY || n >= 3 * HY + ATTW + KVW) return n;
    const int h0 = (n - 3 * HY) & ~127, d = (n - 3 * HY) & 127;
    const int nn = (d >> 5) & 1, base = d - 32 * nn, idx = base < 32 ? base : base - 32, wc = idx >> 4, fq = (idx >> 2) & 3, e = idx & 3;
    return 3 * HY + h0 + 32 * wc + 8 * fq + 4 * nn + e; } };
struct MapGU { int up; __device__ __forceinline__ int operator()(int n) const { return (n >> 2) * 8 + up * 4 + (n & 3); } };

__device__ __forceinline__ float silu_acc(float v) { return v / (1.f + expf(-v)); }

__device__ __forceinline__ void p0a(LAS unsigned char* lds, int G, const int wave_s) {
    FRESH_IDS; FRESH_KP;
    unsigned char* ws = Pp->ws;
    const int gw = blockIdx.x * NWAVES + wave, NGW = G * NWAVES;
    const int gt = blockIdx.x * NTHR + tid, NGT = G * NTHR;
    { const f32x4* xs = (const f32x4*)Pp->in[0]; const f32x4* cs = (const f32x4*)Pp->in[2]; f32x4* X = (f32x4*)(ws + WS_X);
      const int nl = ML * D / 4, nt = MT * D / 4;
      for (int i = gt; i < nt; i += NGT) X[i] = i < nl ? xs[i] : cs[i - nl]; }
    { float* rope = (float*)(ws + WS_ROPE);
      for (int i = gt; i < 64 * 32; i += NGT) { const int pos = i >> 5, p = i & 31; const float inv = powf(10000.f, -(float)p / 32.f); const float ang = (float)pos * inv; rope[2 * i] = cosf(ang); rope[2 * i + 1] = sinf(ang); }
    }
    LAS float* SV = (LAS float*)(lds + 98304);
    for (int i = tid; i < 3 * D; i += NTHR) SV[i] = silu_acc(i < 2 * D ? Pp->in[1][i] : Pp->in[3][i - 2 * D]);
    __syncthreads();
    { float* MODP = (float*)(ws + WS_MODP);
      constexpr int KCH = D / MOD_KC, NCH = 6 * D / 256, NIT = DEPTH * NCH * MOD_KC;
      for (int it = gw; it < NIT; it += NGW) {
          const int kc = it % MOD_KC, nc = (it / MOD_KC) % NCH, layer = it / (MOD_KC * NCH);
          const float* W = Pp->in[6] + (size_t)layer * D * 6 * D + (size_t)(kc * KCH) * 6 * D + nc * 256 + lane * 4;
          f32x4 a0 = {0.f, 0.f, 0.f, 0.f}, a1 = a0, a2 = a0;
#pragma unroll 8
          for (int k = 0; k < KCH; ++k) { const f32x4 w = *(const f32x4*)(W + (size_t)k * 6 * D); const int kk = kc * KCH + k;
              a0 += w * SV[kk]; a1 += w * SV[D + kk]; a2 += w * SV[2 * D + kk]; }
          float* o = MODP + ((size_t)(kc * DEPTH + layer) * 3) * 6 * D + nc * 256 + lane * 4;
          *(f32x4*)o = a0; *(f32x4*)(o + 6 * D) = a1; *(f32x4*)(o + 12 * D) = a2; } }
    { for (int it = gw; it < DEPTH * (SEQ + CTX); it += NGW) {
          const int layer = it / (SEQ + CTX), r = it % (SEQ + CTX); const bool isc = r >= SEQ; const int l = isc ? r - SEQ : r, L = isc ? CTX : SEQ;
          const float* w1 = Pp->in[11] + (size_t)layer * FE * FH; const float* b1 = Pp->in[12] + layer * FH; const float* w2 = Pp->in[13] + (size_t)layer * FH * FH; const float* b2 = Pp->in[14] + layer * FH; const float* fr = Pp->in[16] + layer * FH;
          float emb = 0.f;
          if (lane < FE) { const float t = (float)l / (float)(L - 1); const float w = (2.0f * 3.14159265358979323846f / (float)L) * (float)l;
              if (lane == 0) emb = t; else { const int bi = (lane - 1) & 15; const float band = 1e-4f + (float)bi * ((15.0f - 1e-4f) / 15.0f); emb = lane <= 16 ? cosf(band * w) : -sinf(band * w); } }
          float a = b1[lane];
          for (int j = 0; j < FE; ++j) a += __shfl(emb, j) * w1[j * FH + lane];
          const float h1 = sinf(fr[lane] * a);
          float c = b2[lane];
          for (int j = 0; j < FH; ++j) c += __shfl(h1, j) * w2[j * FH + lane];
          bf16_t* dst = isc ? (bf16_t*)(ws + WS_HIDC) + ((size_t)layer * CTX + l) * FH : (bf16_t*)(ws + WS_HIDL) + ((size_t)layer * SEQ + l) * FH;
          dst[lane] = (bf16_t)f2bf(sinf(fr[lane] * c)); } }
    { for (int it = gw; it < DEPTH * 64; it += NGW) { const int layer = it >> 6, np = (it & 63) * 64 + lane;
          const int j = (np & 1) * 2048 + ((np >> 1) & 1) * 1024 + (np >> 2);
          const float* w3 = Pp->in[15] + (size_t)layer * FH * 4096 + j;
          bf16_t* dst = (bf16_t*)(ws + WS_W3T) + ((size_t)layer * 4096 + np) * FH;
#pragma unroll
          for (int k8 = 0; k8 < 8; ++k8) { float v[8];
#pragma unroll
              for (int e = 0; e < 8; ++e) v[e] = w3[(size_t)(k8 * 8 + e) * 4096];
              u32x4 w; w.x = pk2(v[0], v[1]); w.y = pk2(v[2], v[3]); w.z = pk2(v[4], v[5]); w.w = pk2(v[6], v[7]);
              *(u32x4*)(dst + k8 * 8) = w; } } }
    { LAS float* scr = (LAS float*)(lds + wave * 8704);
      constexpr int I_IN = (D / 64) * (INW / 32), I_OUT = (D / 64) * (D / 32), I_G = (D / 64) * (FF / 32), I_D = (FF / 64) * (D / 32);
      constexpr int PER = I_IN + I_OUT + 2 * I_G + I_D;
      for (int it = gw; it < DEPTH * PER; it += NGW) {
          const int layer = it / PER; int r = it % PER;
          if (r < I_IN) { transpose_item(Pp->in[8] + (size_t)layer * D * INW, D, INW, (bf16_t*)(ws + WS_WIN) + (size_t)layer * INW * D, scr, r, lane, MapIn{}); continue; } r -= I_IN;
          if (r < I_OUT) { transpose_item(Pp->in[21] + (size_t)layer * D * D, D, D, (bf16_t*)(ws + WS_WOUT) + (size_t)layer * D * D, scr, r, lane, MapId{}); continue; } r -= I_OUT;
          if (r < I_G) { transpose_item(Pp->in[22] + (size_t)layer * D * FF, D, FF, (bf16_t*)(ws + WS_WGU) + (size_t)layer * GU * D, scr, r, lane, MapGU{0}); continue; } r -= I_G;
          if (r < I_G) { transpose_item(Pp->in[23] + (size_t)layer * D * FF, D, FF, (bf16_t*)(ws + WS_WGU) + (size_t)layer * GU * D, scr, r, lane, MapGU{1}); continue; } r -= I_G;
          transpose_item(Pp->in[24] + (size_t)layer * FF * D, FF, D, (bf16_t*)(ws + WS_WD) + (size_t)layer * D * FF, scr, r, lane, MapId{}); } }
}

__device__ __forceinline__ void p0b(int G, const int wave_s) {
    FRESH_IDS; FRESH_KP;
    unsigned char* ws = Pp->ws; const int gt = blockIdx.x * NTHR + tid, NGT = G * NTHR;
    const float* MODP = (const float*)(ws + WS_MODP); float* MOD = (float*)(ws + WS_MOD);
    constexpr int NTOT = DEPTH * 3 * 6 * D;
    for (int i = gt; i < NTOT; i += NGT) { const int layer = i / (3 * 6 * D), n = i % (6 * D); float s = Pp->in[7][(size_t)layer * 6 * D + n];
#pragma unroll
        for (int kc = 0; kc < MOD_KC; ++kc) { const int rest = i % (3 * 6 * D); s += MODP[((size_t)(kc * DEPTH + layer) * 3) * 6 * D + rest]; }
        MOD[i] = s; }
}

__device__ __forceinline__ void p0c(LAS unsigned char* lds, int G, const int wave_s) {
    FRESH_IDS; FRESH_KP;
    unsigned char* ws = Pp->ws;
    const int gw = blockIdx.x * NWAVES + wave, NGW = G * NWAVES;
    const int gt = blockIdx.x * NTHR + tid, NGT = G * NTHR;
    const float* MOD = (const float*)(ws + WS_MOD);
    { float* GMV = (float*)(ws + WS_GMV);
      for (int i = gt; i < DEPTH * 2 * 3 * D; i += NGT) { const int c = i % D, v = (i / D) % 3, which = (i / (3 * D)) % 2, layer = i / (6 * D);
          const float g = which ? Pp->in[5][layer * D + c] : Pp->in[4][layer * D + c];
          GMV[i] = g * (1.0f + MOD[((size_t)layer * 3 + v) * 6 * D + (which ? 4 : 1) * D + c]); } }
    { constexpr int PER = (INW + GU) / 32;
      for (int it = gw; it < DEPTH * PER; it += NGW) { const int layer = it / PER, r0 = (it % PER) * 32; const bool isin = r0 < INW;
          const bf16_t* wbase = isin ? (const bf16_t*)(ws + WS_WIN) + ((size_t)layer * INW + r0) * D : (const bf16_t*)(ws + WS_WGU) + ((size_t)layer * GU + (r0 - INW)) * D;
          const float* sh = MOD + (size_t)layer * 3 * 6 * D + (isin ? 0 : 3) * D;
          float k0 = 0.f, k1 = 0.f, k2 = 0.f;
          float s0[32], s1[32], s2[32];
#pragma unroll
          for (int j = 0; j < 4; ++j)
#pragma unroll
              for (int e = 0; e < 8; ++e) { const int k = lane * 8 + 512 * j + e; s0[j * 8 + e] = sh[k]; s1[j * 8 + e] = sh[6 * D + k]; s2[j * 8 + e] = sh[12 * D + k]; }
#pragma nounroll
          for (int rr = 0; rr < 32; ++rr) { const bf16_t* wrow = wbase + (size_t)rr * D;
              float a0 = 0.f, a1 = 0.f, a2 = 0.f;
#pragma unroll
              for (int j = 0; j < 4; ++j) { const int k = lane * 8 + 512 * j; const u32x4 w = *(const u32x4*)(wrow + k);
                  const float wf[8] = {bf_lo(w.x), bf_hi(w.x), bf_lo(w.y), bf_hi(w.y), bf_lo(w.z), bf_hi(w.z), bf_lo(w.w), bf_hi(w.w)};
#pragma unroll
                  for (int e = 0; e < 8; ++e) { a0 += wf[e] * s0[j * 8 + e]; a1 += wf[e] * s1[j * 8 + e]; a2 += wf[e] * s2[j * 8 + e]; } }
              a0 = wave_sum(a0); a1 = wave_sum(a1); a2 = wave_sum(a2);
              if (lane == rr) { k0 = a0; k1 = a1; k2 = a2; } }
          if (lane < 32) { float* o = isin ? (float*)(ws + WS_SHWIN) + (size_t)layer * 3 * INW + r0 + lane : (float*)(ws + WS_SHWGU) + (size_t)layer * 3 * GU + (r0 - INW) + lane;
              const int st = isin ? INW : GU; o[0] = k0; o[st] = k1; o[2 * st] = k2; } } }
    { const float* X = (const float*)(ws + WS_X); bf16_t* AN = (bf16_t*)(ws + WS_AN); float* SSQ = (float*)(ws + WS_SSQ); float* SSQC = (float*)(ws + WS_SSQC);
      for (int it = gw; it < ML + MC / 32; it += NGW) { const bool grp = it >= ML; const int rowb = grp ? ML + (it - ML) * 32 : it, nr = grp ? 32 : 1; float keep = 0.f;
#pragma nounroll
          for (int rr = 0; rr < nr; ++rr) { const int row = rowb + rr, v = vec_of_row(row); const float* xr = X + (size_t)row * D; float s = 0.f;
#pragma unroll
              for (int j = 0; j < 4; ++j) { const int c = lane * 8 + 512 * j; const f32x4 a = *(const f32x4*)(xr + c), b = *(const f32x4*)(xr + c + 4);
                  s += (a[0] * a[0] + a[1] * a[1]) + (a[2] * a[2] + a[3] * a[3]) + (b[0] * b[0] + b[1] * b[1]) + (b[2] * b[2] + b[3] * b[3]);
                  float gm[8];
#pragma unroll
                  for (int e = 0; e < 8; ++e) gm[e] = Pp->in[4][c + e] * (1.0f + MOD[(size_t)v * 6 * D + 1 * D + c + e]);
                  u32x4 w; w.x = pk2(a[0] * gm[0], a[1] * gm[1]); w.y = pk2(a[2] * gm[2], a[3] * gm[3]); w.z = pk2(b[0] * gm[4], b[1] * gm[5]); w.w = pk2(b[2] * gm[6], b[3] * gm[7]);
                  *(u32x4*)(AN + (size_t)row * D + c) = w; }
              s = wave_sum(s);
              if (!grp) { if (lane < 32) SSQ[((size_t)(lane >> 2) * MT + row) * 4 + (lane & 3)] = lane == 0 ? s : 0.f; }
              else if (lane == rr) keep = s; }
          if (grp && lane < 32) { const int r0 = rowb - ML;
#pragma nounroll
              for (int cb = 0; cb < 32; ++cb) SSQC[(size_t)cb * MC + r0 + lane] = cb == 0 ? keep : 0.f; } } }
    { typedef float f32x16_ __attribute__((ext_vector_type(16)));
      const int r32 = lane & 31, hi = lane >> 5;
      constexpr int IT_L = 128 * 8, IT_C = 128, PER = IT_L + IT_C;
      for (int it = gw; it < DEPTH * PER; it += NGW) {
          const int layer = it / PER; int r = it % PER; const bool isc = r >= IT_L; if (isc) r -= IT_L;
          const int nb = r & 127, lc = r >> 7, L = isc ? CTX : SEQ, nlb = isc ? 8 : 16;
          const bf16_t* arow = (const bf16_t*)(ws + WS_W3T) + ((size_t)layer * 4096 + nb * 32 + r32) * FH + hi * 8;
          pg8::bf16x8 a[4];
#pragma unroll
          for (int s = 0; s < 4; ++s) a[s] = *(const pg8::bf16x8*)(arow + 16 * s);
          const bf16_t* hb = isc ? (const bf16_t*)(ws + WS_HIDC) + (size_t)layer * CTX * FH : (const bf16_t*)(ws + WS_HIDL) + (size_t)layer * SEQ * FH;
          f32x2* tf = isc ? (f32x2*)(ws + WS_FLTC) + (size_t)layer * HY * CTX : (f32x2*)(ws + WS_FLT) + (size_t)layer * HY * SEQ;
          f32x2* tb = isc ? (f32x2*)(ws + WS_FLTC) + (size_t)(DEPTH + layer) * HY * CTX : (f32x2*)(ws + WS_FLT) + (size_t)(DEPTH + layer) * HY * SEQ;
          float dl[8];
#pragma unroll
          for (int rp = 0; rp < 8; ++rp) { const int c = (nb * 32 + (2 * (rp & 1)) + 8 * (rp >> 1) + 4 * hi) >> 2;
              dl[rp] = fabsf(-3.0701134573253945f + (float)c * ((-15.350567286626973f + 3.0701134573253945f) / 1023.f)) * LOG2E; }
#pragma nounroll
          for (int lb = 0; lb < nlb; ++lb) { const int l = (lc * 16 + lb) * 32 + r32;
              const bf16_t* brow = hb + (size_t)l * FH + hi * 8;
              f32x16_ acc;
#pragma unroll
              for (int q = 0; q < 16; ++q) acc[q] = 0.f;
#pragma unroll
              for (int s = 0; s < 4; ++s) acc = __builtin_amdgcn_mfma_f32_32x32x16_bf16(a[s], *(const pg8::bf16x8*)(brow + 16 * s), acc, 0, 0, 0);
              const float t = (float)l / (float)(L - 1);
#pragma unroll
              for (int rp = 0; rp < 8; ++rp) { const int rr = 2 * rp, n = nb * 32 + (rr & 3) + 8 * (rr >> 2) + 4 * hi, c = n >> 2, d = (n >> 1) & 1;
                  const float wdw = __builtin_amdgcn_exp2f(-t * dl[rp]);
                  f32x2 v = {acc[rr] * wdw, acc[rr + 1] * wdw};
                  if (d == 0) tf[(size_t)c * L + l] = v; else tb[(size_t)c * L + l] = l == 0 ? (f32x2){0.f, 0.f} : v; } } } }
}

__device__ __forceinline__ void attn_simple(LAS unsigned char* lds, int layer, int G, int nrows, const int wave_s) {
    FRESH_IDS; FRESH_KP;
    unsigned char* ws = Pp->ws;
    const bf16_t* Q = (const bf16_t*)(ws + WS_Q); const bf16_t* Kb = (const bf16_t*)(ws + WS_K); const bf16_t* Vb = (const bf16_t*)(ws + WS_V);
    bf16_t* YM = (bf16_t*)(ws + WS_YM);
    LAS float* qs = (LAS float*)lds + wave * HD;
    LAS float* ps = (LAS float*)(lds + 4096) + wave * 640;
    LAS float* red = (LAS float*)(lds + 4096 + 8 * 640 * 4);
    const int h = wave, kv = h >> 2;
    const float sk = Pp->in[18][layer * NH + h] * LOG2E;
    const float* gat = Pp->in[20] + layer * ATTW; const float* ghy = Pp->in[19] + layer * HY; const float* ZT = (const float*)(ws + WS_SSHY);
    for (int row = blockIdx.x; row < nrows; row += G) {
        { const unsigned w = *(const unsigned*)(Q + (size_t)row * ATTW + h * HD + 2 * lane); qs[2 * lane] = bf_lo(w); qs[2 * lane + 1] = bf_hi(w); }
        int b, j0 = 0, nwin = 0;
        if (row < ML) { b = row / SEQ; const int l = row % SEQ; j0 = l - WINDOW < 0 ? 0 : l - WINDOW; const int j1 = l + WINDOW > SEQ - 1 ? SEQ - 1 : l + WINDOW; nwin = j1 - j0 + 1; }
        else b = (row - ML) / CTX;
        const int nk = nwin + CTX;
        float mx = -3.0e38f;
        for (int j = lane; j < nk; j += 64) {
            const int krow = j < nwin ? b * SEQ + j0 + j : ML + b * CTX + (j - nwin);
            const bf16_t* kr = Kb + (size_t)krow * KVW + kv * HD;
            float s = 0.f;
#pragma unroll
            for (int d = 0; d < HD; d += 8) { const u32x4 w = *(const u32x4*)(kr + d);
                s += qs[d] * bf_lo(w.x) + qs[d + 1] * bf_hi(w.x) + qs[d + 2] * bf_lo(w.y) + qs[d + 3] * bf_hi(w.y) + qs[d + 4] * bf_lo(w.z) + qs[d + 5] * bf_hi(w.z) + qs[d + 6] * bf_lo(w.w) + qs[d + 7] * bf_hi(w.w); }
            ps[j] = s; mx = fmaxf(mx, s);
        }
        mx = fmaxf(wave_max(mx), sk);
        float sum = 0.f;
        for (int j = lane; j < nk; j += 64) { const float e = __builtin_amdgcn_exp2f(ps[j] - mx); ps[j] = e; sum += e; }
        sum = wave_sum(sum) + __builtin_amdgcn_exp2f(sk - mx);
        float o0 = 0.f, o1 = 0.f;
        for (int j = 0; j < nk; ++j) {
            const int krow = j < nwin ? b * SEQ + j0 + j : ML + b * CTX + (j - nwin);
            const unsigned w = *(const unsigned*)(Vb + (size_t)krow * KVW + kv * HD + 2 * lane);
            const float pj = ps[j]; o0 += pj * bf_lo(w); o1 += pj * bf_hi(w);
        }
        const float inv = 1.f / sum; o0 *= inv; o1 *= inv;
        const float part = wave_sum(o0 * o0 + o1 * o1);
        const float z0 = ZT[(size_t)(2 * tid) * MT + row], z1 = ZT[(size_t)(2 * tid + 1) * MT + row];
        const float parth = wave_sum(z0 * z0 + z1 * z1);
        __syncthreads();
        if (lane == 0) { red[wave] = part; red[8 + wave] = parth; }
        __syncthreads();
        float tot = 0.f, toth = 0.f;
#pragma unroll
        for (int i = 0; i < 8; ++i) { tot += red[i]; toth += red[8 + i]; }
        const float r = 1.0f / sqrtf(tot * (1.0f / ATTW) + EPS), rh = 1.0f / sqrtf(toth * (1.0f / HY) + EPS);
        const int c = h * HD + 2 * lane;
        *(unsigned*)(YM + (size_t)row * D + HY + c) = pk2(o0 * r * gat[c], o1 * r * gat[c + 1]);
        *(unsigned*)(YM + (size_t)row * D + 2 * tid) = pk2(z0 * rh * ghy[2 * tid], z1 * rh * ghy[2 * tid + 1]);
    }
    __syncthreads();
}

__device__ __forceinline__ float phy_at(const bf16_t* PHY, int row, int ch) { return bf1(PHY[((size_t)(ch >> 2) * MT + row) * 4 + (ch & 3)]); }
__device__ __forceinline__ float sconv(const bf16_t* PHY, const float* cw, const float* cb, int row, int ch, int l, int L) {
    float a = cb[ch] + cw[3 * HY + ch] * phy_at(PHY, row, ch);
    if (l > 0) a += cw[ch] * phy_at(PHY, row - 1, ch);
    if (l < L - 1) a += cw[2 * 3 * HY + ch] * phy_at(PHY, row + 1, ch);
    return a;
}
template <int L>
__device__ __forceinline__ void hyena_direct(LAS unsigned char* lds, int layer, int G, int row_base, const int wave_s) {
    FRESH_IDS; FRESH_KP;
    unsigned char* ws = Pp->ws;
    constexpr int TPB = L < NTHR ? L : NTHR, NI = L / TPB;
    const bf16_t* PHY = (const bf16_t*)(ws + WS_PHY); float* ZT = (float*)(ws + WS_SSHY);
    const f32x2* TF = L == SEQ ? (const f32x2*)(ws + WS_FLT) + (size_t)layer * HY * SEQ : (const f32x2*)(ws + WS_FLTC) + (size_t)layer * HY * CTX;
    const f32x2* TB = L == SEQ ? (const f32x2*)(ws + WS_FLT) + (size_t)(DEPTH + layer) * HY * SEQ : (const f32x2*)(ws + WS_FLTC) + (size_t)(DEPTH + layer) * HY * CTX;
    const float* cw = Pp->in[9] + (size_t)layer * 3 * 3 * HY; const float* cb = Pp->in[10] + (size_t)layer * 3 * HY;
    const float* fbias = Pp->in[17] + (size_t)layer * 2 * HY;
    LAS float* G0 = (LAS float*)lds; LAS float* G1 = G0 + 2 * L; LAS float* z = G1 + 2 * L;
    for (int it = blockIdx.x; it < HY * BATCH; it += G) {
        const int c = it % HY, seq = it / HY, row0 = row_base + seq * L;
        __syncthreads();
#pragma nounroll
        for (int d = tid; d < L; d += NTHR) {
            { const f32x2 f = TF[(size_t)c * L + d]; G0[L - 1 + d] = f.x; G1[L - 1 + d] = f.y; }
            if (d > 0) { const f32x2 bk = TB[(size_t)c * L + d]; G0[L - 1 - d] = bk.x; G1[L - 1 - d] = bk.y; }
            z[d] = sconv(PHY, cw, cb, row0 + d, 2 * HY + c, d, L);
        }
        __syncthreads();
#pragma unroll
        for (int o = 0; o < 2; ++o) {
            LAS float* Gg = o ? G1 : G0;
            float acc[NI], zn[NI];
#pragma unroll
            for (int i = 0; i < NI; ++i) acc[i] = 0.f;
            if (tid < TPB) {
                for (int s = 0; s < L; ++s) { const float zs = z[s];
#pragma unroll
                    for (int i = 0; i < NI; ++i) acc[i] += zs * Gg[tid + TPB * i - s + L - 1]; }
                const float fb = fbias[o * HY + c];
#pragma nounroll
                for (int i = 0; i < NI; ++i) { const int t = tid + TPB * i; zn[i] = sconv(PHY, cw, cb, row0 + t, o * HY + c, t, L) * (acc[i] + fb * z[t]); }
            }
            __syncthreads();
            if (tid < TPB) {
#pragma unroll
                for (int i = 0; i < NI; ++i) z[tid + TPB * i] = zn[i];
            }
            __syncthreads();
        }
        if (tid < TPB) {
#pragma unroll
            for (int i = 0; i < NI; ++i) { const int t = tid + TPB * i; ZT[(size_t)c * MT + row0 + t] = z[t]; } }
    }
    __syncthreads();
}

constexpr int FN = 8192, FPAD = FN + FN / 32;
__device__ __forceinline__ int fpad(int p) { return p + (p >> 5); }
__device__ __forceinline__ f32x2 cmul(f32x2 a, f32x2 b) { return (f32x2){a.x * b.x - a.y * b.y, a.x * b.y + a.y * b.x}; }
__device__ __forceinline__ f32x2 cmulc(f32x2 a, f32x2 b) { return (f32x2){a.x * b.x + a.y * b.y, a.y * b.x - a.x * b.y}; }
template <bool INV> __device__ __forceinline__ f32x2 cmul_tw(f32x2 a, f32x2 w) { return INV ? cmulc(a, w) : cmul(a, w); }
template <bool INV> __device__ __forceinline__ void dft4(f32x2& x0, f32x2& x1, f32x2& x2, f32x2& x3) {
    const f32x2 t0 = x0 + x2, t1 = x0 - x2, t2 = x1 + x3, t3 = x1 - x3;
    const f32x2 jt3 = INV ? (f32x2){-t3.y, t3.x} : (f32x2){t3.y, -t3.x};
    x0 = t0 + t2; x2 = t0 - t2; x1 = t1 + jt3; x3 = t1 - jt3;
}
template <bool INV> __device__ __forceinline__ void dft16(f32x2 (&x)[16]) {
    constexpr float C1 = 0.92387953251128674f, S1 = 0.38268343236508977f, C2 = 0.70710678118654752f;
#pragma unroll
    for (int b = 0; b < 4; ++b) dft4<INV>(x[b], x[4 + b], x[8 + b], x[12 + b]);
    const f32x2 w1 = {C1, -S1}, w2 = {C2, -C2}, w3 = {S1, -C1}, w4 = {0.f, -1.f}, w6 = {-C2, -C2}, w9 = {-C1, S1};
    x[4 * 1 + 1] = cmul_tw<INV>(x[5], w1); x[4 * 1 + 2] = cmul_tw<INV>(x[6], w2); x[4 * 1 + 3] = cmul_tw<INV>(x[7], w3);
    x[4 * 2 + 1] = cmul_tw<INV>(x[9], w2); x[4 * 2 + 2] = cmul_tw<INV>(x[10], w4); x[4 * 2 + 3] = cmul_tw<INV>(x[11], w6);
    x[4 * 3 + 1] = cmul_tw<INV>(x[13], w3); x[4 * 3 + 2] = cmul_tw<INV>(x[14], w6); x[4 * 3 + 3] = cmul_tw<INV>(x[15], w9);
#pragma unroll
    for (int c = 0; c < 4; ++c) dft4<INV>(x[4 * c], x[4 * c + 1], x[4 * c + 2], x[4 * c + 3]);
    f32x2 y[16];
#pragma unroll
    for (int k = 0; k < 16; ++k) y[k] = x[4 * (k & 3) + (k >> 2)];
#pragma unroll
    for (int k = 0; k < 16; ++k) x[k] = y[k];
}
template <bool INV> __device__ __forceinline__ void dft32(f32x2 (&x)[32]) {
    constexpr float CS[16] = {1.f, 0.98078528040323043f, 0.92387953251128674f, 0.83146961230254524f, 0.70710678118654752f, 0.55557023301960218f, 0.38268343236508977f, 0.19509032201612825f,
                              0.f, -0.19509032201612825f, -0.38268343236508977f, -0.55557023301960218f, -0.70710678118654752f, -0.83146961230254524f, -0.92387953251128674f, -0.98078528040323043f};
    constexpr float SN[16] = {0.f, 0.19509032201612825f, 0.38268343236508977f, 0.55557023301960218f, 0.70710678118654752f, 0.83146961230254524f, 0.92387953251128674f, 0.98078528040323043f,
                              1.f, 0.98078528040323043f, 0.92387953251128674f, 0.83146961230254524f, 0.70710678118654752f, 0.55557023301960218f, 0.38268343236508977f, 0.19509032201612825f};
    f32x2 a[16], b[16];
#pragma unroll
    for (int j = 0; j < 16; ++j) { a[j] = x[j] + x[j + 16]; const f32x2 d = x[j] - x[j + 16]; b[j] = cmul_tw<INV>(d, (f32x2){CS[j], -SN[j]}); }
    dft16<INV>(a); dft16<INV>(b);
#pragma unroll
    for (int k = 0; k < 16; ++k) { x[2 * k] = a[k]; x[2 * k + 1] = b[k]; }
}
__device__ __forceinline__ void tw_powers(f32x2 w1, f32x2 (&w)[16]) {
    w[1] = w1; w[2] = cmul(w1, w1); w[3] = cmul(w[2], w1); w[4] = cmul(w[2], w[2]); w[5] = cmul(w[4], w1); w[6] = cmul(w[3], w[3]); w[7] = cmul(w[4], w[3]);
    w[8] = cmul(w[4], w[4]); w[9] = cmul(w[8], w1); w[10] = cmul(w[5], w[5]); w[11] = cmul(w[8], w[3]); w[12] = cmul(w[6], w[6]); w[13] = cmul(w[8], w[5]); w[14] = cmul(w[7], w[7]); w[15] = cmul(w[8], w[7]);
}
__device__ __forceinline__ f32x2 tw_base(float turns) { asm volatile("" : "+v"(turns)); return (f32x2){__builtin_amdgcn_cosf(turns), -__builtin_amdgcn_sinf(turns)}; }
__device__ __forceinline__ void fft_fwd1(f32x2 (&x)[16], LAS f32x2* B, int n2) {
    asm volatile("" : "+v"(n2));
    dft16<false>(x); f32x2 w[16]; tw_powers(tw_base((float)n2 * (1.0f / 8192.f)), w);
    B[fpad(n2)] = x[0];
#pragma unroll
    for (int k = 1; k < 16; ++k) B[fpad(512 * k + n2)] = cmul(x[k], w[k]);
}
__device__ __forceinline__ void fft_fwd2(LAS f32x2* B, int tid) {
    asm volatile("" : "+v"(tid));
    const int b = tid >> 5, n2 = tid & 31, base = 512 * b + n2; f32x2 x[16];
#pragma unroll
    for (int r = 0; r < 16; ++r) x[r] = B[fpad(base + 32 * r)];
    dft16<false>(x); f32x2 w[16]; tw_powers(tw_base((float)n2 * (1.0f / 512.f)), w);
    B[fpad(base)] = x[0];
#pragma unroll
    for (int k = 1; k < 16; ++k) B[fpad(base + 32 * k)] = cmul(x[k], w[k]);
}
__device__ __forceinline__ void fft_fwd3(LAS f32x2* B, int tid) {
    asm volatile("" : "+v"(tid));
    if (tid < 256) { f32x2 x[32]; LAS f32x2* p = B + 33 * tid;
#pragma unroll
        for (int j = 0; j < 32; ++j) x[j] = p[j];
        dft32<false>(x);
#pragma unroll
        for (int j = 0; j < 32; ++j) p[j] = x[j]; }
}
template <int ORD> __device__ __forceinline__ void fft_mid(LAS f32x2* B, const LAS f32x2* F, int tid) {
    asm volatile("" : "+v"(tid));
    if (tid < 256) { f32x2 x[32]; LAS f32x2* p = B + 33 * tid;
#pragma unroll
        for (int j = 0; j < 32; ++j) x[j] = p[j];
        __builtin_amdgcn_sched_barrier(0); dft32<false>(x); __builtin_amdgcn_sched_barrier(0);
        const int k1 = tid >> 4, k2 = tid & 15, kb1 = (16 - k1) & 15, b1 = k1 != 0 ? 1 : 0, kb2 = (16 - k2 - b1) & 15, b2 = (k2 != 0 || b1) ? 1 : 0;
        const LAS f32x2* fa = F + 33 * tid; const LAS f32x2* fb = F + 33 * (16 * kb1 + kb2); const LAS f32x2* fbq = fb + (1 - b2);
        constexpr float SC = 1.0f / (2.0f * (float)FN);
#pragma unroll
        for (int j = 0; j < 32; ++j) { const f32x2 A = fa[j], Bm = j == 0 ? (b2 ? fb[31] : fa[0]) : fbq[31 - j];
            const f32x2 H = ORD == 0 ? (f32x2){(A.x + Bm.x) * SC, (A.y - Bm.y) * SC} : (f32x2){(A.y + Bm.y) * SC, (Bm.x - A.x) * SC};
            x[j] = cmul(x[j], H); if ((j & 7) == 7) __builtin_amdgcn_sched_barrier(0); }
        dft32<true>(x); __builtin_amdgcn_sched_barrier(0);
#pragma unroll
        for (int j = 0; j < 32; ++j) p[j] = x[j]; }
}
__device__ __forceinline__ void fft_inv2(LAS f32x2* B, int tid) {
    asm volatile("" : "+v"(tid));
    const int b = tid >> 5, n2 = tid & 31, base = 512 * b + n2; f32x2 x[16]; f32x2 w[16]; tw_powers(tw_base((float)n2 * (1.0f / 512.f)), w);
    x[0] = B[fpad(base)];
#pragma unroll
    for (int k = 1; k < 16; ++k) x[k] = cmulc(B[fpad(base + 32 * k)], w[k]);
    dft16<true>(x);
#pragma unroll
    for (int r = 0; r < 16; ++r) B[fpad(base + 32 * r)] = x[r];
}
__device__ __forceinline__ void fft_inv1(f32x2 (&x)[16], const LAS f32x2* B, int n2) {
    asm volatile("" : "+v"(n2));
    f32x2 w[16]; tw_powers(tw_base((float)n2 * (1.0f / 8192.f)), w);
    x[0] = B[fpad(n2)];
#pragma unroll
    for (int k = 1; k < 16; ++k) x[k] = cmulc(B[fpad(512 * k + n2)], w[k]);
    dft16<true>(x);
}
#define WG_SYNC() do { asm volatile("s_waitcnt lgkmcnt(0)" ::: "memory"); __builtin_amdgcn_s_barrier(); asm volatile("" ::: "memory"); } while (0)
__device__ __forceinline__ void hy_stage(LAS float* plane, const bf16_t* PHY, int cg, int jc, int tid) {
    asm volatile("" : "+v"(tid));
    const u32x4* src = (const u32x4*)(PHY + (size_t)cg * MT * 4);
#pragma unroll
    for (int k = 0; k < 8; ++k) { const int i = tid + 512 * k; const u32x4 v = src[i];
        const unsigned w0 = (jc & 2) ? v.y : v.x, w1 = (jc & 2) ? v.w : v.z;
        f32x2 o; o.x = (jc & 1) ? bf_hi(w0) : bf_lo(w0); o.y = (jc & 1) ? bf_hi(w1) : bf_lo(w1);
        *(LAS f32x2*)(plane + 2 * i) = o; }
}
__device__ __forceinline__ void hy_sconv(const LAS float* plane, float w0, float w1, float w2, float cb, int n2, float (&u)[8][2]) {
    asm volatile("" : "+v"(n2));
#pragma unroll
    for (int r = 0; r < 8; ++r)
#pragma unroll
        for (int b = 0; b < 2; ++b) { const int t = n2 + 512 * r, row = b * SEQ + t;
            float a = cb + w1 * plane[row];
            if (t > 0) a += w0 * plane[row - 1];
            if (t < SEQ - 1) a += w2 * plane[row + 1];
            u[r][b] = a; }
}
__device__ __forceinline__ void hyena_fft(LAS unsigned char* lds, int layer, int G, const int wave_s) {
    FRESH_IDS; FRESH_KP;
    unsigned char* ws = Pp->ws;
    const bf16_t* PHY = (const bf16_t*)(ws + WS_PHY); float* ZT = (float*)(ws + WS_SSHY);
    const f32x2* TF = (const f32x2*)(ws + WS_FLT) + (size_t)layer * HY * SEQ; const f32x2* TB = (const f32x2*)(ws + WS_FLT) + (size_t)(DEPTH + layer) * HY * SEQ;
    const float* cw = Pp->in[9] + (size_t)layer * 3 * 3 * HY; const float* cb = Pp->in[10] + (size_t)layer * 3 * HY; const float* fbias = Pp->in[17] + (size_t)layer * 2 * HY;
    LAS f32x2* Db = (LAS f32x2*)lds; LAS f32x2* Fb = Db + FPAD;
    LAS float* pl0 = (LAS float*)lds; LAS float* pl1 = pl0 + 2 * SEQ;
    const int n2 = tid;
    for (int unit = blockIdx.x; unit < HY / 4; unit += G) {
#pragma nounroll
        for (int jc = 0; jc < 4; ++jc) { const int c = 4 * unit + jc;
            WG_SYNC();
            { f32x2 x[16]; const f32x2* tf = TF + (size_t)c * SEQ; const f32x2* tb = TB + (size_t)c * SEQ;
#pragma unroll
              for (int r = 0; r < 8; ++r) x[r] = tf[n2 + 512 * r];
#pragma unroll
              for (int r = 8; r < 16; ++r) { const int l = FN - 512 * r - n2; x[r] = l < SEQ ? tb[l] : (f32x2){0.f, 0.f}; }
              __builtin_amdgcn_sched_barrier(0); fft_fwd1(x, Fb, n2); __builtin_amdgcn_sched_barrier(0); }
            hy_stage(pl0, PHY, 2 * (HY / 4) + unit, jc, tid); __builtin_amdgcn_sched_barrier(0); hy_stage(pl1, PHY, unit, jc, tid); __builtin_amdgcn_sched_barrier(0);
            WG_SYNC();
            float uz[8][2], ux[8][2];
            hy_sconv(pl0, cw[2 * HY + c], cw[3 * HY + 2 * HY + c], cw[6 * HY + 2 * HY + c], cb[2 * HY + c], n2, uz);
            __builtin_amdgcn_sched_barrier(0); hy_sconv(pl1, cw[c], cw[3 * HY + c], cw[6 * HY + c], cb[c], n2, ux); __builtin_amdgcn_sched_barrier(0);
            fft_fwd2(Fb, tid); __builtin_amdgcn_sched_barrier(0);
            WG_SYNC();
            fft_fwd3(Fb, tid); __builtin_amdgcn_sched_barrier(0);
            f32x2 x[16];
#pragma unroll
            for (int r = 0; r < 8; ++r) { x[r] = (f32x2){uz[r][0], uz[r][1]}; x[r + 8] = (f32x2){0.f, 0.f}; }
            fft_fwd1(x, Db, n2); WG_SYNC(); fft_fwd2(Db, tid); WG_SYNC(); fft_mid<0>(Db, Fb, tid); WG_SYNC(); fft_inv2(Db, tid); WG_SYNC(); fft_inv1(x, Db, n2);
            { const float fb0 = fbias[c];
#pragma unroll
              for (int r = 0; r < 8; ++r) { uz[r][0] = ux[r][0] * (x[r].x + fb0 * uz[r][0]); uz[r][1] = ux[r][1] * (x[r].y + fb0 * uz[r][1]); } }
            WG_SYNC();
            hy_stage(pl0, PHY, (HY / 4) + unit, jc, tid);
            WG_SYNC();
            hy_sconv(pl0, cw[HY + c], cw[3 * HY + HY + c], cw[6 * HY + HY + c], cb[HY + c], n2, ux);
            WG_SYNC();
#pragma unroll
            for (int r = 0; r < 8; ++r) { x[r] = (f32x2){uz[r][0], uz[r][1]}; x[r + 8] = (f32x2){0.f, 0.f}; }
            fft_fwd1(x, Db, n2); WG_SYNC(); fft_fwd2(Db, tid); WG_SYNC(); fft_mid<1>(Db, Fb, tid); WG_SYNC(); fft_inv2(Db, tid); WG_SYNC(); fft_inv1(x, Db, n2);
            { const float fb1 = fbias[HY + c]; float* zo = ZT + (size_t)c * MT;
#pragma unroll
              for (int r = 0; r < 8; ++r) { const int t = n2 + 512 * r;
                  zo[t] = ux[r][0] * (x[r].x + fb1 * uz[r][0]); zo[SEQ + t] = ux[r][1] * (x[r].y + fb1 * uz[r][1]); } }
        }
    }
    WG_SYNC();
}

using f32x16 = __attribute__((ext_vector_type(16))) float;
using s16x4 = __attribute__((ext_vector_type(4))) short;
using bf16x8 = pg8::bf16x8;
#define AT_KSWZ(row, colB) ((row) * 256 + ((colB) ^ (((row) & 7) << 4)))
__device__ __forceinline__ int crow(int r, int hi) { return (r & 3) + 8 * (r >> 2) + 4 * hi; }
__device__ __forceinline__ unsigned cvtpk(float lo, float hi) { unsigned r; asm volatile("v_cvt_pk_bf16_f32 %0, %1, %2" : "=v"(r) : "v"(lo), "v"(hi)); return r; }
__device__ __forceinline__ int v_st(int k, int c) { const int kk = (k & ~0xC) | ((k & 4) << 1) | ((k & 8) >> 1); return ((kk >> 3) * 4 + (c >> 5)) * 512 + ((kk & 7) * 32 + (c & 31)) * 2; }
__device__ __forceinline__ int v_rd_base(int lane) { return ((lane & 3) << 3) | (((lane >> 2) & 3) << 6) | (((lane >> 4) & 1) << 5) | (((lane >> 5) & 1) << 8); }
constexpr int v_rd_off(int d0, int ks, int half) { return d0 * 512 + ks * 4096 + half * 2048; }
template <int OFF> __device__ __forceinline__ s16x4 tr_read(int vb) { s16x4 r; asm volatile("ds_read_b64_tr_b16 %0, %1 offset:%2" : "=&v"(r) : "v"(vb), "i"(OFF) : "memory"); return r; }
template <int D0> __device__ __forceinline__ void pv_one(f32x16& od, int vb, bf16x8 pa0, bf16x8 pa1) {
    const s16x4 l0 = tr_read<v_rd_off(D0, 0, 0)>(vb), h0 = tr_read<v_rd_off(D0, 0, 1)>(vb), l1 = tr_read<v_rd_off(D0, 1, 0)>(vb), h1 = tr_read<v_rd_off(D0, 1, 1)>(vb);
    asm volatile("s_waitcnt lgkmcnt(0)" ::: "memory"); __builtin_amdgcn_sched_barrier(0);
#define AT_PK(L, H) (bf16x8){L[0], L[1], L[2], L[3], H[0], H[1], H[2], H[3]}
    od = __builtin_amdgcn_mfma_f32_32x32x16_bf16(pa0, AT_PK(l0, h0), od, 0, 0, 0);
    od = __builtin_amdgcn_mfma_f32_32x32x16_bf16(pa1, AT_PK(l1, h1), od, 0, 0, 0);
#undef AT_PK
}
constexpr int AT_BUF = 32768;
constexpr int AT_SCR = 8 * 32 * 272;
constexpr int AT_XA = AT_SCR + 2048;
constexpr int AT_XH = AT_XA + 1024;
constexpr int AT_OST = 0;
__device__ __forceinline__ void attn_mfma(LAS unsigned char* lds, int layer, int G, const int wave_s) {
    FRESH_IDS; FRESH_KP;
    unsigned char* ws = Pp->ws;
    const bf16_t* Q = (const bf16_t*)(ws + WS_Q); const bf16_t* Kb = (const bf16_t*)(ws + WS_K); const bf16_t* Vb = (const bf16_t*)(ws + WS_V);
    bf16_t* YM = (bf16_t*)(ws + WS_YM); const float* ZT = (const float*)(ws + WS_SSHY);
    const float* gat = Pp->in[20] + layer * ATTW; const float* ghy = Pp->in[19] + layer * HY;
    const int r32 = lane & 31, hi = lane >> 5, h = wave, kv = h >> 2;
    const float sk = Pp->in[18][layer * NH + h] * LOG2E;
    const unsigned lbase = (unsigned)(uintptr_t)lds;
    LAS float* al_l = (LAS float*)(lds + AT_SCR) + wave * 64; LAS float* li_l = al_l + 32;
    LAS float* xa = (LAS float*)(lds + AT_XA); LAS float* xh = (LAS float*)(lds + AT_XH);
    const int sr = tid >> 4, sc = (tid & 15) * 8;
    const int vst = v_st(sr, sc), kst = AT_KSWZ(sr, sc * 2);
    const int nunits = layer == DEPTH - 1 ? ML / 32 : MT / 32;
    for (int unit = blockIdx.x; unit < nunits; unit += G) {
        const bool isc = unit >= ML / 32;
        int b, q0, rowbase;
        if (!isc) { b = unit >> 7; q0 = (unit & 127) * 32; rowbase = b * SEQ + q0; } else { const int u = unit - ML / 32; b = u >> 3; q0 = (u & 7) * 32; rowbase = ML + b * CTX + q0; }
        int t_lo = 0, nw = 0;
        if (!isc) { t_lo = q0 < 128 ? (128 - q0) / 32 : 0; const int t_hi = (SEQ + 96 - q0) / 32 < 8 ? (SEQ + 96 - q0) / 32 : 8; nw = t_hi - t_lo + 1; }
        const int NT = nw + CTX / 32;
        bf16x8 qr[8];
        { const bf16_t* qp = Q + (size_t)(rowbase + r32) * ATTW + h * HD + hi * 8;
#pragma unroll
          for (int d0 = 0; d0 < 8; ++d0) qr[d0] = *(const bf16x8*)(qp + d0 * 16); }
        float m_reg = sk, l_reg = 1.0f; f32x16 o[4];
#pragma unroll
        for (int d = 0; d < 4; ++d)
#pragma unroll
            for (int r = 0; r < 16; ++r) o[d][r] = 0.f;
        bf16x8 s_k0, s_k1, s_v0, s_v1;
#define AT_KEYROW(i) ((i) < nw ? b * SEQ + q0 - 128 + 32 * (t_lo + (i)) : ML + b * CTX + 32 * ((i) - nw))
#define AT_SLOAD(i) do { const size_t kr_ = (size_t)(AT_KEYROW(i) + sr) * KVW + sc; s_k0 = *(const bf16x8*)(Kb + kr_); s_k1 = *(const bf16x8*)(Kb + kr_ + HD); s_v0 = *(const bf16x8*)(Vb + kr_); s_v1 = *(const bf16x8*)(Vb + kr_ + HD); } while (0)
#define AT_SWRITE(bf) do { LAS unsigned char* sb_ = lds + (bf) * AT_BUF; *(LAS bf16x8*)(sb_ + kst) = s_k0; *(LAS bf16x8*)(sb_ + 8192 + kst) = s_k1; *(LAS bf16x8*)(sb_ + 16384 + vst) = s_v0; *(LAS bf16x8*)(sb_ + 24576 + vst) = s_v1; } while (0)
        __syncthreads();
        AT_SLOAD(0); AT_SWRITE(0);
        __syncthreads();
#pragma nounroll
        for (int i = 0; i < NT; ++i) {
            const int bf = i & 1;
            if (i + 1 < NT) AT_SLOAD(i + 1);
            f32x16 p0;
#pragma unroll
            for (int r = 0; r < 16; ++r) p0[r] = 0.f;
            { const LAS unsigned char* Ks = lds + bf * AT_BUF + kv * 8192;
#pragma unroll
              for (int d0 = 0; d0 < 8; ++d0) { const int cb = (d0 * 16 + hi * 8) * 2; const bf16x8 kf = *(const LAS bf16x8*)(Ks + AT_KSWZ(r32, cb));
                  p0 = __builtin_amdgcn_mfma_f32_32x32x16_bf16(kf, qr[d0], p0, 0, 0, 0); } }
            if (i < nw) { const int t = t_lo + i;
                if (t == 0) {
#pragma unroll
                    for (int r = 0; r < 16; ++r) if (crow(r, hi) < r32) p0[r] = -1.0e30f; }
                else if (t == 8) {
#pragma unroll
                    for (int r = 0; r < 16; ++r) if (crow(r, hi) > r32) p0[r] = -1.0e30f; } }
            float pmax = p0[0];
#pragma unroll
            for (int r = 1; r < 16; ++r) pmax = fmaxf(pmax, p0[r]);
            { auto rr = __builtin_amdgcn_permlane32_swap(__float_as_uint(pmax), __float_as_uint(pmax), false, false); pmax = fmaxf(__uint_as_float(rr[0]), __uint_as_float(rr[1])); }
            const float mn = fmaxf(m_reg, pmax), alpha = __builtin_amdgcn_exp2f(m_reg - mn); m_reg = mn;
            float ps = 0.f;
#pragma unroll
            for (int r = 0; r < 16; ++r) { p0[r] = __builtin_amdgcn_exp2f(p0[r] - mn); ps += p0[r]; }
            { auto rr = __builtin_amdgcn_permlane32_swap(__float_as_uint(ps), __float_as_uint(ps), false, false); ps = __uint_as_float(rr[0]) + __uint_as_float(rr[1]); }
            l_reg = l_reg * alpha + ps;
            if (__any(alpha < 1.f)) { if (hi == 0) al_l[r32] = alpha; asm volatile("s_waitcnt lgkmcnt(0)" ::: "memory");
#pragma unroll
                for (int d = 0; d < 4; ++d)
#pragma unroll
                    for (int r = 0; r < 16; ++r) o[d][r] *= al_l[crow(r, hi)]; }
            bf16x8 pa0, pa1;
#define AT_PK4(P, BASE, OUT) do { unsigned a0 = cvtpk(P[BASE + 0], P[BASE + 1]), a1 = cvtpk(P[BASE + 2], P[BASE + 3]); unsigned b0 = cvtpk(P[BASE + 4], P[BASE + 5]), b1 = cvtpk(P[BASE + 6], P[BASE + 7]); \
    auto r0 = __builtin_amdgcn_permlane32_swap(a0, b0, false, false); auto r1 = __builtin_amdgcn_permlane32_swap(a1, b1, false, false); u32x4 w = {r0[0], r1[0], r0[1], r1[1]}; OUT = *reinterpret_cast<bf16x8*>(&w); } while (0)
            AT_PK4(p0, 0, pa0); AT_PK4(p0, 8, pa1);
#undef AT_PK4
            { const int vb = (int)(lbase + bf * AT_BUF + 16384 + kv * 8192) + v_rd_base(lane);
              pv_one<0>(o[0], vb, pa0, pa1); pv_one<1>(o[1], vb, pa0, pa1); pv_one<2>(o[2], vb, pa0, pa1); pv_one<3>(o[3], vb, pa0, pa1); }
            if (i + 1 < NT) AT_SWRITE(bf ^ 1);
            __syncthreads();
        }
#undef AT_SLOAD
#undef AT_SWRITE
#undef AT_KEYROW
        if (hi == 0) li_l[r32] = l_reg; asm volatile("s_waitcnt lgkmcnt(0)" ::: "memory");
        float part[16];
#pragma unroll
        for (int r = 0; r < 16; ++r) { const float rl = __builtin_amdgcn_rcpf(li_l[crow(r, hi)]); float s = 0.f;
#pragma unroll
            for (int d = 0; d < 4; ++d) { o[d][r] *= rl; s += o[d][r] * o[d][r]; }
#pragma unroll
            for (int m = 1; m < 32; m <<= 1) s += __shfl_xor(s, m);
            part[r] = s; }
        if (r32 == 0) {
#pragma unroll
            for (int r = 0; r < 16; ++r) xa[wave * 32 + crow(r, hi)] = part[r]; }
        const int cgp = wave * 2 + hi, c0 = cgp * 64;
        float zv[64]; float sh = 0.f;
        { const float* zp = ZT + (size_t)c0 * MT + rowbase + r32;
#pragma unroll
          for (int j = 0; j < 64; ++j) { zv[j] = zp[(size_t)j * MT]; sh += zv[j] * zv[j]; } }
        xh[cgp * 32 + r32] = sh;
        __syncthreads();
        float ta = 0.f, th = 0.f;
#pragma unroll
        for (int w = 0; w < 8; ++w) ta += xa[w * 32 + r32];
#pragma unroll
        for (int g = 0; g < 16; ++g) th += xh[g * 32 + r32];
        const float ra = 1.0f / sqrtf(ta * (1.0f / ATTW) + EPS), rh = 1.0f / sqrtf(th * (1.0f / HY) + EPS);
        { bf16_t* yp = YM + (size_t)(rowbase + r32) * D + c0;
#pragma unroll
          for (int j = 0; j < 64; j += 8) { const f32x4 g0 = *(const f32x4*)(ghy + c0 + j), g1 = *(const f32x4*)(ghy + c0 + j + 4);
              u32x4 w; w.x = pk2(zv[j] * rh * g0[0], zv[j + 1] * rh * g0[1]); w.y = pk2(zv[j + 2] * rh * g0[2], zv[j + 3] * rh * g0[3]);
              w.z = pk2(zv[j + 4] * rh * g1[0], zv[j + 5] * rh * g1[1]); w.w = pk2(zv[j + 6] * rh * g1[2], zv[j + 7] * rh * g1[3]);
              *(u32x4*)(yp + j) = w; } }
        if (hi == 0) al_l[r32] = ra; asm volatile("s_waitcnt lgkmcnt(0)" ::: "memory");
        { LAS unsigned char* ost = lds + AT_OST + wave * (32 * 272);
          float gc[4];
#pragma unroll
          for (int d = 0; d < 4; ++d) gc[d] = gat[h * HD + 32 * d + r32];
#pragma unroll
          for (int r = 0; r < 16; ++r) { const int q = crow(r, hi); const float rq = al_l[q];
#pragma unroll
              for (int d = 0; d < 4; ++d) *(LAS bf16_t*)(ost + q * 272 + (32 * d + r32) * 2) = (bf16_t)f2bf(o[d][r] * rq * gc[d]); }
          asm volatile("s_waitcnt lgkmcnt(0)" ::: "memory");
#pragma unroll
          for (int k = 0; k < 8; ++k) { const int q = k * 4 + (lane >> 4), ch = lane & 15;
              const u32x4 v = *(const LAS u32x4*)(ost + q * 272 + ch * 16);
              *(u32x4*)(YM + (size_t)(rowbase + q) * D + HY + h * HD + ch * 8) = v; } }
    }
    __syncthreads();
}


#define CS_KSWZ(row, colB) ((row) * 256 + ((colB) ^ (((row) & 7) << 4)))
template <int K>
__device__ __forceinline__ void ctx_small_gemm(LAS unsigned char* lds, const bf16_t* A, int lda, const bf16_t* Bt, int ldb, float* X, const float* gate, const float* gnext, bf16_t* AN, float* ssqc, int G, const int wave_s, const int live = 1) {
    FRESH_IDS;
    typedef float f32x16_ __attribute__((ext_vector_type(16)));
    constexpr int NCH = K / 128, SLOT = 32768;
    static_assert(NCH >= 4, "ring depth");
    const int r32 = lane & 31, hi = lane >> 5, wm = wave & 1, wn = (wave >> 1) & 1, wk = wave >> 2;
    LAS float* red = (LAS float*)lds;
    LAS float* rsum = (LAS float*)(lds + 16384);
    for (int tile = blockIdx.x; tile < (MC / 64) * (D / 64); tile += G) {
        const int rb = tile >> 5, cb = 4 * (tile & 7) + ((tile >> 3) & 3);
        const char* asrc[2]; const char* bsrc[2];
#pragma unroll
        for (int j = 0; j < 2; ++j) { const int pos = j * 8192 + wave * 1024 + lane * 16, row = pos >> 8, colB = (pos & 255) ^ ((row & 7) << 4);
            asrc[j] = (const char*)(A + (size_t)(rb * 64 + row) * lda) + colB; bsrc[j] = (const char*)(Bt + (size_t)(cb * 64 + row) * ldb) + colB; }
#define CS_ISSUE(ch) do { LAS unsigned char* sl_ = lds + ((ch) & 3) * SLOT + wave * 1024; \
        __builtin_amdgcn_global_load_lds((const unsigned*)(asrc[0] + (size_t)(ch) * 256), (LAS unsigned*)(sl_), 16, 0, 0); \
        __builtin_amdgcn_global_load_lds((const unsigned*)(asrc[1] + (size_t)(ch) * 256), (LAS unsigned*)(sl_ + 8192), 16, 0, 0); \
        __builtin_amdgcn_global_load_lds((const unsigned*)(bsrc[0] + (size_t)(ch) * 256), (LAS unsigned*)(sl_ + 16384), 16, 0, 0); \
        __builtin_amdgcn_global_load_lds((const unsigned*)(bsrc[1] + (size_t)(ch) * 256), (LAS unsigned*)(sl_ + 24576), 16, 0, 0); } while (0)
        __syncthreads();
        CS_ISSUE(0); CS_ISSUE(1); CS_ISSUE(2);
        f32x16_ acc;
#pragma unroll
        for (int q = 0; q < 16; ++q) acc[q] = 0.f;
        const int aoff = CS_KSWZ(wm * 32 + r32, (wk * 64 + hi * 8) * 2), boff = 16384 + CS_KSWZ(wn * 32 + r32, (wk * 64 + hi * 8) * 2);
#pragma nounroll
        for (int i = 0; i < NCH; ++i) {
            if (i + 2 < NCH) asm volatile("s_waitcnt vmcnt(8)" ::: "memory"); else if (i + 1 < NCH) asm volatile("s_waitcnt vmcnt(4)" ::: "memory"); else asm volatile("s_waitcnt vmcnt(0)" ::: "memory");
            __builtin_amdgcn_s_barrier(); asm volatile("" ::: "memory");
            if (i + 3 < NCH) CS_ISSUE(i + 3);
            const LAS unsigned char* sl = lds + (i & 3) * SLOT;
            pg8::bf16x8 a[4], b[4];
#pragma unroll
            for (int s = 0; s < 4; ++s) { a[s] = *(const LAS pg8::bf16x8*)(sl + (aoff ^ (s << 5))); b[s] = *(const LAS pg8::bf16x8*)(sl + (boff ^ (s << 5))); }
#pragma unroll
            for (int s = 0; s < 4; ++s) acc = __builtin_amdgcn_mfma_f32_32x32x16_bf16(a[s], b[s], acc, 0, 0, 0);
        }
#undef CS_ISSUE
        __syncthreads();
        if (wk == 1) {
#pragma unroll
            for (int q = 0; q < 16; ++q) red[((wm * 2 + wn) * 16 + q) * 64 + lane] = acc[q]; }
        __syncthreads();
        if (wk == 0) {
            const int col = cb * 64 + wn * 32 + r32; const float gt = gate[col], gn = gnext ? gnext[col] : 0.f;
#pragma unroll
            for (int q = 0; q < 16; ++q) { const int rloc = wm * 32 + (q & 3) + 8 * (q >> 2) + 4 * hi, row = rb * 64 + rloc;
                const float x = X[(size_t)row * D + col] + gt * (acc[q] + red[((wm * 2 + wn) * 16 + q) * 64 + lane]);
                if (live) X[(size_t)row * D + col] = x;
                if (gnext && live) AN[(size_t)row * D + col] = (bf16_t)f2bf(x * gn);
                float s = x * x;
#pragma unroll
                for (int m = 1; m < 32; m <<= 1) s += __shfl_xor(s, m);
                if (r32 == 0) rsum[wn * 64 + rloc] = s; } }
        __syncthreads();
        if (wave == 0 && live) ssqc[(size_t)cb * MC + rb * 64 + lane] = rsum[lane] + rsum[64 + lane];
    }
    __syncthreads();
}

__device__ __forceinline__ void final_norm(int G, const int wave_s) {
    FRESH_IDS; FRESH_KP;
    unsigned char* ws = Pp->ws; const int gw = blockIdx.x * NWAVES + wave, NGW = G * NWAVES;
    const float* X = (const float*)(ws + WS_X); const float* SSQ = (const float*)(ws + WS_SSQ); const float* g = Pp->in[25];
    for (int row = gw; row < ML; row += NGW) {
        const float s = wave_sum(lane < 32 ? SSQ[((size_t)(lane >> 2) * MT + row) * 4 + (lane & 3)] : 0.f);
        const float r = 1.0f / sqrtf(s * (1.0f / D) + EPS);
#pragma unroll
        for (int j = 0; j < 8; ++j) { const int c = lane * 4 + 256 * j; const f32x4 x = *(const f32x4*)(X + (size_t)row * D + c), gg = *(const f32x4*)(g + c);
            *(f32x4*)(Pp->out + (size_t)row * D + c) = x * r * gg; }
    }
}

#ifndef MK_REP
#define MK_REP -1
#endif
#define REP(k) _Pragma("unroll") for (int rep_ = 0; rep_ < (MK_REP == (k) ? 2 : 1); ++rep_)
constexpr int NPHASE = 3 + 6 * DEPTH + 1;
__global__ void __launch_bounds__(NTHR, 2) mk_fwd(Params P) {
    extern __shared__ __attribute__((aligned(16))) unsigned char lds_raw[];
    LAS unsigned char* lds = (LAS unsigned char*)lds_raw;
    const int tid = threadIdx.x, G = gridDim.x, wave_s = __builtin_amdgcn_readfirstlane(tid >> 6);
    unsigned char* ws; int lo, hi; { FRESH_KP; ws = Pp->ws; lo = Pp->ph_lo; hi = Pp->ph_hi; }
    volatile LAS unsigned* MISC = (volatile LAS unsigned*)(lds + MISC_OFF);
    for (int u = tid; u < (LDS_BYTES - RING_BYTES) / 4; u += NTHR) ((LAS unsigned*)(lds + RING_BYTES))[u] = 0u;
    __syncthreads();
    XcdBarrier bar = xcd_barrier_post((unsigned*)(ws + WS_CTL) + CW_BAR, MISC + 8);
#define IN(k) (lo <= (k) && (k) < hi)
#define SEAM(k) do { if (IN(k) && IN((k) + 1)) xcd_barrier(bar, wave_s); } while (0)

    if (IN(0)) { REP(100) p0a(lds, G, wave_s); } SEAM(0);
    if (IN(1)) { p0b(G, wave_s); } SEAM(1);
    if (IN(2)) { REP(102) p0c(lds, G, wave_s); } SEAM(2);

    for (int layer = 0; layer < DEPTH; ++layer) {
        const int pb = 3 + 6 * layer;
#define WSL FRESH_KP; unsigned char* w = Pp->ws; const float* MODL = (const float*)(w + WS_MOD) + (size_t)layer * 3 * 6 * D; (void)MODL
        if (IN(pb)) REP(1) {
            WSL;
            pg8::Gemm g{(const bf16_t*)(w + WS_AN), (const bf16_t*)(w + WS_WIN) + (size_t)layer * INW * D, MT, INW, D, D, D};
            pg8::StaticOrder S; S.init(MT, INW, G, (int)blockIdx.x);
            EpiIn E{(const float*)(w + WS_SSQ), (const float*)(w + WS_SSQC), (const float*)(w + WS_SHWIN) + (size_t)layer * 3 * INW, (bf16_t*)(w + WS_PHY), (bf16_t*)(w + WS_Q), (bf16_t*)(w + WS_K), (bf16_t*)(w + WS_V), (const float*)(w + WS_ROPE)};
            pg8::gemm_phase<EpiIn, pg8::StaticOrder, true, true>(lds, g, S, E, wave_s);
        }
        SEAM(pb);
        if (IN(pb + 1)) REP(2) {
            hyena_fft(lds, layer, G, wave_s);
            if (layer != DEPTH - 1) hyena_direct<CTX>(lds, layer, G, ML, wave_s);
        }
        SEAM(pb + 1);
        if (IN(pb + 2)) REP(3) {
            attn_mfma(lds, layer, G, wave_s);
        }
        SEAM(pb + 2);
        if (IN(pb + 3)) {
            WSL;
            pg8::Gemm g{(const bf16_t*)(w + WS_YM), (const bf16_t*)(w + WS_WOUT) + (size_t)layer * D * D, ML, D, D, D, D};
            pg8::StaticOrder S; S.init(ML, D, G, (int)blockIdx.x);
            EpiResid E{(float*)(w + WS_X), MODL + 2 * D, (const float*)(w + WS_GMV) + ((size_t)layer * 2 + 1) * 3 * D, (bf16_t*)(w + WS_AN), (float*)(w + WS_SSQ), 1};
            if (MK_REP == 4) { EpiResid Ed = E; Ed.live = lo > 1000; pg8::gemm_phase<EpiResid, pg8::StaticOrder, true, true>(lds, g, S, Ed, wave_s); }
            pg8::gemm_phase<EpiResid, pg8::StaticOrder, true, true>(lds, g, S, E, wave_s);
            if (layer != DEPTH - 1)
                ctx_small_gemm<D>(lds, (const bf16_t*)(w + WS_YM) + (size_t)ML * D, D, (const bf16_t*)(w + WS_WOUT) + (size_t)layer * D * D, D, (float*)(w + WS_X) + (size_t)ML * D,
                                  MODL + 2 * D + 2 * 6 * D, (const float*)(w + WS_GMV) + ((size_t)layer * 2 + 1) * 3 * D + 2 * D, (bf16_t*)(w + WS_AN) + (size_t)ML * D, (float*)(w + WS_SSQC), G, wave_s);
        }
        SEAM(pb + 3);
        if (IN(pb + 4)) REP(5) {
            WSL;
            const int mrows = layer == DEPTH - 1 ? ML : MT;
            pg8::Gemm g{(const bf16_t*)(w + WS_AN), (const bf16_t*)(w + WS_WGU) + (size_t)layer * GU * D, mrows, GU, D, D, D};
            pg8::StaticOrder S; S.init(mrows, GU, G, (int)blockIdx.x);
            EpiGU E{(const float*)(w + WS_SSQ), (const float*)(w + WS_SSQC), (const float*)(w + WS_SHWGU) + (size_t)layer * 3 * GU, (bf16_t*)(w + WS_HB)};
            pg8::gemm_phase<EpiGU, pg8::StaticOrder, true, true>(lds, g, S, E, wave_s);
        }
        SEAM(pb + 4);
        if (IN(pb + 5)) {
            WSL;
            pg8::Gemm g{(const bf16_t*)(w + WS_HB), (const bf16_t*)(w + WS_WD) + (size_t)layer * D * FF, ML, D, FF, FF, FF};
            pg8::StaticOrder S; S.init(ML, D, G, (int)blockIdx.x);
            EpiResid E{(float*)(w + WS_X), MODL + 5 * D, layer + 1 < DEPTH ? (const float*)(w + WS_GMV) + ((size_t)(layer + 1) * 2 + 0) * 3 * D : nullptr, (bf16_t*)(w + WS_AN), (float*)(w + WS_SSQ), 1};
            if (MK_REP == 6) { EpiResid Ed = E; Ed.live = lo > 1000; pg8::gemm_phase<EpiResid, pg8::StaticOrder, true, true>(lds, g, S, Ed, wave_s); }
            pg8::gemm_phase<EpiResid, pg8::StaticOrder, true, true>(lds, g, S, E, wave_s);
            if (layer != DEPTH - 1)
                ctx_small_gemm<FF>(lds, (const bf16_t*)(w + WS_HB) + (size_t)ML * FF, FF, (const bf16_t*)(w + WS_WD) + (size_t)layer * D * FF, FF, (float*)(w + WS_X) + (size_t)ML * D,
                                   MODL + 5 * D + 2 * 6 * D, (const float*)(w + WS_GMV) + ((size_t)(layer + 1) * 2 + 0) * 3 * D + 2 * D, (bf16_t*)(w + WS_AN) + (size_t)ML * D, (float*)(w + WS_SSQC), G, wave_s);
            if (MK_REP == 7 && layer != DEPTH - 1)
                ctx_small_gemm<FF>(lds, (const bf16_t*)(w + WS_HB) + (size_t)ML * FF, FF, (const bf16_t*)(w + WS_WD) + (size_t)layer * D * FF, FF, (float*)(w + WS_X) + (size_t)ML * D,
                                   MODL + 5 * D + 2 * 6 * D, (const float*)(w + WS_GMV) + ((size_t)(layer + 1) * 2 + 0) * 3 * D + 2 * D, (bf16_t*)(w + WS_AN) + (size_t)ML * D, (float*)(w + WS_SSQC), G, wave_s, lo > 1000);
        }
        SEAM(pb + 5);
    }
    if (IN(NPHASE - 1)) final_norm(G, wave_s);
#undef IN
#undef SEAM
}
}

#ifndef MK_N_LAUNCHES
#define MK_N_LAUNCHES 1
#endif
extern "C" void kernel_launch(void* const* d_in, const int* in_sizes, int n_in, void* d_out, int out_size, void* d_ws, size_t ws_size, hipStream_t stream) {
    using namespace mk;
    static int grid = 0;
    if (grid == 0) {
        if (n_in != 26 || ws_size < WS_END) { fprintf(stderr, "kernel_launch: need 26 inputs and %zu bytes of workspace (got %d, %zu)\n", (size_t)WS_END, n_in, ws_size); grid = -1; return; }
        int dev = 0, cus = 0, per_cu = 0;
        if (hipGetDevice(&dev) != hipSuccess || hipDeviceGetAttribute(&cus, hipDeviceAttributeMultiprocessorCount, dev) != hipSuccess) { grid = -1; return; }
        if (hipFuncSetAttribute((const void*)mk_fwd, hipFuncAttributeMaxDynamicSharedMemorySize, LDS_BYTES) != hipSuccess) { fprintf(stderr, "kernel_launch: hipFuncSetAttribute failed\n"); grid = -1; return; }
        if (hipOccupancyMaxActiveBlocksPerMultiprocessor(&per_cu, (const void*)mk_fwd, NTHR, LDS_BYTES) != hipSuccess || per_cu < 1) { fprintf(stderr, "kernel_launch: occupancy query says %d\n", per_cu); }
        (void)hipGetLastError();
        grid = cus;
    }
    if (grid < 0) return;
    (void)hipMemsetAsync((char*)d_ws + WS_CTL, 0, CTL_BYTES, stream);
    Params p{};
    for (int i = 0; i < 26; ++i) p.in[i] = (const float*)d_in[i];
    p.out = (float*)d_out; p.ws = (unsigned char*)d_ws;
#if MK_N_LAUNCHES == 1
    p.ph_lo = 0; p.ph_hi = NPHASE;
    hipLaunchKernelGGL(mk_fwd, dim3(grid), dim3(NTHR), LDS_BYTES, stream, p);
#else
    for (int ph = 0; ph < NPHASE; ++ph) { p.ph_lo = ph; p.ph_hi = ph + 1; hipLaunchKernelGGL(mk_fwd, dim3(grid), dim3(NTHR), LDS_BYTES, stream, p); }
#endif
}
```

```cpp
#include <hip/hip_runtime.h>
#include <cstdint>
#include <cstdio>
#define LAS __attribute__((address_space(3)))
#define GAS __attribute__((address_space(1)))
#define MK_LANE_ASM(l) asm volatile("v_mbcnt_lo_u32_b32 %0, -1, 0\n\tv_mbcnt_hi_u32_b32 %0, -1, %0" : "=v"(l))
namespace pg8 {
#define PG8_LAS __attribute__((address_space(3)))
typedef unsigned short bf16_t;
typedef short bf16x8 __attribute__((ext_vector_type(8)));
typedef float f32x4 __attribute__((ext_vector_type(4)));
typedef unsigned u32x4 __attribute__((ext_vector_type(4)));
constexpr int BM = 256, BK = 64, HALF = 128, HTB = HALF * BK * 2  , STAGE_BYTES = 8 * HTB, NXCD = 8, WGM = 8;

__host__ __device__ __forceinline__ int lds_byte(int r, int c) { const int st = (r >> 4) * 2 + (c >> 5), rr = r & 15, cc = c & 31, ob = rr * 64 + cc * 2; return st * 1024 + (ob ^ (((ob >> 9) & 1) << 5)); }
__host__ __device__ __forceinline__ void stage_rc(int b, int& R, int& C) { const int st = b / 1024, sb = b % 1024, swz = sb ^ (((sb >> 9) & 1) << 5); R = (st >> 1) * 16 + swz / 64; C = (st & 1) * 32 + (swz % 64) / 2; }
__host__ __device__ __forceinline__ int perm32(int rho) { const int n = rho >> 4, i = rho & 15; return 8 * (i >> 2) + 4 * n + (i & 3); }

struct Unit { int pm, pn; };
struct Gemm { const bf16_t* A; const bf16_t* Bt; int M, N, K, lda, ldb; };

struct StaticOrder {
    int nM, nN, nwg, G, c;
    __host__ __device__ void init(int M, int N, int G_, int c_) { nM = M / BM; nN = N / BM; nwg = nM * nN; G = G_; c = c_; }
    __host__ __device__ bool next(int i, Unit& u) const {
        const long L = (long)i * G + c; if (L >= nwg) return false;
        int wgid = (int)L; { const int q = nwg / NXCD, r = nwg % NXCD, xcd = wgid % NXCD, off = wgid / NXCD; wgid = (xcd < r ? xcd * (q + 1) : r * (q + 1) + (xcd - r) * q) + off; }
        const int nig = WGM * nN, gid = wgid / nig, fm = gid * WGM, gsz = (nM - fm) < WGM ? (nM - fm) : WGM;
        u.pm = fm + ((wgid % nig) % gsz); u.pn = (wgid % nig) / gsz; return true;
    }
    __device__ __forceinline__ void a_ready(const Unit&) const {}
    __device__ __forceinline__ void done(const Unit&) const {}
};

template <class Epi, class Sched, bool ALIGN_EPI = false, bool SP2 = false>
__device__ __forceinline__ void gemm_phase(PG8_LAS unsigned char* lds, const Gemm g, const Sched& S, const Epi& E, const int wave_s) {
    int lane_; MK_LANE_ASM(lane_); int wv_ = wave_s; asm volatile("" : "+s"(wv_)); const int wid = wv_, lane = lane_, tid = wid * 64 + lane, wr = wid >> 2, wc = wid & 3, fr = lane & 15, fq = lane >> 4;
    const int K = g.K, nt = K / BK;
    unsigned voffA[2], voffB[2];
#pragma unroll
    for (int i = 0; i < 2; ++i) { int R, C; stage_rc(tid * 16 + i * 8192, R, C); const int Rb = Epi::PERM ? ((R & ~31) + perm32(R & 31)) : R;
        voffA[i] = (unsigned)(R * g.lda + C) * 2u; voffB[i] = (unsigned)(Rb * g.ldb + C) * 2u; }
    const size_t kstep = (size_t)(BK * 2);
    const size_t hstepA = (size_t)HALF * g.lda * 2, hstepB = (size_t)HALF * g.ldb * 2;
    const size_t tstepA = 2 * hstepA, tstepB = 2 * hstepB;
    const unsigned ldsw = (unsigned)wid * 1024u;
    const int aoff = lds_byte(wr * 64 + fr, fq * 8), boff = lds_byte(wc * 32 + fr, fq * 8);
#define PG8_SA(b, h) (((b) * 2 + (h)) * HTB)
#define PG8_SB(b, h) ((4 + (b) * 2 + (h)) * HTB)
#define PG8_STAGE(bufoff, gbase, voff) do { _Pragma("unroll") for (int _i = 0; _i < 2; ++_i) \
        __builtin_amdgcn_global_load_lds((const unsigned*)((const char*)(gbase) + (voff)[_i]), (PG8_LAS unsigned*)(lds + (bufoff) + ldsw + _i * 8192), 16, 0, 0); } while (0)
#define PG8_LDA(dst, b, h) do { _Pragma("unroll") for (int m = 0; m < 4; ++m) _Pragma("unroll") for (int k = 0; k < 2; ++k) dst[m][k] = *(const PG8_LAS bf16x8*)(lds + PG8_SA(b, h) + aoff + m * 2048 + k * 1024); } while (0)
#define PG8_LDB(dst, b, h) do { _Pragma("unroll") for (int n = 0; n < 2; ++n) _Pragma("unroll") for (int k = 0; k < 2; ++k) dst[n][k] = *(const PG8_LAS bf16x8*)(lds + PG8_SB(b, h) + boff + n * 2048 + k * 1024); } while (0)
#define PG8_MMA(ai, bj, At, Bt) do { __builtin_amdgcn_s_setprio(1); _Pragma("unroll") for (int m = 0; m < 4; ++m) _Pragma("unroll") for (int n = 0; n < 2; ++n) _Pragma("unroll") for (int k = 0; k < 2; ++k) \
        acc[ai][bj][m][n] = __builtin_amdgcn_mfma_f32_16x16x32_bf16(Bt[n][k], At[m][k], acc[ai][bj][m][n], 0, 0, 0); __builtin_amdgcn_s_setprio(0); } while (0)
#define PG8_WAIT_V(n) asm volatile("s_waitcnt vmcnt(" #n ")" ::: "memory")
#define PG8_WAIT_L(n) asm volatile("s_waitcnt lgkmcnt(" #n ")" ::: "memory")
#define PG8_BAR __builtin_amdgcn_s_barrier()
#define PG8_SCHED __builtin_amdgcn_sched_barrier(0)
    Unit cur, nxt; int ui = 0;
    (void)S.next(0, cur);
    f32x4 acc[2][2][4][2];
#pragma unroll
    for (int a = 0; a < 2; ++a)
#pragma unroll
        for (int b = 0; b < 2; ++b)
#pragma unroll
            for (int m = 0; m < 4; ++m)
#pragma unroll
                for (int n = 0; n < 2; ++n) acc[a][b][m][n] = (f32x4){0.f, 0.f, 0.f, 0.f};
    bf16x8 At[4][2], B0[2][2], B1[2][2];
    const char* cA = (const char*)g.A + (size_t)cur.pm * tstepA; const char* cB = (const char*)g.Bt + (size_t)cur.pn * tstepB;
    S.a_ready(cur);
    if constexpr (SP2) {
        PG8_STAGE(PG8_SB(0, 0), cB, voffB); PG8_STAGE(PG8_SB(0, 1), cB + hstepB, voffB); PG8_STAGE(PG8_SA(0, 0), cA, voffA); PG8_STAGE(PG8_SA(0, 1), cA + hstepA, voffA);
        if (wr == 1) PG8_BAR;
        PG8_WAIT_V(2); PG8_BAR;
        PG8_STAGE(PG8_SB(1, 0), cB + kstep, voffB); PG8_STAGE(PG8_SA(1, 0), cA + kstep, voffA); PG8_STAGE(PG8_SB(1, 1), cB + hstepB + kstep, voffB);
        PG8_WAIT_V(6); PG8_BAR;
    } else {
        PG8_STAGE(PG8_SB(0, 0), cB, voffB); PG8_STAGE(PG8_SA(0, 0), cA, voffA); PG8_STAGE(PG8_SB(0, 1), cB + hstepB, voffB); PG8_STAGE(PG8_SA(0, 1), cA + hstepA, voffA);
        if (wr == 1) PG8_BAR;
        PG8_WAIT_V(4); PG8_BAR;
        PG8_STAGE(PG8_SB(1, 0), cB + kstep, voffB); PG8_STAGE(PG8_SA(1, 0), cA + kstep, voffA); PG8_STAGE(PG8_SB(1, 1), cB + hstepB + kstep, voffB);
        PG8_WAIT_V(6); PG8_BAR;
    }
    for (;;) {
        const bool has_next = S.next(ui + 1, nxt);
        const char* nA = has_next ? (const char*)g.A + (size_t)nxt.pm * tstepA : cA; const char* nB = has_next ? (const char*)g.Bt + (size_t)nxt.pn * tstepB : cB;
        for (int t = 0; t < nt; t += 2) {
            const bool last = (t == nt - 2);
            const char* a1 = cA + (size_t)(t + 1) * kstep;
            const char* a2 = last ? nA : cA + (size_t)(t + 2) * kstep; const char* b2 = last ? nB : cB + (size_t)(t + 2) * kstep;
            const char* a3 = a2 + kstep; const char* b3 = b2 + kstep;
            if (last && has_next) S.a_ready(nxt);
            if constexpr (SP2) {
            PG8_LDB(B0, 0, 0); PG8_LDB(B1, 0, 1); PG8_SCHED; PG8_LDA(At, 0, 0); PG8_STAGE(PG8_SA(1, 1), a1 + hstepA, voffA);
            PG8_WAIT_V(8); PG8_WAIT_L(0); PG8_BAR; PG8_MMA(0, 0, At, B0); PG8_MMA(0, 1, At, B1); PG8_BAR; PG8_SCHED;
            PG8_LDA(At, 0, 1); PG8_STAGE(PG8_SB(0, 0), b2, voffB); PG8_STAGE(PG8_SB(0, 1), b2 + hstepB, voffB); PG8_STAGE(PG8_SA(0, 0), a2, voffA);
            PG8_WAIT_V(8); PG8_WAIT_L(0); PG8_BAR; PG8_MMA(1, 0, At, B0); PG8_MMA(1, 1, At, B1); PG8_BAR; PG8_SCHED;
            PG8_LDB(B0, 1, 0); PG8_LDB(B1, 1, 1); PG8_SCHED; PG8_LDA(At, 1, 0); PG8_STAGE(PG8_SA(0, 1), a2 + hstepA, voffA);
            PG8_WAIT_V(8); PG8_WAIT_L(0); PG8_BAR; PG8_MMA(0, 0, At, B0); PG8_MMA(0, 1, At, B1); PG8_BAR; PG8_SCHED;
            PG8_LDA(At, 1, 1); PG8_STAGE(PG8_SB(1, 0), b3, voffB); PG8_STAGE(PG8_SB(1, 1), b3 + hstepB, voffB); PG8_STAGE(PG8_SA(1, 0), a3, voffA);
            PG8_WAIT_V(8); PG8_WAIT_L(0); PG8_BAR; PG8_MMA(1, 0, At, B0); PG8_MMA(1, 1, At, B1); PG8_BAR; PG8_SCHED;
            } else {
            PG8_LDB(B0, 0, 0); PG8_SCHED; PG8_LDA(At, 0, 0); PG8_STAGE(PG8_SA(1, 1), a1 + hstepA, voffA);
            PG8_WAIT_L(8); PG8_BAR; PG8_WAIT_L(0); PG8_MMA(0, 0, At, B0); PG8_BAR; PG8_SCHED;
            PG8_LDB(B1, 0, 1); PG8_STAGE(PG8_SB(0, 0), b2, voffB);
            PG8_BAR; PG8_WAIT_L(0); PG8_MMA(0, 1, At, B1); PG8_BAR;
            PG8_LDA(At, 0, 1); PG8_STAGE(PG8_SA(0, 0), a2, voffA);
            PG8_BAR; PG8_WAIT_L(0); PG8_MMA(1, 0, At, B0); PG8_BAR; PG8_SCHED;
            PG8_STAGE(PG8_SB(0, 1), b2 + hstepB, voffB);
            PG8_WAIT_V(6); PG8_BAR; PG8_MMA(1, 1, At, B1); PG8_BAR;
            PG8_LDB(B0, 1, 0); PG8_SCHED; PG8_LDA(At, 1, 0); PG8_STAGE(PG8_SA(0, 1), a2 + hstepA, voffA);
            PG8_WAIT_L(8); PG8_BAR; PG8_WAIT_L(0); PG8_MMA(0, 0, At, B0); PG8_BAR; PG8_SCHED;
            PG8_LDB(B1, 1, 1); PG8_STAGE(PG8_SB(1, 0), b3, voffB);
            PG8_BAR; PG8_WAIT_L(0); PG8_MMA(0, 1, At, B1); PG8_BAR;
            PG8_LDA(At, 1, 1); PG8_STAGE(PG8_SA(1, 0), a3, voffA);
            PG8_BAR; PG8_WAIT_L(0); PG8_MMA(1, 0, At, B0); PG8_BAR; PG8_SCHED;
            PG8_STAGE(PG8_SB(1, 1), b3 + hstepB, voffB);
            PG8_WAIT_V(6); PG8_BAR; PG8_MMA(1, 1, At, B1); PG8_BAR;
            }
        }
        if constexpr (ALIGN_EPI) { if (wr == 0) PG8_BAR; }
        if constexpr (!Epi::AFTER_DRAIN) { E(acc, cur, wr, wc, fr, fq); S.done(cur); }
        if (!has_next) break;
#pragma unroll
        for (int a = 0; a < 2; ++a)
#pragma unroll
            for (int b = 0; b < 2; ++b)
#pragma unroll
                for (int m = 0; m < 4; ++m)
#pragma unroll
                    for (int n = 0; n < 2; ++n) acc[a][b][m][n] = (f32x4){0.f, 0.f, 0.f, 0.f};
        cur = nxt; cA = nA; cB = nB; ++ui;
        if constexpr (ALIGN_EPI) { if (wr == 1) PG8_BAR; }
    }
    PG8_WAIT_V(0);
    if constexpr (!ALIGN_EPI) { if (wr == 0) PG8_BAR; }
    PG8_BAR;
    if constexpr (Epi::AFTER_DRAIN) { E.fused(acc, cur, wr, wc, fr, fq, lds, wid, lane); S.done(cur); }
#undef PG8_SA
#undef PG8_SB
#undef PG8_STAGE
#undef PG8_LDA
#undef PG8_LDB
#undef PG8_MMA
#undef PG8_WAIT_V
#undef PG8_WAIT_L
#undef PG8_BAR
#undef PG8_SCHED
}
}

#define XB_TMO      128
#define XB_XCNT(j)  (256  + 64 * (j))
#define XB_XSUB(j)  (1280 + 64 * (j))
#define XB_XGEN(j)  (2304 + 64 * (j))
#define XB_TOP      3328
#define XB_TOPGEN   3392
#define XCD_BAR_WORDS 3456
#define XB_SPIN_CAP (1u << 18)

__device__ __forceinline__ unsigned xb_ld(unsigned* p)              { return __hip_atomic_load(p, __ATOMIC_RELAXED, __HIP_MEMORY_SCOPE_AGENT); }
__device__ __forceinline__ unsigned xb_add(unsigned* p, unsigned v) { return __hip_atomic_fetch_add(p, v, __ATOMIC_RELAXED, __HIP_MEMORY_SCOPE_AGENT); }
__device__ __forceinline__ unsigned xb_xcc_id() { return (unsigned)__builtin_amdgcn_s_getreg((3 << 11) | 20) & 0xFu; }
#define XB_SPIN(cond, bar) do { unsigned _sp = 0; while (cond) { __builtin_amdgcn_s_sleep(1); \
    if ((++_sp & 255u) == 0u) { if (xb_ld(&(bar)[XB_TMO])) break; if (_sp > XB_SPIN_CAP) { atomicAdd(&(bar)[XB_TMO], 1u); break; } } } } while (0)

struct XcdBarrier {
    unsigned* bar; unsigned x;
    volatile LAS unsigned* st;
};

__device__ __forceinline__ XcdBarrier xcd_barrier_post(unsigned* bar, volatile LAS unsigned* st) {
    XcdBarrier b; b.bar = bar; b.x = xb_xcc_id(); b.st = st;
    if (threadIdx.x == 0) (void)xb_add(&bar[XB_XCNT(b.x)], 1u);
    return b;
}
__device__ __forceinline__ void xcd_barrier_complete(unsigned* bar, unsigned x, unsigned& nloc, unsigned& nx) {
    const unsigned G = gridDim.x * gridDim.y * gridDim.z;
    unsigned sum, cnt, mine, sp = 0u;
    for (;;) {
        sum = 0u; cnt = 0u; mine = 0u;
#pragma unroll
        for (unsigned j = 0; j < 16; ++j) { const unsigned c = xb_ld(&bar[XB_XCNT(j)]); sum += c; cnt += (c > 0u) ? 1u : 0u; mine = (j == x) ? c : mine; }
        if (sum == G) break;
        __builtin_amdgcn_s_sleep(1);
        if ((++sp & 255u) == 0u) { if (xb_ld(&bar[XB_TMO])) break; if (sp > XB_SPIN_CAP) { atomicAdd(&bar[XB_TMO], 1u); break; } }
    }
    nloc = mine > 0u ? mine : 1u; nx = cnt > 0u ? cnt : 1u;
}

__device__ __forceinline__ void xcd_barrier(const XcdBarrier& b, const int wave_s) {
    int xb_lane_; MK_LANE_ASM(xb_lane_); const bool xb_t0 = (wave_s == 0) && (xb_lane_ == 0);
    asm volatile("s_waitcnt vmcnt(0)" ::: "memory");
    __syncthreads();
    if (xb_t0) {
        unsigned* bar = b.bar;
        __builtin_amdgcn_s_waitcnt(0);
        unsigned nloc = b.st[0], nx = b.st[1];
        if (nloc == 0u) { xcd_barrier_complete(bar, b.x, nloc, nx); b.st[0] = nloc; b.st[1] = nx; }
        const unsigned old = xb_add(&bar[XB_XSUB(b.x)], 1u);
        const unsigned gen = old / nloc;
        if (old + 1u == (gen + 1u) * nloc) {
            __builtin_amdgcn_fence(__ATOMIC_RELEASE, "agent");
            asm volatile("s_waitcnt vmcnt(0)" ::: "memory");
            const unsigned og = xb_add(&bar[XB_TOP], 1u);
            const unsigned tg = og / nx;
            if (og + 1u == (tg + 1u) * nx) xb_add(&bar[XB_TOPGEN], 1u);
            else XB_SPIN(xb_ld(&bar[XB_TOPGEN]) == tg, bar);
            __builtin_amdgcn_fence(__ATOMIC_ACQUIRE, "agent");
            xb_add(&bar[XB_XGEN(b.x)], 1u);
            asm volatile("s_waitcnt vmcnt(0)" ::: "memory");
        } else {
            XB_SPIN(xb_ld(&bar[XB_XGEN(b.x)]) == gen, bar);
            __builtin_amdgcn_fence(__ATOMIC_ACQUIRE, "agent");
            asm volatile("s_waitcnt vmcnt(0)" ::: "memory");
        }
    }
    __syncthreads();
}


namespace mk {
using pg8::bf16_t; using pg8::f32x4; using pg8::Unit; using pg8::BM; using pg8::HALF;
typedef unsigned u32x4 __attribute__((ext_vector_type(4)));
typedef unsigned u32x2 __attribute__((ext_vector_type(2)));
typedef float f32x2 __attribute__((ext_vector_type(2)));

constexpr int D = 2048, BATCH = 2, SEQ = 4096, DEPTH = 4, CTX = 256;
constexpr int HY = 1024, NH = 8, NKV = 2, HD = 128, ATTW = 1024, KVW = 256;
constexpr int INW = 4608, FF = 5632, GU = 2 * FF, FH = 64, FE = 33;
constexpr int ML = BATCH * SEQ, MC = BATCH * CTX, MT = ML + MC;
constexpr float EPS = 1e-6f;
constexpr float LOG2E = 1.4426950408889634f;
constexpr float QSCALE = 0.08838834764831845f * LOG2E;
constexpr int WINDOW = 128;
constexpr int NWAVES = 8, NTHR = 512;
constexpr int MOD_KC = 8;

constexpr size_t al(size_t x) { return (x + 255) & ~(size_t)255; }
constexpr size_t WS_CTL = 0, CTL_BYTES = 1u << 20;
constexpr size_t WS_X = CTL_BYTES;
constexpr size_t WS_AN = WS_X + al((size_t)MT * D * 4);
constexpr size_t WS_SSQ = WS_AN + al((size_t)MT * D * 2);
constexpr size_t WS_SSQC = WS_SSQ + al((size_t)MT * 32 * 4);
constexpr size_t WS_PHY = WS_SSQC + al((size_t)32 * MC * 4);
constexpr size_t WS_Q = WS_PHY + al((size_t)3 * HY * MT * 2);
constexpr size_t WS_K = WS_Q + al((size_t)MT * ATTW * 2);
constexpr size_t WS_V = WS_K + al((size_t)MT * KVW * 2);
constexpr size_t WS_YM = WS_V + al((size_t)MT * KVW * 2);
constexpr size_t WS_SSHY = WS_YM + al((size_t)MT * D * 2);
constexpr size_t WS_HB = WS_SSHY + al((size_t)HY * MT * 4);
constexpr size_t WS_MODP = WS_HB + al((size_t)MT * FF * 2);
constexpr size_t WS_MOD = WS_MODP + al((size_t)MOD_KC * DEPTH * 3 * 6 * D * 4);
constexpr size_t WS_MODB = WS_MOD + al((size_t)DEPTH * 3 * 6 * D * 4);
constexpr size_t WS_GMV = WS_MODB + al((size_t)DEPTH * 3 * 6 * D * 2);
constexpr size_t WS_SHWIN = WS_GMV + al((size_t)DEPTH * 2 * 3 * D * 4);
constexpr size_t WS_SHWGU = WS_SHWIN + al((size_t)DEPTH * 3 * INW * 4);
constexpr size_t WS_HIDL = WS_SHWGU + al((size_t)DEPTH * 3 * GU * 4);
constexpr size_t WS_W3T = WS_HIDL + al((size_t)DEPTH * SEQ * FH * 2);
constexpr size_t WS_HIDC = WS_HIDL + al((size_t)DEPTH * SEQ * FH * 4);
constexpr size_t WS_ROPE = WS_HIDC + al((size_t)DEPTH * CTX * FH * 4);
constexpr size_t WS_FLT = WS_ROPE + al((size_t)64 * 32 * 2 * 4);
constexpr size_t WS_FLTC = WS_FLT + al((size_t)DEPTH * 4 * HY * SEQ * 4);
constexpr size_t WS_WIN = WS_FLTC + al((size_t)DEPTH * 4 * HY * CTX * 4);
constexpr size_t WS_WOUT = WS_WIN + al((size_t)DEPTH * INW * D * 2);
constexpr size_t WS_WGU = WS_WOUT + al((size_t)DEPTH * D * D * 2);
constexpr size_t WS_WD = WS_WGU + al((size_t)DEPTH * GU * D * 2);
constexpr size_t WS_END = WS_WD + al((size_t)DEPTH * D * FF * 2);
constexpr int INW_A = 15 * 256, NQKV = ((INW - INW_A) / 256) * (MT / 256);
constexpr int CW_BAR = 4096;

constexpr int RING_BYTES = 135168  , MISC_OFF = RING_BYTES + 320, LDS_BYTES = RING_BYTES + 8192;

__device__ __forceinline__ unsigned f2bf(float f) { unsigned u = __builtin_bit_cast(unsigned, f); return (u + 0x7fffu + ((u >> 16) & 1u)) >> 16; }
__device__ __forceinline__ unsigned pk2(float lo, float hi) { unsigned r; asm("v_cvt_pk_bf16_f32 %0, %1, %2" : "=v"(r) : "v"(lo), "v"(hi)); return r; }
__device__ __forceinline__ float bf_lo(unsigned w) { return __builtin_bit_cast(float, w << 16); }
__device__ __forceinline__ float bf_hi(unsigned w) { return __builtin_bit_cast(float, w & 0xffff0000u); }
__device__ __forceinline__ float bf1(bf16_t b) { return __builtin_bit_cast(float, (unsigned)b << 16); }
__device__ __forceinline__ float wave_sum(float v) {
#pragma unroll
    for (int o = 1; o < 64; o <<= 1) v += __shfl_xor(v, o);
    return v;
}
__device__ __forceinline__ float wave_max(float v) {
#pragma unroll
    for (int o = 1; o < 64; o <<= 1) v = fmaxf(v, __shfl_xor(v, o));
    return v;
}
__device__ __forceinline__ int vec_of_panel(int pm) { return pm < 16 ? 0 : (pm < 32 ? 1 : 2); }
__device__ __forceinline__ int vec_of_row(int row) { return row < SEQ ? 0 : (row < ML ? 1 : 2); }
__host__ __device__ __forceinline__ int qk_dim(int j) { const int wc = j >> 5, fq = (j >> 3) & 3, n = (j >> 2) & 1, e = j & 3, idx = wc * 16 + fq * 4 + e; return (idx < 32 ? idx : idx + 32) + 32 * n; }

#define FRESH_IDS int lane_; MK_LANE_ASM(lane_); int wv_ = wave_s; asm volatile("" : "+s"(wv_)); const int lane = lane_, wave = wv_, tid = wv_ * 64 + lane_; (void)lane; (void)wave; (void)tid
#ifndef MK_TS
#define MK_TS -1
#endif
#ifndef MK_TSL
#define MK_TSL 1
#endif
#ifndef MK_TSB
#define MK_TSB 0
#endif
#define TS_MARK(word, cond) do { if (MK_TS >= 0 && (cond) && blockIdx.x == MK_TSB && wave_s == 0) { int l_; MK_LANE_ASM(l_); if (l_ == 0) { const unsigned long long t_ = __builtin_amdgcn_s_memrealtime(); MISC[16 + 2 * (word)] = (unsigned)t_; MISC[17 + 2 * (word)] = (unsigned)(t_ >> 32); } } } while (0)
struct Params {
    const float* in[26];
    float* out;
    unsigned char* ws;
    int ph_lo, ph_hi;
};
typedef __attribute__((address_space(4))) const Params* KP;
#define FRESH_KP KP Pp; { unsigned long long ki_ = (unsigned long long)__builtin_amdgcn_kernarg_segment_ptr(); asm volatile("" : "+s"(ki_)); Pp = (KP)ki_; }

__device__ __forceinline__ void load_rstd8(const float* ssq, const float* ssqc, int row0, int fq, float (&rs)[2][4]) {
    const bool isc = row0 >= ML;
#pragma unroll
    for (int ai = 0; ai < 2; ++ai)
#pragma unroll
        for (int m = 0; m < 4; ++m) {
            const int row = row0 + ai * HALF + m * 16;
            float s;
            if (!isc) { const f32x4 a = *(const f32x4*)(ssq + ((size_t)(2 * fq) * MT + row) * 4), b = *(const f32x4*)(ssq + ((size_t)(2 * fq + 1) * MT + row) * 4);
                s = ((a[0] + a[1]) + (a[2] + a[3])) + ((b[0] + b[1]) + (b[2] + b[3])); }
            else { s = 0.f;
#pragma unroll
                for (int j = 0; j < 8; ++j) s += ssqc[(size_t)(fq * 8 + j) * MC + (row - ML)]; }
            s += __shfl_xor(s, 16); s += __shfl_xor(s, 32);
            rs[ai][m] = 1.0f / sqrtf(s * (1.0f / D) + EPS);
        }
}

struct EpiIn {
    static constexpr bool PERM = true, AFTER_DRAIN = false;
    const float* ssq; const float* ssqc; const float* shw;
    bf16_t* PHY; bf16_t* Q; bf16_t* Kb; bf16_t* Vb; const float* rope; int live; int pn_off;
    __device__ __forceinline__ void operator()(const f32x4 (&acc)[2][2][4][2], const Unit& u, int wr, int wc, int fr_, int fq_) const {
        int fr = fr_, fq = fq_; asm volatile("" : "+v"(fr), "+v"(fq));
        const int row0 = u.pm * BM + wr * 64 + fr, v = vec_of_panel(u.pm);
        const int pn = u.pn + pn_off;
        float rs[2][4]; load_rstd8(ssq, ssqc, row0, fq, rs);
        const int cpos = wc * 32 + 8 * fq;
        const int colb = pn * BM + cpos;
        f32x4 sh[2][2];
#pragma unroll
        for (int bj = 0; bj < 2; ++bj)
#pragma unroll
            for (int n = 0; n < 2; ++n) { const int dsrc = (wc < 2 ? 16 * wc + 4 * fq : 16 * wc + 4 * fq + 32) + 32 * n;
                sh[bj][n] = *(const f32x4*)(shw + (size_t)v * INW + (pn >= 12 && pn < 17 ? pn * BM + bj * HALF + dsrc : colb + bj * HALF + 4 * n)); }
        if (pn < 12) {
#pragma unroll
            for (int ai = 0; ai < 2; ++ai)
#pragma unroll
                for (int m = 0; m < 4; ++m) { const int row = row0 + ai * HALF + m * 16; const float r = rs[ai][m];
#pragma unroll
                    for (int bj = 0; bj < 2; ++bj)
#pragma unroll
                        for (int n = 0; n < 2; ++n) { const f32x4 x = acc[ai][bj][m][n] * r + sh[bj][n];
                            u32x2 w; w.x = pk2(x[0], x[1]); w.y = pk2(x[2], x[3]);
                            const int cg = (colb + bj * HALF) / 4 + n;
                            if (live) *(u32x2*)(PHY + ((size_t)cg * MT + row) * 4) = w; } }
        } else if (pn < 17) {
            const bool isq = pn < 16, latent = u.pm < 32;
            const int axis = wc >> 1, p0 = (wc * 16 + fq * 4) & 31;
            const float qs = isq ? QSCALE : 1.0f;
#pragma unroll
            for (int ai = 0; ai < 2; ++ai)
#pragma unroll
                for (int m = 0; m < 4; ++m) { const int row = row0 + ai * HALF + m * 16; const float r = rs[ai][m];
                    const int l = row & (SEQ - 1), pos = axis ? (l & 63) : (l >> 6);
                    f32x4 t0 = (f32x4){1.f, 0.f, 1.f, 0.f}, t1 = t0;
                    if (latent) { const f32x4* tp = (const f32x4*)(rope + ((size_t)pos * 32 + p0) * 2); t0 = tp[0]; t1 = tp[1]; }
                    const float cs[4] = {t0[0], t0[2], t1[0], t1[2]}, sn[4] = {t0[1], t0[3], t1[1], t1[3]};
#pragma unroll
                    for (int bj = 0; bj < 2; ++bj) { const f32x4 a = acc[ai][bj][m][0] * r + sh[bj][0], b = acc[ai][bj][m][1] * r + sh[bj][1];
                        float ra[4], rb[4];
#pragma unroll
                        for (int e = 0; e < 4; ++e) { ra[e] = (a[e] * cs[e] - b[e] * sn[e]) * qs; rb[e] = (a[e] * sn[e] + b[e] * cs[e]) * qs; }
                        u32x4 w; w.x = pk2(ra[0], ra[1]); w.y = pk2(ra[2], ra[3]); w.z = pk2(rb[0], rb[1]); w.w = pk2(rb[2], rb[3]);
                        bf16_t* dst = isq ? Q + (size_t)row * ATTW + (pn - 12) * BM + bj * HALF + cpos : Kb + (size_t)row * KVW + bj * HALF + cpos;
                        if (live) *(u32x4*)dst = w; } }
        } else {
#pragma unroll
            for (int ai = 0; ai < 2; ++ai)
#pragma unroll
                for (int m = 0; m < 4; ++m) { const int row = row0 + ai * HALF + m * 16; const float r = rs[ai][m];
#pragma unroll
                    for (int bj = 0; bj < 2; ++bj) { const f32x4 a = acc[ai][bj][m][0] * r + sh[bj][0], b = acc[ai][bj][m][1] * r + sh[bj][1];
                        u32x4 w; w.x = pk2(a[0], a[1]); w.y = pk2(a[2], a[3]); w.z = pk2(b[0], b[1]); w.w = pk2(b[2], b[3]);
                        if (live) *(u32x4*)(Vb + (size_t)row * KVW + bj * HALF + cpos) = w; } }
        }
    }
};

struct EpiOutA {
    static constexpr bool PERM = true, AFTER_DRAIN = false;
    float* X; const float* gate;
    const float* sshy;
    __device__ __forceinline__ void operator()(const f32x4 (&acc)[2][2][4][2], const Unit& u, int wr, int wc, int fr_, int fq_) const {
        int fr = fr_, fq = fq_; asm volatile("" : "+v"(fr), "+v"(fq));
        const int row0 = u.pm * BM + wr * 64 + fr, v = vec_of_panel(u.pm);
        const int colb = u.pn * BM + wc * 32 + 8 * fq;
        f32x4 gt[2][2];
#pragma unroll
        for (int bj = 0; bj < 2; ++bj)
#pragma unroll
            for (int n = 0; n < 2; ++n) gt[bj][n] = *(const f32x4*)(gate + (size_t)v * 6 * D + colb + bj * HALF + 4 * n);
#pragma unroll
        for (int ai = 0; ai < 2; ++ai)
#pragma unroll
            for (int m = 0; m < 4; ++m) { const int row = row0 + ai * HALF + m * 16;
                const float r = 1.0f / sqrtf(sshy[row] * (1.0f / HY) + EPS);
                float* xr = X + (size_t)row * D + colb;
#pragma unroll
                for (int bj = 0; bj < 2; ++bj)
#pragma unroll
                    for (int n = 0; n < 2; ++n) { f32x4* px = (f32x4*)(xr + bj * HALF + 4 * n); *px = *px + gt[bj][n] * (acc[ai][bj][m][n] * r); } }
    }
};

struct EpiResid {
    static constexpr bool PERM = true, AFTER_DRAIN = false;
    const float* Xin; const bf16_t* Xb; bf16_t* X; const float* gate; const float* gnext  ; bf16_t* AN; float* ssq; int live;
    __device__ __forceinline__ void operator()(const f32x4 (&acc)[2][2][4][2], const Unit& u, int wr, int wc, int fr_, int fq_) const {
        int fr = fr_, fq = fq_; asm volatile("" : "+v"(fr), "+v"(fq));
        const int row0 = u.pm * BM + wr * 64 + fr, v = vec_of_panel(u.pm);
        const int colb = u.pn * BM + wc * 32 + 8 * fq;
        f32x4 gt[2][2], gn[2][2];
#pragma unroll
        for (int bj = 0; bj < 2; ++bj)
#pragma unroll
            for (int n = 0; n < 2; ++n) { gt[bj][n] = *(const f32x4*)(gate + (size_t)v * 6 * D + colb + bj * HALF + 4 * n);
                gn[bj][n] = gnext ? *(const f32x4*)(gnext + (size_t)v * D + colb + bj * HALF + 4 * n) : (f32x4){0.f, 0.f, 0.f, 0.f}; }
#pragma unroll
        for (int ai = 0; ai < 2; ++ai)
#pragma unroll
            for (int m = 0; m < 4; ++m) { const int row = row0 + ai * HALF + m * 16;
                const size_t eo = (size_t)row * D + colb; float s = 0.f;
#pragma unroll
                for (int bj = 0; bj < 2; ++bj) { f32x4 x[2];
                    if (Xin) { x[0] = *(const f32x4*)(Xin + eo + bj * HALF); x[1] = *(const f32x4*)(Xin + eo + bj * HALF + 4); }
                    else { const u32x4 xw = *(const u32x4*)(Xb + eo + bj * HALF); x[0] = (f32x4){bf_lo(xw.x), bf_hi(xw.x), bf_lo(xw.y), bf_hi(xw.y)}; x[1] = (f32x4){bf_lo(xw.z), bf_hi(xw.z), bf_lo(xw.w), bf_hi(xw.w)}; }
#pragma unroll
                    for (int n = 0; n < 2; ++n) { x[n] = x[n] + gt[bj][n] * acc[ai][bj][m][n];
                        s += (x[n][0] * x[n][0] + x[n][1] * x[n][1]) + (x[n][2] * x[n][2] + x[n][3] * x[n][3]); }
                    if (live) { u32x4 xo; xo.x = pk2(x[0][0], x[0][1]); xo.y = pk2(x[0][2], x[0][3]); xo.z = pk2(x[1][0], x[1][1]); xo.w = pk2(x[1][2], x[1][3]); *(u32x4*)(X + eo + bj * HALF) = xo; }
                    if (gnext && live) { const f32x4 a = x[0] * gn[bj][0], b = x[1] * gn[bj][1];
                        u32x4 w; w.x = pk2(a[0], a[1]); w.y = pk2(a[2], a[3]); w.z = pk2(b[0], b[1]); w.w = pk2(b[2], b[3]);
                        *(u32x4*)(AN + (size_t)row * D + colb + bj * HALF) = w; } }
                s += __shfl_xor(s, 16); s += __shfl_xor(s, 32);
                if (fq == 0 && live) ssq[((size_t)u.pn * MT + row) * 4 + wc] = s; }
    }
};

struct EpiGU {
    static constexpr bool PERM = true, AFTER_DRAIN = false;
    const float* ssq; const float* ssqc; const float* shw;
    bf16_t* HB; volatile LAS unsigned* MISC; int wave_s; int tsl;
    __device__ __forceinline__ void operator()(const f32x4 (&acc)[2][2][4][2], const Unit& u, int wr, int wc, int fr_, int fq_) const {
        int fr = fr_, fq = fq_; asm volatile("" : "+v"(fr), "+v"(fq));
        const bool first_ = (MK_TS == 60 || MK_TS == 61) ? (MISC[20] == 0u) : false;
        TS_MARK(1, MK_TS == 61 && tsl && first_); TS_MARK(0, MK_TS == 60 && tsl && first_);
        const int row0 = u.pm * BM + wr * 64 + fr, v = vec_of_panel(u.pm);
        float rs[2][4]; load_rstd8(ssq, ssqc, row0, fq, rs);
        const int colb = u.pn * BM + wc * 32 + 8 * fq;
        f32x4 sh[2][2];
#pragma unroll
        for (int bj = 0; bj < 2; ++bj)
#pragma unroll
            for (int n = 0; n < 2; ++n) sh[bj][n] = *(const f32x4*)(shw + (size_t)v * GU + colb + bj * HALF + 4 * n);
#pragma unroll
        for (int ai = 0; ai < 2; ++ai)
#pragma unroll
            for (int m = 0; m < 4; ++m) { const int row = row0 + ai * HALF + m * 16; const float r = rs[ai][m];
                unsigned hw[4];
#pragma unroll
                for (int n = 0; n < 2; ++n) { const f32x4 g = acc[ai][0][m][n] * r + sh[0][n], up = acc[ai][1][m][n] * r + sh[1][n];
                    float h[4];
#pragma unroll
                    for (int e = 0; e < 4; ++e) h[e] = g[e] * __builtin_amdgcn_rcpf(1.0f + __builtin_amdgcn_exp2f(-g[e] * LOG2E)) * up[e];
                    hw[2 * n] = pk2(h[0], h[1]); hw[2 * n + 1] = pk2(h[2], h[3]); }
                u32x4 w; w.x = hw[0]; w.y = hw[1]; w.z = hw[2]; w.w = hw[3];
                *(u32x4*)(HB + (size_t)row * FF + u.pn * HALF + wc * 32 + 8 * fq) = w; }
        if (MK_TS == 60 || MK_TS == 61) { asm volatile("s_waitcnt vmcnt(0)" ::: "memory"); TS_MARK(1, MK_TS == 60 && tsl && first_); if (tsl && wave_s == 0) MISC[20] = 1u; }
    }
};

template <class RowMap>
__device__ __forceinline__ void transpose_item(const float* W, int K, int N, bf16_t* WT, LAS float* scr, int item, int lane, const RowMap& rm) {
    const int nblk = N / 32, kb = item / nblk, nb = item % nblk, k0 = 64 * kb, n0 = 32 * nb;
    const int lr = lane >> 3, ln = (lane & 7) * 4;
#pragma unroll
    for (int i = 0; i < 8; ++i) { const int kk = 8 * i + lr; const f32x4 v = *(const f32x4*)(W + (size_t)(k0 + kk) * N + n0 + ln); *(LAS f32x4*)(scr + kk * 36 + ln) = v; }
    asm volatile("s_waitcnt lgkmcnt(0)" ::: "memory");
    const int c = lane & 7;
#pragma unroll
    for (int j = 0; j < 4; ++j) { const int n = (lane >> 3) + 8 * j; const LAS float* s = scr + (8 * c) * 36 + n;
        u32x4 o; o.x = pk2(s[0 * 36], s[1 * 36]); o.y = pk2(s[2 * 36], s[3 * 36]); o.z = pk2(s[4 * 36], s[5 * 36]); o.w = pk2(s[6 * 36], s[7 * 36]);
        *(u32x4*)(WT + (size_t)rm(n0 + n) * K + k0 + 8 * c) = o; }
    asm volatile("s_waitcnt lgkmcnt(0)" ::: "memory");
}
struct MapId { __device__ __forceinline__ int operator()(int n) const { return n; } };
struct MapIn { __device__ __forceinline__ int operator()(int n) const {
    if (n < 3 * HY || n >= 3 * HY + ATTW + KVW) return n;
    const int h0 = (n - 3 * HY) & ~127, d = (n - 3 * HY) & 127;
    const int nn = (d >> 5) & 1, base = d - 32 * nn, idx = base < 32 ? base : base - 32, wc = idx >> 4, fq = (idx >> 2) & 3, e = idx & 3;
    return 3 * HY + h0 + 32 * wc + 8 * fq + 4 * nn + e; } };
struct MapGU { int up; __device__ __forceinline__ int operator()(int n) const { return (n >> 7) * 256 + up * 128 + (n & 127); } };

struct ConvItem { const float* src; bf16_t* dst; int K, N, k0, n0, kind; };
struct ConvSrc { const float* win; const float* wout; const float* wg; const float* wu; const float* wd; };
__device__ __forceinline__ ConvItem conv_item(const ConvSrc& in, unsigned char* ws, int layer, int r) {
    constexpr int I_IN = (D / 64) * (INW / 32), I_OUT = (D / 64) * (D / 32), I_G = (D / 64) * (FF / 32);
    ConvItem c; int nn;
    if (r < I_IN) { c.src = in.win + (size_t)layer * D * INW; c.dst = (bf16_t*)(ws + WS_WIN) + (size_t)layer * INW * D; c.K = D; nn = INW; c.kind = 1; }
    else if ((r -= I_IN) < I_OUT) { c.src = in.wout + (size_t)layer * D * D; c.dst = (bf16_t*)(ws + WS_WOUT) + (size_t)layer * D * D; c.K = D; nn = D; c.kind = 0; }
    else if ((r -= I_OUT) < I_G) { c.src = in.wg + (size_t)layer * D * FF; c.dst = (bf16_t*)(ws + WS_WGU) + (size_t)layer * GU * D; c.K = D; nn = FF; c.kind = 2; }
    else if ((r -= I_G) < I_G) { c.src = in.wu + (size_t)layer * D * FF; c.dst = (bf16_t*)(ws + WS_WGU) + (size_t)layer * GU * D; c.K = D; nn = FF; c.kind = 3; }
    else { r -= I_G; c.src = in.wd + (size_t)layer * FF * D; c.dst = (bf16_t*)(ws + WS_WD) + (size_t)layer * D * FF; c.K = FF; nn = D; c.kind = 0; }
    const int nblk = nn / 32; c.N = nn; c.k0 = 64 * (r / nblk); c.n0 = 32 * (r % nblk); return c;
}
__device__ __forceinline__ void convert_layer(LAS unsigned char* lds, const int layer, int w0, int nw, const int wave_s, const int lo, const int hi) {
    FRESH_IDS; FRESH_KP;
    unsigned char* ws = Pp->ws;
    LAS float* scr = (LAS float*)(lds + wave * 9216);
    constexpr int I_IN = (D / 64) * (INW / 32), I_OUT = (D / 64) * (D / 32), I_G = (D / 64) * (FF / 32), I_D = (FF / 64) * (D / 32);
    const ConvSrc inp{Pp->in[8], Pp->in[21], Pp->in[22], Pp->in[23], Pp->in[24]};
    const int lr = lane >> 3, ln = (lane & 7) * 4, c8 = lane & 7;
    f32x4 v[8];
    int it = lo + w0; const int TOT = hi;
#define CONV_ITEM(i_) conv_item(inp, ws, layer, (i_) < I_OUT ? I_IN + (i_) : I_IN + 2 * I_G + (i_))
    if (it < TOT) {
    ConvItem cur = CONV_ITEM(it);
#pragma unroll
    for (int i = 0; i < 8; ++i) v[i] = *(const f32x4*)(cur.src + (size_t)(cur.k0 + 8 * i + lr) * cur.N + cur.n0 + ln);
    for (;;) {
#pragma unroll
        for (int i = 0; i < 8; ++i) *(LAS f32x4*)(scr + (8 * i + lr) * 36 + ln) = v[i];
        const int itn = it + nw; const bool more = itn < TOT; ConvItem nxt = cur;
        if (more) { nxt = CONV_ITEM(itn);
#pragma unroll
            for (int i = 0; i < 8; ++i) v[i] = *(const f32x4*)(nxt.src + (size_t)(nxt.k0 + 8 * i + lr) * nxt.N + nxt.n0 + ln); }
        asm volatile("s_waitcnt lgkmcnt(0)" ::: "memory");
#pragma unroll
        for (int j = 0; j < 4; ++j) { const int nl_ = (lane >> 3) + 8 * j, n = cur.n0 + nl_; const LAS float* s = scr + (8 * c8) * 36 + nl_;
            u32x4 o; o.x = pk2(s[0 * 36], s[1 * 36]); o.y = pk2(s[2 * 36], s[3 * 36]); o.z = pk2(s[4 * 36], s[5 * 36]); o.w = pk2(s[6 * 36], s[7 * 36]);
            const int row = cur.kind == 1 ? MapIn{}(n) : cur.kind == 2 ? MapGU{0}(n) : cur.kind == 3 ? MapGU{1}(n) : n;
            *(u32x4*)(cur.dst + (size_t)row * cur.K + cur.k0 + 8 * c8) = o; }
        asm volatile("s_waitcnt lgkmcnt(0)" ::: "memory");
        if (!more) break;
        cur = nxt; it = itn;
    } }
}

__device__ __forceinline__ void convert_few(LAS unsigned char* lds, const int layer, int w0, int nw, const int wave_s, const int lo, const int hi) {
    FRESH_IDS; FRESH_KP;
    unsigned char* ws = Pp->ws;
    LAS float* scr = (LAS float*)(lds + wave * 9216);
    constexpr int I_IN = (D / 64) * (INW / 32), I_OUT = (D / 64) * (D / 32), I_G = (D / 64) * (FF / 32);
    const ConvSrc inp{Pp->in[8], Pp->in[21], Pp->in[22], Pp->in[23], Pp->in[24]};
    const int lr = lane >> 3, ln = (lane & 7) * 4, c8 = lane & 7;
    f32x4 v[4][8];
#pragma unroll
    for (int q = 0; q < 4; ++q) { const int it = lo + w0 + q * nw;
        if (it < hi) { const ConvItem c = CONV_ITEM(it);
#pragma unroll
            for (int i = 0; i < 8; ++i) v[q][i] = *(const f32x4*)(c.src + (size_t)(c.k0 + 8 * i + lr) * c.N + c.n0 + ln); } }
#pragma unroll
    for (int q = 0; q < 4; ++q) { const int it = lo + w0 + q * nw;
        if (it < hi) { const ConvItem c = CONV_ITEM(it);
#pragma unroll
            for (int i = 0; i < 8; ++i) *(LAS f32x4*)(scr + (8 * i + lr) * 36 + ln) = v[q][i];
            asm volatile("s_waitcnt lgkmcnt(0)" ::: "memory");
#pragma unroll
            for (int j = 0; j < 4; ++j) { const int nl_ = (lane >> 3) + 8 * j, n = c.n0 + nl_; const LAS float* s = scr + (8 * c8) * 36 + nl_;
                u32x4 o; o.x = pk2(s[0 * 36], s[1 * 36]); o.y = pk2(s[2 * 36], s[3 * 36]); o.z = pk2(s[4 * 36], s[5 * 36]); o.w = pk2(s[6 * 36], s[7 * 36]);
                *(u32x4*)(c.dst + (size_t)n * c.K + c.k0 + 8 * c8) = o; }
            asm volatile("s_waitcnt lgkmcnt(0)" ::: "memory"); } }
}

__device__ __forceinline__ void shw_items(int layer, int part, int w0, int nw, const int wave_s) {
    FRESH_IDS; FRESH_KP;
    unsigned char* ws = Pp->ws;
    const float* MOD = (const float*)(ws + WS_MOD);
    const bool isin = part == 0; const int nitems = (isin ? INW : GU) / 32;
    const float* sh = MOD + (size_t)layer * 3 * 6 * D + (isin ? 0 : 3) * D;
    float s0[32], s1[32], s2[32];
#pragma unroll
    for (int j = 0; j < 4; ++j)
#pragma unroll
        for (int e = 0; e < 8; ++e) { const int k = lane * 8 + 512 * j + e; s0[j * 8 + e] = sh[k]; s1[j * 8 + e] = sh[6 * D + k]; s2[j * 8 + e] = sh[12 * D + k]; }
    for (int it = w0; it < nitems; it += nw) { const int r0 = it * 32;
        const bf16_t* wbase = isin ? (const bf16_t*)(ws + WS_WIN) + ((size_t)layer * INW + r0) * D : (const bf16_t*)(ws + WS_WGU) + ((size_t)layer * GU + r0) * D;
        float k0 = 0.f, k1 = 0.f, k2 = 0.f;
#pragma unroll 2
        for (int rr = 0; rr < 32; ++rr) { const bf16_t* wrow = wbase + (size_t)rr * D;
            float a0 = 0.f, a1 = 0.f, a2 = 0.f;
#pragma unroll
            for (int j = 0; j < 4; ++j) { const int k = lane * 8 + 512 * j; const u32x4 w = *(const u32x4*)(wrow + k);
                const float wf[8] = {bf_lo(w.x), bf_hi(w.x), bf_lo(w.y), bf_hi(w.y), bf_lo(w.z), bf_hi(w.z), bf_lo(w.w), bf_hi(w.w)};
#pragma unroll
                for (int e = 0; e < 8; ++e) { a0 += wf[e] * s0[j * 8 + e]; a1 += wf[e] * s1[j * 8 + e]; a2 += wf[e] * s2[j * 8 + e]; } }
            a0 = wave_sum(a0); a1 = wave_sum(a1); a2 = wave_sum(a2);
            if (lane == rr) { k0 = a0; k1 = a1; k2 = a2; } }
        if (lane < 32) { float* o = isin ? (float*)(ws + WS_SHWIN) + (size_t)layer * 3 * INW + r0 + lane : (float*)(ws + WS_SHWGU) + (size_t)layer * 3 * GU + r0 + lane;
            const int st = isin ? INW : GU; o[0] = k0; o[st] = k1; o[2 * st] = k2; } }
}

__device__ __forceinline__ float silu_acc(float v) { return v / (1.f + expf(-v)); }

constexpr int CV_OUTD = (D / 64) * (D / 32) + (FF / 64) * (D / 32);
__device__ __forceinline__ void convert_shw(LAS unsigned char* lds, int w0, int nw, const int wave_s) {
    FRESH_IDS; FRESH_KP;
    unsigned char* ws = Pp->ws;
    LAS float* scr = (LAS float*)(lds + wave * 9216);
    const int lr = lane >> 3, ln = (lane & 7) * 4, c8 = lane & 7;
    constexpr int B_IN = INW / 32, B_G = FF / 32, PERL = B_IN + 2 * B_G;
#pragma nounroll
    for (int it = w0; it < DEPTH * PERL; it += nw) {
        const int layer = it / PERL; int r = it % PERL;
        const float* src; bf16_t* dst; float* shw; int N, n0, kind;
        if (r < B_IN) { kind = 1; N = INW; n0 = 32 * r; src = Pp->in[8] + (size_t)layer * D * INW; dst = (bf16_t*)(ws + WS_WIN) + (size_t)layer * INW * D; shw = (float*)(ws + WS_SHWIN) + (size_t)layer * 3 * INW + n0; }
        else { r -= B_IN; const int up = r >= B_G ? 1 : 0; if (up) r -= B_G; kind = 2 + up; N = FF; n0 = 32 * r; src = (up ? Pp->in[23] : Pp->in[22]) + (size_t)layer * D * FF;
               dst = (bf16_t*)(ws + WS_WGU) + (size_t)layer * GU * D; shw = (float*)(ws + WS_SHWGU) + (size_t)layer * 3 * GU + MapGU{up}(n0); }
        const int sstride = kind == 1 ? INW : GU;
        const float* shv = (const float*)(ws + WS_MOD) + (size_t)layer * 3 * 6 * D + (kind == 1 ? 0 : 3) * D + 8 * c8;
        const float* sp = src + (size_t)lr * N + n0 + ln;
        f32x4 v[8], sv[3][2]; float acc[4][3];
#pragma unroll
        for (int j = 0; j < 4; ++j) { acc[j][0] = 0.f; acc[j][1] = 0.f; acc[j][2] = 0.f; }
#pragma unroll
        for (int i = 0; i < 8; ++i) v[i] = *(const f32x4*)(sp + (size_t)(8 * i) * N);
#pragma unroll
        for (int vv = 0; vv < 3; ++vv) { sv[vv][0] = *(const f32x4*)(shv + (size_t)vv * 6 * D); sv[vv][1] = *(const f32x4*)(shv + (size_t)vv * 6 * D + 4); }
#pragma nounroll
        for (int kb = 0; kb < D / 64; ++kb) {
#pragma unroll
            for (int i = 0; i < 8; ++i) *(LAS f32x4*)(scr + (8 * i + lr) * 36 + ln) = v[i];
            float cs[3][8];
#pragma unroll
            for (int vv = 0; vv < 3; ++vv)
#pragma unroll
                for (int e = 0; e < 8; ++e) cs[vv][e] = sv[vv][e >> 2][e & 3];
            if (kb + 1 < D / 64) { const float* spn = sp + (size_t)(64 * (kb + 1)) * N; const float* shn = shv + 64 * (kb + 1);
#pragma unroll
                for (int i = 0; i < 8; ++i) v[i] = *(const f32x4*)(spn + (size_t)(8 * i) * N);
#pragma unroll
                for (int vv = 0; vv < 3; ++vv) { sv[vv][0] = *(const f32x4*)(shn + (size_t)vv * 6 * D); sv[vv][1] = *(const f32x4*)(shn + (size_t)vv * 6 * D + 4); } }
            asm volatile("s_waitcnt lgkmcnt(0)" ::: "memory");
#pragma unroll
            for (int j = 0; j < 4; ++j) { const int nl_ = (lane >> 3) + 8 * j, n = n0 + nl_; const LAS float* s = scr + (8 * c8) * 36 + nl_;
                float w[8];
#pragma unroll
                for (int e = 0; e < 8; ++e) w[e] = s[e * 36];
                u32x4 o; o.x = pk2(w[0], w[1]); o.y = pk2(w[2], w[3]); o.z = pk2(w[4], w[5]); o.w = pk2(w[6], w[7]);
                const int row = kind == 1 ? MapIn{}(n) : MapGU{kind - 2}(n);
                *(u32x4*)(dst + (size_t)row * D + 64 * kb + 8 * c8) = o;
#pragma unroll
                for (int vv = 0; vv < 3; ++vv) { float a = acc[j][vv];
#pragma unroll
                    for (int e = 0; e < 8; ++e) a += cs[vv][e] * w[e];
                    acc[j][vv] = a; } }
            asm volatile("s_waitcnt lgkmcnt(0)" ::: "memory");
        }
#pragma unroll
        for (int j = 0; j < 4; ++j)
#pragma unroll
            for (int vv = 0; vv < 3; ++vv) { float a = acc[j][vv]; a += __shfl_xor(a, 1); a += __shfl_xor(a, 2); a += __shfl_xor(a, 4);
                if (c8 == 0) shw[(size_t)vv * sstride + (lane >> 3) + 8 * j] = a; }
    }
}
__device__ __forceinline__ void p0a(LAS unsigned char* lds, int G, const int wave_s) {
    FRESH_IDS; FRESH_KP;
    unsigned char* ws = Pp->ws;
    const int gw = blockIdx.x * NWAVES + wave, NGW = G * NWAVES;
    const int gt = blockIdx.x * NTHR + tid, NGT = G * NTHR;
    { float* rope = (float*)(ws + WS_ROPE);
      for (int i = gt; i < 64 * 32; i += NGT) { const int pos = i >> 5, p = i & 31; const float inv = powf(10000.f, -(float)p / 32.f); const float ang = (float)pos * inv; rope[2 * i] = cosf(ang); rope[2 * i + 1] = sinf(ang); }
    }
    LAS float* SV = (LAS float*)(lds + 98304);
    for (int i = tid; i < 3 * D; i += NTHR) SV[i] = silu_acc(i < 2 * D ? Pp->in[1][i] : Pp->in[3][i - 2 * D]);
    __syncthreads();
    volatile LAS unsigned* MISC = (volatile LAS unsigned*)(lds + MISC_OFF); (void)MISC;
    TS_MARK(0, MK_TS == 13);
    { float* MODP = (float*)(ws + WS_MODP);
      constexpr int KCH = D / MOD_KC, NCH = 6 * D / 256, NIT = DEPTH * NCH * MOD_KC;
      static_assert(NIT == 256 * 6, "six GEMV waves per workgroup");
      if (wave < 6) { const int it = (int)blockIdx.x * 6 + wave;
          const int kc = it % MOD_KC, nc = (it / MOD_KC) % NCH, layer = it / (MOD_KC * NCH);
          const float* W = Pp->in[6] + (size_t)layer * D * 6 * D + (size_t)(kc * KCH) * 6 * D + nc * 256 + lane * 4;
          f32x4 a0 = {0.f, 0.f, 0.f, 0.f}, a1 = a0, a2 = a0;
#pragma unroll 16
          for (int k = 0; k < KCH; ++k) { const f32x4 w = *(const f32x4*)(W + (size_t)k * 6 * D); const int kk = kc * KCH + k;
              a0 += w * SV[kk]; a1 += w * SV[D + kk]; a2 += w * SV[2 * D + kk]; }
          float* o = MODP + ((size_t)(kc * DEPTH + layer) * 3) * 6 * D + nc * 256 + lane * 4;
          *(f32x4*)o = a0; *(f32x4*)(o + 6 * D) = a1; *(f32x4*)(o + 12 * D) = a2; } }
    TS_MARK(1, MK_TS == 13); TS_MARK(0, MK_TS == 14);
    if (wave >= 6) { constexpr int PL = SEQ + CTX; const int fw = (int)blockIdx.x * 2 + (wave - 6), NFW = G * 2;
#pragma nounroll
      for (int layer = 0; layer < DEPTH; ++layer) {
          const float* w1 = Pp->in[11] + (size_t)layer * FE * FH + lane; const float* w2 = Pp->in[13] + (size_t)layer * FH * FH + lane;
          float w1c[FE], w2c[FH];
#pragma unroll
          for (int j = 0; j < FE; ++j) w1c[j] = w1[j * FH];
#pragma unroll
          for (int j = 0; j < FH; ++j) w2c[j] = w2[j * FH];
          const float b1l = Pp->in[12][layer * FH + lane], b2l = Pp->in[14][layer * FH + lane], frl = Pp->in[16][layer * FH + lane];
#pragma nounroll
          for (int r = fw; r < PL; r += NFW) { const bool isc = r >= SEQ; const int l = isc ? r - SEQ : r, L = isc ? CTX : SEQ;
              float emb = 0.f;
              if (lane < FE) { const float t = (float)l / (float)(L - 1); const float w = (2.0f * 3.14159265358979323846f / (float)L) * (float)l;
                  if (lane == 0) emb = t; else { const int bi = (lane - 1) & 15; const float band = 1e-4f + (float)bi * ((15.0f - 1e-4f) / 15.0f); emb = lane <= 16 ? cosf(band * w) : -sinf(band * w); } }
              float a = b1l;
#pragma unroll
              for (int j = 0; j < FE; ++j) a += __shfl(emb, j) * w1c[j];
              const float h1 = sinf(frl * a);
              float c = b2l;
#pragma unroll
              for (int j = 0; j < FH; ++j) c += __shfl(h1, j) * w2c[j];
              bf16_t* dst = isc ? (bf16_t*)(ws + WS_HIDC) + ((size_t)layer * CTX + l) * FH : (bf16_t*)(ws + WS_HIDL) + ((size_t)layer * SEQ + l) * FH;
              dst[lane] = (bf16_t)f2bf(sinf(frl * c)); } } }
    TS_MARK(1, MK_TS == 14); TS_MARK(0, MK_TS == 15);
    { for (int it = gw; it < DEPTH * 64; it += NGW) { const int layer = it >> 6, np = (it & 63) * 64 + lane;
          const int j = (np & 1) * 2048 + ((np >> 1) & 1) * 1024 + (np >> 2);
          const float* w3 = Pp->in[15] + (size_t)layer * FH * 4096 + j;
          bf16_t* dst = (bf16_t*)(ws + WS_W3T) + ((size_t)layer * 4096 + np) * FH;
#pragma unroll
          for (int k8 = 0; k8 < 8; ++k8) { float v[8];
#pragma unroll
              for (int e = 0; e < 8; ++e) v[e] = w3[(size_t)(k8 * 8 + e) * 4096];
              u32x4 w; w.x = pk2(v[0], v[1]); w.y = pk2(v[2], v[3]); w.z = pk2(v[4], v[5]); w.w = pk2(v[6], v[7]);
              *(u32x4*)(dst + k8 * 8) = w; } } }
    TS_MARK(1, MK_TS == 15);
}

__device__ __forceinline__ void p0b(int G, const int wave_s) {
    FRESH_IDS; FRESH_KP;
    unsigned char* ws = Pp->ws; const int gt = blockIdx.x * NTHR + tid, NGT = G * NTHR;
    const float* MODP = (const float*)(ws + WS_MODP); float* MOD = (float*)(ws + WS_MOD);
    constexpr int NTOT = DEPTH * 3 * 6 * D;
    for (int i = gt; i < NTOT; i += NGT) { const int layer = i / (3 * 6 * D), n = i % (6 * D); float s = Pp->in[7][(size_t)layer * 6 * D + n];
#pragma unroll
        for (int kc = 0; kc < MOD_KC; ++kc) { const int rest = i % (3 * 6 * D); s += MODP[((size_t)(kc * DEPTH + layer) * 3) * 6 * D + rest]; }
        MOD[i] = s; ((bf16_t*)(ws + WS_MODB))[i] = (bf16_t)f2bf(s); }
}

__device__ __forceinline__ void p0c(LAS unsigned char* lds, int G, const int wave_s) {
    FRESH_IDS; FRESH_KP;
    unsigned char* ws = Pp->ws;
    const int gw = blockIdx.x * NWAVES + wave, NGW = G * NWAVES;
    const int gt = blockIdx.x * NTHR + tid, NGT = G * NTHR;
    const float* MOD = (const float*)(ws + WS_MOD);
    volatile LAS unsigned* MISC = (volatile LAS unsigned*)(lds + MISC_OFF);
    TS_MARK(0, MK_TS == 30);
    { float* GMV = (float*)(ws + WS_GMV);
      for (int i = gt; i < DEPTH * 2 * 3 * D; i += NGT) { const int c = i % D, v = (i / D) % 3, which = (i / (3 * D)) % 2, layer = i / (6 * D);
          const float g = which ? Pp->in[5][layer * D + c] : Pp->in[4][layer * D + c];
          GMV[i] = g * (1.0f + MOD[((size_t)layer * 3 + v) * 6 * D + (which ? 4 : 1) * D + c]); } }
    TS_MARK(1, MK_TS == 30); TS_MARK(0, MK_TS == 31);
    { constexpr int NSUP = DEPTH * ((INW + 2 * FF) / 32), FIRST = 32 * (256 * NWAVES - NSUP);
      convert_shw(lds, gw, NGW, wave_s);
      if (gw >= NSUP) convert_layer(lds, 0, gw - NSUP, NGW - NSUP, wave_s, 0, FIRST);
      convert_layer(lds, 0, gw, NGW, wave_s, FIRST, CV_OUTD); }
    TS_MARK(1, MK_TS == 31); TS_MARK(0, MK_TS == 32);
    { bf16_t* AN = (bf16_t*)(ws + WS_AN); float* SSQ = (float*)(ws + WS_SSQ); float* SSQC = (float*)(ws + WS_SSQC);
      const int nlat = (ML + NGW - 1 - gw) / NGW;
      const int nctx = (int)blockIdx.x < MC / 32 ? 4 : 0;
#pragma unroll 2
      for (int i = 0; i < nlat + nctx; ++i) { const bool isc = i >= nlat; const int row = isc ? ML + (int)blockIdx.x * 32 + wave * 4 + (i - nlat) : gw + i * NGW;
          const int v = vec_of_row(row); const float* xr = isc ? Pp->in[2] + (size_t)(row - ML) * D : Pp->in[0] + (size_t)row * D; float s = 0.f;
#pragma unroll
          for (int j = 0; j < 4; ++j) { const int c = lane * 8 + 512 * j; const f32x4 a = *(const f32x4*)(xr + c), b = *(const f32x4*)(xr + c + 4);
              s += (a[0] * a[0] + a[1] * a[1]) + (a[2] * a[2] + a[3] * a[3]) + (b[0] * b[0] + b[1] * b[1]) + (b[2] * b[2] + b[3] * b[3]);
              const f32x4 g0 = *(const f32x4*)(Pp->in[4] + c), g1 = *(const f32x4*)(Pp->in[4] + c + 4), m0 = *(const f32x4*)(MOD + (size_t)v * 6 * D + D + c), m1 = *(const f32x4*)(MOD + (size_t)v * 6 * D + D + c + 4);
              const f32x4 ga = a * g0 * (m0 + 1.0f), gb = b * g1 * (m1 + 1.0f);
              u32x4 w; w.x = pk2(ga[0], ga[1]); w.y = pk2(ga[2], ga[3]); w.z = pk2(gb[0], gb[1]); w.w = pk2(gb[2], gb[3]);
              *(u32x4*)(AN + (size_t)row * D + c) = w; }
          s = wave_sum(s);
          if (!isc) { if (lane < 32) SSQ[((size_t)(lane >> 2) * MT + row) * 4 + (lane & 3)] = lane == 0 ? s : 0.f; }
          else if (lane < 32) SSQC[(size_t)lane * MC + (row - ML)] = lane == 0 ? s : 0.f; } }
    TS_MARK(1, MK_TS == 32); TS_MARK(0, MK_TS == 33);
    { typedef float f32x16_ __attribute__((ext_vector_type(16)));
      const int r32 = lane & 31, hi = lane >> 5;
      constexpr int IT_L = 128 * 16, IT_C = 128, PER = IT_L + IT_C;
      for (int it = gw; it < DEPTH * PER; it += NGW) {
          const int layer = it / PER; int r = it % PER; const bool isc = r >= IT_L; if (isc) r -= IT_L;
          const int nb = r & 127, lc = r >> 7, L = isc ? CTX : SEQ; constexpr int nlb = 8;
          const bf16_t* arow = (const bf16_t*)(ws + WS_W3T) + ((size_t)layer * 4096 + nb * 32 + r32) * FH + hi * 8;
          pg8::bf16x8 a[4];
#pragma unroll
          for (int s = 0; s < 4; ++s) a[s] = *(const pg8::bf16x8*)(arow + 16 * s);
          const bf16_t* hb = isc ? (const bf16_t*)(ws + WS_HIDC) + (size_t)layer * CTX * FH : (const bf16_t*)(ws + WS_HIDL) + (size_t)layer * SEQ * FH;
          unsigned* tf = isc ? (unsigned*)(ws + WS_FLTC) + (size_t)layer * HY * CTX : (unsigned*)(ws + WS_FLT) + (size_t)layer * HY * SEQ;
          unsigned* tb = isc ? (unsigned*)(ws + WS_FLTC) + (size_t)(DEPTH + layer) * HY * CTX : (unsigned*)(ws + WS_FLT) + (size_t)(DEPTH + layer) * HY * SEQ;
          float dl[8];
#pragma unroll
          for (int rp = 0; rp < 8; ++rp) { const int c = (nb * 32 + (2 * (rp & 1)) + 8 * (rp >> 1) + 4 * hi) >> 2;
              dl[rp] = fabsf(-3.0701134573253945f + (float)c * ((-15.350567286626973f + 3.0701134573253945f) / 1023.f)) * LOG2E; }
#pragma unroll 4
          for (int lb = 0; lb < nlb; ++lb) { const int l = (lc * 8 + lb) * 32 + r32;
              const bf16_t* brow = hb + (size_t)l * FH + hi * 8;
              f32x16_ acc;
#pragma unroll
              for (int q = 0; q < 16; ++q) acc[q] = 0.f;
#pragma unroll
              for (int s = 0; s < 4; ++s) acc = __builtin_amdgcn_mfma_f32_32x32x16_bf16(a[s], *(const pg8::bf16x8*)(brow + 16 * s), acc, 0, 0, 0);
              const float t = (float)l / (float)(L - 1);
#pragma unroll
              for (int rp = 0; rp < 8; ++rp) { const int rr = 2 * rp, n = nb * 32 + (rr & 3) + 8 * (rr >> 2) + 4 * hi, c = n >> 2, d = (n >> 1) & 1;
                  const float wdw = __builtin_amdgcn_exp2f(-t * dl[rp]);
                  const unsigned v = pk2(acc[rr] * wdw, acc[rr + 1] * wdw);
                  if (d == 0) tf[(size_t)c * L + l] = v; else tb[(size_t)c * L + l] = l == 0 ? 0u : v; } } } }
    TS_MARK(1, MK_TS == 33);
}

__device__ __forceinline__ void attn_simple(LAS unsigned char* lds, int layer, int G, int nrows, const int wave_s) {
    FRESH_IDS; FRESH_KP;
    unsigned char* ws = Pp->ws;
    const bf16_t* Q = (const bf16_t*)(ws + WS_Q); const bf16_t* Kb = (const bf16_t*)(ws + WS_K); const bf16_t* Vb = (const bf16_t*)(ws + WS_V);
    bf16_t* YM = (bf16_t*)(ws + WS_YM);
    LAS float* qs = (LAS float*)lds + wave * HD;
    LAS float* ps = (LAS float*)(lds + 4096) + wave * 640;
    LAS float* red = (LAS float*)(lds + 4096 + 8 * 640 * 4);
    const int h = wave, kv = h >> 2;
    const float sk = Pp->in[18][layer * NH + h] * LOG2E;
    const float* gat = Pp->in[20] + layer * ATTW; const float* ghy = Pp->in[19] + layer * HY; const float* ZT = (const float*)(ws + WS_SSHY);
    for (int row = blockIdx.x; row < nrows; row += G) {
        { const unsigned w = *(const unsigned*)(Q + (size_t)row * ATTW + h * HD + 2 * lane); qs[2 * lane] = bf_lo(w); qs[2 * lane + 1] = bf_hi(w); }
        int b, j0 = 0, nwin = 0;
        if (row < ML) { b = row / SEQ; const int l = row % SEQ; j0 = l - WINDOW < 0 ? 0 : l - WINDOW; const int j1 = l + WINDOW > SEQ - 1 ? SEQ - 1 : l + WINDOW; nwin = j1 - j0 + 1; }
        else b = (row - ML) / CTX;
        const int nk = nwin + CTX;
        float mx = -3.0e38f;
        for (int j = lane; j < nk; j += 64) {
            const int krow = j < nwin ? b * SEQ + j0 + j : ML + b * CTX + (j - nwin);
            const bf16_t* kr = Kb + (size_t)krow * KVW + kv * HD;
            float s = 0.f;
#pragma unroll
            for (int d = 0; d < HD; d += 8) { const u32x4 w = *(const u32x4*)(kr + d);
                s += qs[d] * bf_lo(w.x) + qs[d + 1] * bf_hi(w.x) + qs[d + 2] * bf_lo(w.y) + qs[d + 3] * bf_hi(w.y) + qs[d + 4] * bf_lo(w.z) + qs[d + 5] * bf_hi(w.z) + qs[d + 6] * bf_lo(w.w) + qs[d + 7] * bf_hi(w.w); }
            ps[j] = s; mx = fmaxf(mx, s);
        }
        mx = fmaxf(wave_max(mx), sk);
        float sum = 0.f;
        for (int j = lane; j < nk; j += 64) { const float e = __builtin_amdgcn_exp2f(ps[j] - mx); ps[j] = e; sum += e; }
        sum = wave_sum(sum) + __builtin_amdgcn_exp2f(sk - mx);
        float o0 = 0.f, o1 = 0.f;
        for (int j = 0; j < nk; ++j) {
            const int krow = j < nwin ? b * SEQ + j0 + j : ML + b * CTX + (j - nwin);
            const unsigned w = *(const unsigned*)(Vb + (size_t)krow * KVW + kv * HD + 2 * lane);
            const float pj = ps[j]; o0 += pj * bf_lo(w); o1 += pj * bf_hi(w);
        }
        const float inv = 1.f / sum; o0 *= inv; o1 *= inv;
        const float part = wave_sum(o0 * o0 + o1 * o1);
        const float z0 = ZT[(size_t)(2 * tid) * MT + row], z1 = ZT[(size_t)(2 * tid + 1) * MT + row];
        const float parth = wave_sum(z0 * z0 + z1 * z1);
        __syncthreads();
        if (lane == 0) { red[wave] = part; red[8 + wave] = parth; }
        __syncthreads();
        float tot = 0.f, toth = 0.f;
#pragma unroll
        for (int i = 0; i < 8; ++i) { tot += red[i]; toth += red[8 + i]; }
        const float r = 1.0f / sqrtf(tot * (1.0f / ATTW) + EPS), rh = 1.0f / sqrtf(toth * (1.0f / HY) + EPS);
        const int c = h * HD + 2 * lane;
        *(unsigned*)(YM + (size_t)row * D + HY + c) = pk2(o0 * r * gat[c], o1 * r * gat[c + 1]);
        *(unsigned*)(YM + (size_t)row * D + 2 * tid) = pk2(z0 * rh * ghy[2 * tid], z1 * rh * ghy[2 * tid + 1]);
    }
    __syncthreads();
}

__device__ __forceinline__ float phy_at(const bf16_t* PHY, int row, int ch) { return bf1(PHY[((size_t)(ch >> 2) * MT + row) * 4 + (ch & 3)]); }
__device__ __forceinline__ float sconv(const bf16_t* PHY, const float* cw, const float* cb, int row, int ch, int l, int L) {
    float a = cb[ch] + cw[3 * HY + ch] * phy_at(PHY, row, ch);
    if (l > 0) a += cw[ch] * phy_at(PHY, row - 1, ch);
    if (l < L - 1) a += cw[2 * 3 * HY + ch] * phy_at(PHY, row + 1, ch);
    return a;
}
template <int L>
__device__ __forceinline__ void hyena_direct(LAS unsigned char* lds, int layer, int G, int row_base, const int wave_s) {
    FRESH_IDS; FRESH_KP;
    unsigned char* ws = Pp->ws;
    constexpr int TPB = L < NTHR ? L : NTHR, NI = L / TPB;
    const bf16_t* PHY = (const bf16_t*)(ws + WS_PHY); float* ZT = (float*)(ws + WS_SSHY);
    const unsigned* TF = L == SEQ ? (const unsigned*)(ws + WS_FLT) + (size_t)layer * HY * SEQ : (const unsigned*)(ws + WS_FLTC) + (size_t)layer * HY * CTX;
    const unsigned* TB = L == SEQ ? (const unsigned*)(ws + WS_FLT) + (size_t)(DEPTH + layer) * HY * SEQ : (const unsigned*)(ws + WS_FLTC) + (size_t)(DEPTH + layer) * HY * CTX;
    const float* cw = Pp->in[9] + (size_t)layer * 3 * 3 * HY; const float* cb = Pp->in[10] + (size_t)layer * 3 * HY;
    const float* fbias = Pp->in[17] + (size_t)layer * 2 * HY;
    LAS float* G0 = (LAS float*)lds; LAS float* G1 = G0 + 2 * L; LAS float* z = G1 + 2 * L;
    for (int it = blockIdx.x; it < HY * BATCH; it += G) {
        const int c = it % HY, seq = it / HY, row0 = row_base + seq * L;
        __syncthreads();
#pragma nounroll
        for (int d = tid; d < L; d += NTHR) {
            { const unsigned f = TF[(size_t)c * L + d]; G0[L - 1 + d] = bf_lo(f); G1[L - 1 + d] = bf_hi(f); }
            if (d > 0) { const unsigned bk = TB[(size_t)c * L + d]; G0[L - 1 - d] = bf_lo(bk); G1[L - 1 - d] = bf_hi(bk); }
            z[d] = sconv(PHY, cw, cb, row0 + d, 2 * HY + c, d, L);
        }
        __syncthreads();
#pragma unroll
        for (int o = 0; o < 2; ++o) {
            LAS float* Gg = o ? G1 : G0;
            float acc[NI], zn[NI];
#pragma unroll
            for (int i = 0; i < NI; ++i) acc[i] = 0.f;
            if (tid < TPB) {
                for (int s = 0; s < L; ++s) { const float zs = z[s];
#pragma unroll
                    for (int i = 0; i < NI; ++i) acc[i] += zs * Gg[tid + TPB * i - s + L - 1]; }
                const float fb = fbias[o * HY + c];
#pragma nounroll
                for (int i = 0; i < NI; ++i) { const int t = tid + TPB * i; zn[i] = sconv(PHY, cw, cb, row0 + t, o * HY + c, t, L) * (acc[i] + fb * z[t]); }
            }
            __syncthreads();
            if (tid < TPB) {
#pragma unroll
                for (int i = 0; i < NI; ++i) z[tid + TPB * i] = zn[i];
            }
            __syncthreads();
        }
        if (tid < TPB) {
#pragma unroll
            for (int i = 0; i < NI; ++i) { const int t = tid + TPB * i; ZT[(size_t)c * MT + row0 + t] = z[t]; } }
    }
    __syncthreads();
}

__device__ __forceinline__ void hyena_ctx(LAS unsigned char* lds, int layer, int first, int stride, const int wave_s) {
    FRESH_IDS; FRESH_KP;
    unsigned char* ws = Pp->ws;
    constexpr int L = CTX;
    const bf16_t* PHY = (const bf16_t*)(ws + WS_PHY); float* ZT = (float*)(ws + WS_SSHY);
    const unsigned* TF = (const unsigned*)(ws + WS_FLTC) + (size_t)layer * HY * CTX; const unsigned* TB = (const unsigned*)(ws + WS_FLTC) + (size_t)(DEPTH + layer) * HY * CTX;
    const float* cw = Pp->in[9] + (size_t)layer * 3 * 3 * HY; const float* cb = Pp->in[10] + (size_t)layer * 3 * HY; const float* fbias = Pp->in[17] + (size_t)layer * 2 * HY;
    const int half = tid >> 8, t = tid & 255;
    LAS float* Gb = (LAS float*)(lds + half * 8192);
    LAS float* zb = Gb + 1024;
    for (int it = first; it < HY / 2; it += stride) {
        const int c = 2 * it + half;
        __syncthreads();
        { const unsigned f = TF[(size_t)c * L + t]; Gb[255 + t] = bf_lo(f); Gb[512 + 255 + t] = bf_hi(f);
          if (t > 0) { const unsigned bk = TB[(size_t)c * L + t]; Gb[255 - t] = bf_lo(bk); Gb[512 + 255 - t] = bf_hi(bk); }
          zb[t] = sconv(PHY, cw, cb, ML + t, 2 * HY + c, t, L); zb[256 + t] = sconv(PHY, cw, cb, ML + L + t, 2 * HY + c, t, L); }
        float gte[2][2];
#pragma unroll
        for (int o = 0; o < 2; ++o) { gte[o][0] = sconv(PHY, cw, cb, ML + t, o * HY + c, t, L); gte[o][1] = sconv(PHY, cw, cb, ML + L + t, o * HY + c, t, L); }
        __syncthreads();
#pragma unroll
        for (int o = 0; o < 2; ++o) {
            const LAS float* Gg = Gb + o * 512 + t + 255;
            float a0 = 0.f, a1 = 0.f;
#pragma unroll 4
            for (int s = 0; s < L; s += 4) { const f32x4 z0 = *(const LAS f32x4*)(zb + s), z1 = *(const LAS f32x4*)(zb + 256 + s);
#pragma unroll
                for (int e = 0; e < 4; ++e) { const float g = Gg[-(s + e)]; a0 += z0[e] * g; a1 += z1[e] * g; } }
            const float fb = fbias[o * HY + c];
            const float n0 = gte[o][0] * (a0 + fb * zb[t]);
            const float n1 = gte[o][1] * (a1 + fb * zb[256 + t]);
            __syncthreads();
            zb[t] = n0; zb[256 + t] = n1;
            __syncthreads();
        }
        ZT[(size_t)c * MT + ML + t] = zb[t]; ZT[(size_t)c * MT + ML + L + t] = zb[256 + t];
    }
    __syncthreads();
}

constexpr int FN = 8192, FPAD = FN + FN / 32;
__device__ __forceinline__ int fpad(int p) { return p + (p >> 5); }
__device__ __forceinline__ f32x2 cmul(f32x2 a, f32x2 b) { return (f32x2){a.x * b.x - a.y * b.y, a.x * b.y + a.y * b.x}; }
__device__ __forceinline__ f32x2 cmulc(f32x2 a, f32x2 b) { return (f32x2){a.x * b.x + a.y * b.y, a.y * b.x - a.x * b.y}; }
template <bool INV> __device__ __forceinline__ f32x2 cmul_tw(f32x2 a, f32x2 w) { return INV ? cmulc(a, w) : cmul(a, w); }
template <bool INV> __device__ __forceinline__ void dft4(f32x2& x0, f32x2& x1, f32x2& x2, f32x2& x3) {
    const f32x2 t0 = x0 + x2, t1 = x0 - x2, t2 = x1 + x3, t3 = x1 - x3;
    const f32x2 jt3 = INV ? (f32x2){-t3.y, t3.x} : (f32x2){t3.y, -t3.x};
    x0 = t0 + t2; x2 = t0 - t2; x1 = t1 + jt3; x3 = t1 - jt3;
}
template <bool INV> __device__ __forceinline__ void dft16(f32x2 (&x)[16]) {
    constexpr float C1 = 0.92387953251128674f, S1 = 0.38268343236508977f, C2 = 0.70710678118654752f;
#pragma unroll
    for (int b = 0; b < 4; ++b) dft4<INV>(x[b], x[4 + b], x[8 + b], x[12 + b]);
    const f32x2 w1 = {C1, -S1}, w2 = {C2, -C2}, w3 = {S1, -C1}, w4 = {0.f, -1.f}, w6 = {-C2, -C2}, w9 = {-C1, S1};
    x[4 * 1 + 1] = cmul_tw<INV>(x[5], w1); x[4 * 1 + 2] = cmul_tw<INV>(x[6], w2); x[4 * 1 + 3] = cmul_tw<INV>(x[7], w3);
    x[4 * 2 + 1] = cmul_tw<INV>(x[9], w2); x[4 * 2 + 2] = cmul_tw<INV>(x[10], w4); x[4 * 2 + 3] = cmul_tw<INV>(x[11], w6);
    x[4 * 3 + 1] = cmul_tw<INV>(x[13], w3); x[4 * 3 + 2] = cmul_tw<INV>(x[14], w6); x[4 * 3 + 3] = cmul_tw<INV>(x[15], w9);
#pragma unroll
    for (int c = 0; c < 4; ++c) dft4<INV>(x[4 * c], x[4 * c + 1], x[4 * c + 2], x[4 * c + 3]);
    f32x2 y[16];
#pragma unroll
    for (int k = 0; k < 16; ++k) y[k] = x[4 * (k & 3) + (k >> 2)];
#pragma unroll
    for (int k = 0; k < 16; ++k) x[k] = y[k];
}
__device__ __forceinline__ void dft16_fwd_lo(f32x2 (&x)[16]) {
    constexpr float C1 = 0.92387953251128674f, S1 = 0.38268343236508977f, C2 = 0.70710678118654752f;
#pragma unroll
    for (int b = 0; b < 4; ++b) { const f32x2 x0 = x[b], x1 = x[4 + b]; const f32x2 j1 = {x1.y, -x1.x};
        x[b] = x0 + x1; x[4 + b] = x0 + j1; x[8 + b] = x0 - x1; x[12 + b] = x0 - j1; }
    const f32x2 w1 = {C1, -S1}, w2 = {C2, -C2}, w3 = {S1, -C1}, w4 = {0.f, -1.f}, w6 = {-C2, -C2}, w9 = {-C1, S1};
    x[5] = cmul(x[5], w1); x[6] = cmul(x[6], w2); x[7] = cmul(x[7], w3);
    x[9] = cmul(x[9], w2); x[10] = cmul(x[10], w4); x[11] = cmul(x[11], w6);
    x[13] = cmul(x[13], w3); x[14] = cmul(x[14], w6); x[15] = cmul(x[15], w9);
#pragma unroll
    for (int c = 0; c < 4; ++c) dft4<false>(x[4 * c], x[4 * c + 1], x[4 * c + 2], x[4 * c + 3]);
    f32x2 y[16];
#pragma unroll
    for (int k = 0; k < 16; ++k) y[k] = x[4 * (k & 3) + (k >> 2)];
#pragma unroll
    for (int k = 0; k < 16; ++k) x[k] = y[k];
}
__device__ __forceinline__ void dft16_inv_lo(f32x2 (&x)[16]) {
    constexpr float C1 = 0.92387953251128674f, S1 = 0.38268343236508977f, C2 = 0.70710678118654752f;
#pragma unroll
    for (int b = 0; b < 4; ++b) dft4<true>(x[b], x[4 + b], x[8 + b], x[12 + b]);
    const f32x2 w1 = {C1, -S1}, w2 = {C2, -C2}, w3 = {S1, -C1}, w4 = {0.f, -1.f}, w6 = {-C2, -C2}, w9 = {-C1, S1};
    x[5] = cmulc(x[5], w1); x[6] = cmulc(x[6], w2); x[7] = cmulc(x[7], w3);
    x[9] = cmulc(x[9], w2); x[10] = cmulc(x[10], w4); x[11] = cmulc(x[11], w6);
    x[13] = cmulc(x[13], w3); x[14] = cmulc(x[14], w6); x[15] = cmulc(x[15], w9);
    f32x2 y[8];
#pragma unroll
    for (int c = 0; c < 4; ++c) { const f32x2 t0 = x[4 * c] + x[4 * c + 2], t1 = x[4 * c] - x[4 * c + 2], t2 = x[4 * c + 1] + x[4 * c + 3], t3 = x[4 * c + 1] - x[4 * c + 3];
        y[c] = t0 + t2; y[4 + c] = t1 + (f32x2){-t3.y, t3.x}; }
#pragma unroll
    for (int k = 0; k < 8; ++k) x[k] = y[k];
}
template <bool INV> __device__ __forceinline__ void dft32(f32x2 (&x)[32]) {
    constexpr float CS[16] = {1.f, 0.98078528040323043f, 0.92387953251128674f, 0.83146961230254524f, 0.70710678118654752f, 0.55557023301960218f, 0.38268343236508977f, 0.19509032201612825f,
                              0.f, -0.19509032201612825f, -0.38268343236508977f, -0.55557023301960218f, -0.70710678118654752f, -0.83146961230254524f, -0.92387953251128674f, -0.98078528040323043f};
    constexpr float SN[16] = {0.f, 0.19509032201612825f, 0.38268343236508977f, 0.55557023301960218f, 0.70710678118654752f, 0.83146961230254524f, 0.92387953251128674f, 0.98078528040323043f,
                              1.f, 0.98078528040323043f, 0.92387953251128674f, 0.83146961230254524f, 0.70710678118654752f, 0.55557023301960218f, 0.38268343236508977f, 0.19509032201612825f};
    f32x2 a[16], b[16];
#pragma unroll
    for (int j = 0; j < 16; ++j) { a[j] = x[j] + x[j + 16]; const f32x2 d = x[j] - x[j + 16]; b[j] = cmul_tw<INV>(d, (f32x2){CS[j], -SN[j]}); }
    dft16<INV>(a); dft16<INV>(b);
#pragma unroll
    for (int k = 0; k < 16; ++k) { x[2 * k] = a[k]; x[2 * k + 1] = b[k]; }
}
__device__ __forceinline__ void tw_powers(f32x2 w1, f32x2 (&w)[16]) {
    w[1] = w1; w[2] = cmul(w1, w1); w[3] = cmul(w[2], w1); w[4] = cmul(w[2], w[2]); w[5] = cmul(w[4], w1); w[6] = cmul(w[3], w[3]); w[7] = cmul(w[4], w[3]);
    w[8] = cmul(w[4], w[4]); w[9] = cmul(w[8], w1); w[10] = cmul(w[5], w[5]); w[11] = cmul(w[8], w[3]); w[12] = cmul(w[6], w[6]); w[13] = cmul(w[8], w[5]); w[14] = cmul(w[7], w[7]); w[15] = cmul(w[8], w[7]);
}
__device__ __forceinline__ f32x2 tw_base(float turns) { asm volatile("" : "+v"(turns)); return (f32x2){__builtin_amdgcn_cosf(turns), -__builtin_amdgcn_sinf(turns)}; }
template <bool LO> __device__ __forceinline__ void fft_fwd1(f32x2 (&x)[16], LAS f32x2* B, int n2, const f32x2 (&w)[16]) {
    asm volatile("" : "+v"(n2));
    if (LO) dft16_fwd_lo(x); else dft16<false>(x);
    B[fpad(n2)] = x[0];
#pragma unroll
    for (int k = 1; k < 16; ++k) B[fpad(512 * k + n2)] = cmul(x[k], w[k]);
}
__device__ __forceinline__ void fft_fwd2(LAS f32x2* B, const LAS f32x2* TW2, int tid) {
    asm volatile("" : "+v"(tid));
    const int b = tid >> 5, n2 = tid & 31, base = 512 * b + n2; f32x2 x[16];
#pragma unroll
    for (int r = 0; r < 16; ++r) x[r] = B[fpad(base + 32 * r)];
    dft16<false>(x);
    B[fpad(base)] = x[0];
#pragma unroll
    for (int k = 1; k < 16; ++k) B[fpad(base + 32 * k)] = cmul(x[k], TW2[k * 32 + n2]);
}
__device__ __forceinline__ void fft_inv2(LAS f32x2* B, const LAS f32x2* TW2, int tid) {
    asm volatile("" : "+v"(tid));
    const int b = tid >> 5, n2 = tid & 31, base = 512 * b + n2; f32x2 x[16];
    x[0] = B[fpad(base)];
#pragma unroll
    for (int k = 1; k < 16; ++k) x[k] = cmulc(B[fpad(base + 32 * k)], TW2[k * 32 + n2]);
    dft16<true>(x);
#pragma unroll
    for (int r = 0; r < 16; ++r) B[fpad(base + 32 * r)] = x[r];
}
template <int MODE> __device__ __forceinline__ void fft_pair32(LAS f32x2* B, const LAS f32x2* F, int wave, int lane) {
    asm volatile("" : "+v"(lane));
    constexpr float CS[16] = {1.f, 0.98078528040323043f, 0.92387953251128674f, 0.83146961230254524f, 0.70710678118654752f, 0.55557023301960218f, 0.38268343236508977f, 0.19509032201612825f,
                              0.f, -0.19509032201612825f, -0.38268343236508977f, -0.55557023301960218f, -0.70710678118654752f, -0.83146961230254524f, -0.92387953251128674f, -0.98078528040323043f};
    constexpr float SN[16] = {0.f, 0.19509032201612825f, 0.38268343236508977f, 0.55557023301960218f, 0.70710678118654752f, 0.83146961230254524f, 0.92387953251128674f, 0.98078528040323043f,
                              1.f, 0.98078528040323043f, 0.92387953251128674f, 0.83146961230254524f, 0.70710678118654752f, 0.55557023301960218f, 0.38268343236508977f, 0.19509032201612825f};
    const int hi = lane >> 5, blk = 32 * wave + (lane & 31); const float sg = hi ? -1.f : 1.f;
    LAS f32x2* p = B + 33 * blk; f32x2 v[16];
#pragma unroll
    for (int j = 0; j < 16; ++j) { const f32x2 d = p[j] + p[j + 16] * sg;
        const f32x2 w = {hi ? CS[j] : 1.f, hi ? -SN[j] : 0.f}; v[j] = j == 0 ? d : cmul(d, w); }
    dft16<false>(v);
    if (MODE == 2) {
#pragma unroll
        for (int k = 0; k < 16; ++k) p[2 * k + hi] = v[k];
        return; }
    const int k1 = blk >> 4, k2 = blk & 15, kb1 = (16 - k1) & 15, b1 = k1 != 0 ? 1 : 0, kb2 = (16 - k2 - b1) & 15, b2 = (k2 != 0 || b1) ? 1 : 0;
    const LAS f32x2* fa = F + 33 * blk; const LAS f32x2* fb = F + 33 * (16 * kb1 + kb2);
    const LAS f32x2* fah = fa + hi; const LAS f32x2* fbh = fb + (1 - b2) - hi;
    constexpr float SC = 1.0f / (2.0f * (float)FN);
#pragma unroll
    for (int k = 0; k < 16; ++k) { const f32x2 A = fah[2 * k]; f32x2 Bm = fbh[31 - 2 * k];
        if (k == 0) { const f32x2 m0 = b2 ? fb[31] : fa[0]; Bm = hi ? Bm : m0; }
        const f32x2 H = MODE == 0 ? (f32x2){(A.x + Bm.x) * SC, (A.y - Bm.y) * SC} : (f32x2){(A.y + Bm.y) * SC, (Bm.x - A.x) * SC};
        v[k] = cmul(v[k], H); }
    dft16<true>(v);
#pragma unroll
    for (int j = 0; j < 16; ++j) { const f32x2 w = {hi ? CS[j] : 1.f, hi ? -SN[j] : 0.f}; const f32x2 u = j == 0 ? v[j] : cmulc(v[j], w);
        const auto rx = __builtin_amdgcn_permlane32_swap(__float_as_uint(u.x), __float_as_uint(u.x), false, false);
        const auto ry = __builtin_amdgcn_permlane32_swap(__float_as_uint(u.y), __float_as_uint(u.y), false, false);
        const f32x2 a = {__uint_as_float(rx[0]), __uint_as_float(ry[0])}, b = {__uint_as_float(rx[1]), __uint_as_float(ry[1])};
        p[16 * hi + j] = a + b * sg; }
}
__device__ __forceinline__ void fft_inv1(f32x2 (&x)[16], const LAS f32x2* B, int n2, const f32x2 (&w)[16]) {
    asm volatile("" : "+v"(n2));
    x[0] = B[fpad(n2)];
#pragma unroll
    for (int k = 1; k < 16; ++k) x[k] = cmulc(B[fpad(512 * k + n2)], w[k]);
    dft16_inv_lo(x);
}
#define WG_SYNC() do { asm volatile("s_waitcnt lgkmcnt(0)" ::: "memory"); __builtin_amdgcn_s_barrier(); asm volatile("" ::: "memory"); } while (0)
__device__ __forceinline__ void hy_stage(LAS float* plane, const bf16_t* PHY, int cg, int jc, int tid) {
    asm volatile("" : "+v"(tid));
    const u32x4* src = (const u32x4*)(PHY + (size_t)cg * MT * 4);
#pragma unroll
    for (int k = 0; k < 8; ++k) { const int i = tid + 512 * k; const u32x4 v = src[i];
        const unsigned w0 = (jc & 2) ? v.y : v.x, w1 = (jc & 2) ? v.w : v.z;
        f32x2 o; o.x = (jc & 1) ? bf_hi(w0) : bf_lo(w0); o.y = (jc & 1) ? bf_hi(w1) : bf_lo(w1);
        *(LAS f32x2*)(plane + 2 * i) = o; }
}
__device__ __forceinline__ void hy_sconv(const LAS float* plane, float w0, float w1, float w2, float cb, int n2, float (&u)[8][2]) {
    asm volatile("" : "+v"(n2));
#pragma unroll
    for (int r = 0; r < 8; ++r)
#pragma unroll
        for (int b = 0; b < 2; ++b) { const int t = n2 + 512 * r, row = b * SEQ + t;
            float a = cb + w1 * plane[row];
            if (t > 0) a += w0 * plane[row - 1];
            if (t < SEQ - 1) a += w2 * plane[row + 1];
            u[r][b] = a; }
}
#define WAVE_FENCE() do { asm volatile("s_waitcnt lgkmcnt(0)" ::: "memory"); __builtin_amdgcn_sched_barrier(0); } while (0)
constexpr int HY_TW2 = RING_BYTES + 1024;
__device__ __forceinline__ void hyena_fft(LAS unsigned char* lds, int layer, int G, const int wave_s) {
    FRESH_IDS; FRESH_KP;
    unsigned char* ws = Pp->ws;
    const bf16_t* PHY = (const bf16_t*)(ws + WS_PHY); float* ZT = (float*)(ws + WS_SSHY);
    const unsigned* TF = (const unsigned*)(ws + WS_FLT) + (size_t)layer * HY * SEQ; const unsigned* TB = (const unsigned*)(ws + WS_FLT) + (size_t)(DEPTH + layer) * HY * SEQ;
    const float* cw = Pp->in[9] + (size_t)layer * 3 * 3 * HY; const float* cb = Pp->in[10] + (size_t)layer * 3 * HY; const float* fbias = Pp->in[17] + (size_t)layer * 2 * HY;
    LAS f32x2* Db = (LAS f32x2*)lds; LAS f32x2* Fb = Db + FPAD; LAS f32x2* TW2 = (LAS f32x2*)(lds + HY_TW2);
    LAS float* pl0 = (LAS float*)lds; LAS float* pl1 = pl0 + 2 * SEQ;
    const int n2 = tid;
    TW2[tid] = tw_base((float)((tid & 31) * (tid >> 5)) * (1.0f / 512.f));
    f32x2 w1p[16]; tw_powers(tw_base((float)n2 * (1.0f / 8192.f)), w1p); w1p[0] = (f32x2){1.f, 0.f};
    for (int unit = blockIdx.x; unit < HY / 4; unit += G) {
#pragma nounroll
        for (int jc = 0; jc < 4; ++jc) { const int c = 4 * unit + jc;
            WG_SYNC();
            { f32x2 x[16]; const unsigned* tf = TF + (size_t)c * SEQ; const unsigned* tb = TB + (size_t)c * SEQ;
#pragma unroll
              for (int r = 0; r < 8; ++r) { const unsigned w = tf[n2 + 512 * r]; x[r] = (f32x2){bf_lo(w), bf_hi(w)}; }
#pragma unroll
              for (int r = 8; r < 16; ++r) { const int l = FN - 512 * r - n2; const unsigned w = l < SEQ ? tb[l] : 0u; x[r] = (f32x2){bf_lo(w), bf_hi(w)}; }
              __builtin_amdgcn_sched_barrier(0); fft_fwd1<false>(x, Fb, n2, w1p); __builtin_amdgcn_sched_barrier(0); }
            hy_stage(pl0, PHY, 2 * (HY / 4) + unit, jc, tid); __builtin_amdgcn_sched_barrier(0); hy_stage(pl1, PHY, unit, jc, tid); __builtin_amdgcn_sched_barrier(0);
            WG_SYNC();
            float uz[8][2], ux[8][2];
            hy_sconv(pl0, cw[2 * HY + c], cw[3 * HY + 2 * HY + c], cw[6 * HY + 2 * HY + c], cb[2 * HY + c], n2, uz);
            __builtin_amdgcn_sched_barrier(0); hy_sconv(pl1, cw[c], cw[3 * HY + c], cw[6 * HY + c], cb[c], n2, ux); __builtin_amdgcn_sched_barrier(0);
            fft_fwd2(Fb, TW2, tid); WAVE_FENCE(); fft_pair32<2>(Fb, Fb, wave, lane); __builtin_amdgcn_sched_barrier(0);
            WG_SYNC();
            f32x2 x[16];
#pragma unroll
            for (int r = 0; r < 8; ++r) { x[r] = (f32x2){uz[r][0], uz[r][1]}; x[r + 8] = (f32x2){0.f, 0.f}; }
            fft_fwd1<true>(x, Db, n2, w1p); WG_SYNC();
            fft_fwd2(Db, TW2, tid); WAVE_FENCE(); fft_pair32<0>(Db, Fb, wave, lane); WAVE_FENCE(); fft_inv2(Db, TW2, tid);
            WG_SYNC(); fft_inv1(x, Db, n2, w1p);
            { const float fb0 = fbias[c];
#pragma unroll
              for (int r = 0; r < 8; ++r) { uz[r][0] = ux[r][0] * (x[r].x + fb0 * uz[r][0]); uz[r][1] = ux[r][1] * (x[r].y + fb0 * uz[r][1]); } }
            WG_SYNC();
            hy_stage(pl0, PHY, (HY / 4) + unit, jc, tid);
            WG_SYNC();
            hy_sconv(pl0, cw[HY + c], cw[3 * HY + HY + c], cw[6 * HY + HY + c], cb[HY + c], n2, ux);
            WG_SYNC();
#pragma unroll
            for (int r = 0; r < 8; ++r) { x[r] = (f32x2){uz[r][0], uz[r][1]}; x[r + 8] = (f32x2){0.f, 0.f}; }
            fft_fwd1<true>(x, Db, n2, w1p); WG_SYNC();
            fft_fwd2(Db, TW2, tid); WAVE_FENCE(); fft_pair32<1>(Db, Fb, wave, lane); WAVE_FENCE(); fft_inv2(Db, TW2, tid);
            WG_SYNC(); fft_inv1(x, Db, n2, w1p);
            { const float fb1 = fbias[HY + c]; float* zo = ZT + (size_t)c * MT;
#pragma unroll
              for (int r = 0; r < 8; ++r) { const int t = n2 + 512 * r;
                  zo[t] = ux[r][0] * (x[r].x + fb1 * uz[r][0]); zo[SEQ + t] = ux[r][1] * (x[r].y + fb1 * uz[r][1]); } }
        }
    }
    WG_SYNC();
}

using f32x16 = __attribute__((ext_vector_type(16))) float;
using s16x4 = __attribute__((ext_vector_type(4))) short;
using bf16x8 = pg8::bf16x8;
#define AT_KSWZ(row, colB) ((row) * 256 + ((colB) ^ (((row) & 7) << 4)))
__device__ __forceinline__ int crow(int r, int hi) { return (r & 3) + 8 * (r >> 2) + 4 * hi; }
__device__ __forceinline__ unsigned cvtpk(float lo, float hi) { unsigned r; asm volatile("v_cvt_pk_bf16_f32 %0, %1, %2" : "=v"(r) : "v"(lo), "v"(hi)); return r; }
__device__ __forceinline__ int v_st(int k, int c) { const int kk = (k & ~0xC) | ((k & 4) << 1) | ((k & 8) >> 1); return ((kk >> 3) * 4 + (c >> 5)) * 512 + ((kk & 7) * 32 + (c & 31)) * 2; }
__device__ __forceinline__ int v_rd_base(int lane) { return ((lane & 3) << 3) | (((lane >> 2) & 3) << 6) | (((lane >> 4) & 1) << 5) | (((lane >> 5) & 1) << 8); }
constexpr int v_rd_off(int d0, int ks, int half) { return d0 * 512 + ks * 4096 + half * 2048; }
template <int OFF> __device__ __forceinline__ s16x4 tr_read(int vb) { s16x4 r; asm volatile("ds_read_b64_tr_b16 %0, %1 offset:%2" : "=&v"(r) : "v"(vb), "i"(OFF) : "memory"); return r; }
template <int D0> __device__ __forceinline__ void pv_one(f32x16& od, int vb, bf16x8 pa0, bf16x8 pa1) {
    const s16x4 l0 = tr_read<v_rd_off(D0, 0, 0)>(vb), h0 = tr_read<v_rd_off(D0, 0, 1)>(vb), l1 = tr_read<v_rd_off(D0, 1, 0)>(vb), h1 = tr_read<v_rd_off(D0, 1, 1)>(vb);
    asm volatile("s_waitcnt lgkmcnt(0)" ::: "memory"); __builtin_amdgcn_sched_barrier(0);
#define AT_PK(L, H) (bf16x8){L[0], L[1], L[2], L[3], H[0], H[1], H[2], H[3]}
    od = __builtin_amdgcn_mfma_f32_32x32x16_bf16(pa0, AT_PK(l0, h0), od, 0, 0, 0);
    od = __builtin_amdgcn_mfma_f32_32x32x16_bf16(pa1, AT_PK(l1, h1), od, 0, 0, 0);
#undef AT_PK
}
template <int D0> __device__ __forceinline__ void pv_one4(f32x16& od, int vb, bf16x8 pa0, bf16x8 pa1, bf16x8 pa2, bf16x8 pa3) {
    const s16x4 l0 = tr_read<v_rd_off(D0, 0, 0)>(vb), h0 = tr_read<v_rd_off(D0, 0, 1)>(vb), l1 = tr_read<v_rd_off(D0, 1, 0)>(vb), h1 = tr_read<v_rd_off(D0, 1, 1)>(vb);
    const s16x4 l2 = tr_read<v_rd_off(D0, 2, 0)>(vb), h2 = tr_read<v_rd_off(D0, 2, 1)>(vb), l3 = tr_read<v_rd_off(D0, 3, 0)>(vb), h3 = tr_read<v_rd_off(D0, 3, 1)>(vb);
    asm volatile("s_waitcnt lgkmcnt(0)" ::: "memory"); __builtin_amdgcn_sched_barrier(0);
#define AT_PK(L, H) (bf16x8){L[0], L[1], L[2], L[3], H[0], H[1], H[2], H[3]}
    od = __builtin_amdgcn_mfma_f32_32x32x16_bf16(pa0, AT_PK(l0, h0), od, 0, 0, 0);
    od = __builtin_amdgcn_mfma_f32_32x32x16_bf16(pa1, AT_PK(l1, h1), od, 0, 0, 0);
    od = __builtin_amdgcn_mfma_f32_32x32x16_bf16(pa2, AT_PK(l2, h2), od, 0, 0, 0);
    od = __builtin_amdgcn_mfma_f32_32x32x16_bf16(pa3, AT_PK(l3, h3), od, 0, 0, 0);
#undef AT_PK
}
constexpr int AT_BUF = 65536;
constexpr int AT_SCR = 2 * AT_BUF;
constexpr int AT_XA = AT_SCR + 2048;
constexpr int AT_XH = AT_XA + 1024;
constexpr int AT_OST = 0;
__device__ __forceinline__ void attn_mfma(LAS unsigned char* lds, int layer, int G, const int wave_s) {
    FRESH_IDS; FRESH_KP;
    unsigned char* ws = Pp->ws;
    const bf16_t* Q = (const bf16_t*)(ws + WS_Q); const bf16_t* Kb = (const bf16_t*)(ws + WS_K); const bf16_t* Vb = (const bf16_t*)(ws + WS_V);
    bf16_t* YM = (bf16_t*)(ws + WS_YM); const float* ZT = (const float*)(ws + WS_SSHY);
    const float* gat = Pp->in[20] + layer * ATTW; const float* ghy = Pp->in[19] + layer * HY;
    const int r32 = lane & 31, hi = lane >> 5, h = wave, kv = h >> 2;
    const float sk = Pp->in[18][layer * NH + h] * LOG2E;
    const unsigned lbase = (unsigned)(uintptr_t)lds;
    LAS float* al_l = (LAS float*)(lds + AT_SCR) + wave * 64; LAS float* li_l = al_l + 32;
    LAS float* xa = (LAS float*)(lds + AT_XA); LAS float* xh = (LAS float*)(lds + AT_XH);
    const int nunits = layer == DEPTH - 1 ? ML / 32 : MT / 32;
    for (int unit = blockIdx.x; unit < nunits; unit += G) {
        const bool isc = unit >= ML / 32;
        int b, q0, rowbase;
        if (!isc) { b = unit >> 7; q0 = (unit & 127) * 32; rowbase = b * SEQ + q0; } else { const int u = unit - ML / 32; b = u >> 3; q0 = (u & 7) * 32; rowbase = ML + b * CTX + q0; }
        int t_lo = 0, nw = 0;
        if (!isc) { int t_hi = 4; while (q0 - 128 + 64 * t_lo + 63 < 0) ++t_lo; while (q0 - 128 + 64 * t_hi > SEQ - 1) --t_hi; nw = t_hi - t_lo + 1; }
        const int NT = nw + CTX / 64;
        bf16x8 qr[8];
        { int hi_l = hi; asm volatile("" : "+v"(hi_l));
          const bf16_t* qp = Q + (size_t)(rowbase + r32) * ATTW + h * HD + hi_l * 8;
#pragma unroll
          for (int d0 = 0; d0 < 8; ++d0) qr[d0] = *(const bf16x8*)(qp + d0 * 16); }
        float m_reg = sk, l_reg = 1.0f; f32x16 o[4];
#pragma unroll
        for (int d = 0; d < 4; ++d)
#pragma unroll
            for (int r = 0; r < 16; ++r) o[d][r] = 0.f;
        bf16x8 s_k[4], s_v[4];
#define AT_KEY0(i) ((i) < nw ? q0 - 128 + 64 * (t_lo + (i)) : 64 * ((i) - nw))
#define AT_SLOAD(i) do { const bool win_ = (i) < nw; const int k0_ = AT_KEY0(i); int ll_; MK_LANE_ASM(ll_); const int tt_ = wave * 64 + ll_, sr = tt_ >> 4, sc = (tt_ & 15) * 8; \
        _Pragma("unroll") for (int hf_ = 0; hf_ < 2; ++hf_) { int kk_ = k0_ + sr + 32 * hf_; if (win_) kk_ = kk_ < 0 ? 0 : (kk_ > SEQ - 1 ? SEQ - 1 : kk_); \
            const size_t kr_ = (size_t)((win_ ? b * SEQ : ML + b * CTX) + kk_) * KVW + sc; \
            s_k[hf_] = *(const bf16x8*)(Kb + kr_); s_k[2 + hf_] = *(const bf16x8*)(Kb + kr_ + HD); s_v[hf_] = *(const bf16x8*)(Vb + kr_); s_v[2 + hf_] = *(const bf16x8*)(Vb + kr_ + HD); } } while (0)
#define AT_SWRITE(bf) do { LAS unsigned char* sb_ = lds + (bf) * AT_BUF; int ll_; MK_LANE_ASM(ll_); const int tt_ = wave * 64 + ll_, sr_ = tt_ >> 4, sc_ = (tt_ & 15) * 8, vst = v_st(sr_, sc_), kst = AT_KSWZ(sr_, sc_ * 2); \
        _Pragma("unroll") for (int hf_ = 0; hf_ < 2; ++hf_) { *(LAS bf16x8*)(sb_ + kst + hf_ * 8192) = s_k[hf_]; *(LAS bf16x8*)(sb_ + 16384 + kst + hf_ * 8192) = s_k[2 + hf_]; \
            *(LAS bf16x8*)(sb_ + 32768 + vst + hf_ * 8192) = s_v[hf_]; *(LAS bf16x8*)(sb_ + 49152 + vst + hf_ * 8192) = s_v[2 + hf_]; } } while (0)
        __syncthreads();
        { volatile LAS unsigned* MISC = (volatile LAS unsigned*)(lds + MISC_OFF); TS_MARK(0, MK_TS == 50 && layer == MK_TSL && unit < 256); }
        AT_SLOAD(0); AT_SWRITE(0);
        __syncthreads();
#pragma nounroll
        for (int i = 0; i < NT; ++i) {
            const int bf = i & 1;
            f32x16 p0, p1;
#pragma unroll
            for (int r = 0; r < 16; ++r) { p0[r] = 0.f; p1[r] = 0.f; }
            { const LAS unsigned char* Ks = lds + bf * AT_BUF + kv * 16384;
#pragma unroll
              for (int d0 = 0; d0 < 8; ++d0) { const int cb = (d0 * 16 + hi * 8) * 2;
                  const bf16x8 k0f = *(const LAS bf16x8*)(Ks + AT_KSWZ(r32, cb)), k1f = *(const LAS bf16x8*)(Ks + AT_KSWZ(32 + r32, cb));
                  p0 = __builtin_amdgcn_mfma_f32_32x32x16_bf16(k0f, qr[d0], p0, 0, 0, 0);
                  p1 = __builtin_amdgcn_mfma_f32_32x32x16_bf16(k1f, qr[d0], p1, 0, 0, 0); } }
            if (i < nw) { const int kb = AT_KEY0(i) + 4 * hi - (q0 + r32);
#pragma unroll
                for (int r = 0; r < 16; ++r) { const int d = kb + (r & 3) + 8 * (r >> 2), kk = d + q0 + r32;
                    if (d < -WINDOW || d > WINDOW || kk < 0) p0[r] = -1.0e30f;
                    if (d + 32 < -WINDOW || d + 32 > WINDOW || kk + 32 > SEQ - 1 || kk + 32 < 0) p1[r] = -1.0e30f;
                    if (kk > SEQ - 1) p0[r] = -1.0e30f; } }
            float pmax = fmaxf(p0[0], p1[0]);
#pragma unroll
            for (int r = 1; r < 16; ++r) pmax = fmaxf(pmax, fmaxf(p0[r], p1[r]));
            { auto rr = __builtin_amdgcn_permlane32_swap(__float_as_uint(pmax), __float_as_uint(pmax), false, false); pmax = fmaxf(__uint_as_float(rr[0]), __uint_as_float(rr[1])); }
            const float mn = fmaxf(m_reg, pmax), alpha = __builtin_amdgcn_exp2f(m_reg - mn); m_reg = mn;
            float ps = 0.f;
#pragma unroll
            for (int r = 0; r < 16; ++r) { p0[r] = __builtin_amdgcn_exp2f(p0[r] - mn); p1[r] = __builtin_amdgcn_exp2f(p1[r] - mn); ps += p0[r] + p1[r]; }
            { auto rr = __builtin_amdgcn_permlane32_swap(__float_as_uint(ps), __float_as_uint(ps), false, false); ps = __uint_as_float(rr[0]) + __uint_as_float(rr[1]); }
            l_reg = l_reg * alpha + ps;
            if (__any(alpha < 1.f)) { if (hi == 0) al_l[r32] = alpha; asm volatile("s_waitcnt lgkmcnt(0)" ::: "memory");
#pragma unroll
                for (int d = 0; d < 4; ++d)
#pragma unroll
                    for (int r = 0; r < 16; ++r) o[d][r] *= al_l[crow(r, hi)]; }
            bf16x8 pa0, pa1, pa2, pa3;
#define AT_PK4(P, BASE, OUT) do { unsigned a0 = cvtpk(P[BASE + 0], P[BASE + 1]), a1 = cvtpk(P[BASE + 2], P[BASE + 3]); unsigned b0 = cvtpk(P[BASE + 4], P[BASE + 5]), b1 = cvtpk(P[BASE + 6], P[BASE + 7]); \
    auto r0 = __builtin_amdgcn_permlane32_swap(a0, b0, false, false); auto r1 = __builtin_amdgcn_permlane32_swap(a1, b1, false, false); u32x4 w = {r0[0], r1[0], r0[1], r1[1]}; OUT = *reinterpret_cast<bf16x8*>(&w); } while (0)
            AT_PK4(p0, 0, pa0); AT_PK4(p0, 8, pa1); AT_PK4(p1, 0, pa2); AT_PK4(p1, 8, pa3);
#undef AT_PK4
            if (i + 1 < NT) AT_SLOAD(i + 1);
            { const int vb = (int)(lbase + bf * AT_BUF + 32768 + kv * 16384) + v_rd_base(lane);
              pv_one4<0>(o[0], vb, pa0, pa1, pa2, pa3); pv_one4<1>(o[1], vb, pa0, pa1, pa2, pa3); pv_one4<2>(o[2], vb, pa0, pa1, pa2, pa3); pv_one4<3>(o[3], vb, pa0, pa1, pa2, pa3); }
            if (i + 1 < NT) AT_SWRITE(bf ^ 1);
            __syncthreads();
        }
#undef AT_SLOAD
#undef AT_SWRITE
#undef AT_KEY0
        { volatile LAS unsigned* MISC = (volatile LAS unsigned*)(lds + MISC_OFF); TS_MARK(1, MK_TS == 50 && layer == MK_TSL && unit < 256); TS_MARK(0, MK_TS == 51 && layer == MK_TSL && unit < 256); TS_MARK(0, MK_TS == 52 && layer == MK_TSL && unit < 256); }
        if (hi == 0) li_l[r32] = l_reg; asm volatile("s_waitcnt lgkmcnt(0)" ::: "memory");
        float part[16];
#pragma unroll
        for (int r = 0; r < 16; ++r) { const float rl = __builtin_amdgcn_rcpf(li_l[crow(r, hi)]); float s = 0.f;
#pragma unroll
            for (int d = 0; d < 4; ++d) { o[d][r] *= rl; s += o[d][r] * o[d][r]; }
#pragma unroll
            for (int m = 1; m < 32; m <<= 1) s += __shfl_xor(s, m);
            part[r] = s; }
        if (r32 == 0) {
#pragma unroll
            for (int r = 0; r < 16; ++r) xa[wave * 32 + crow(r, hi)] = part[r]; }
        f32x4 zb[2][8]; float sh4[4] = {0.f, 0.f, 0.f, 0.f};
        const int rg = lane & 7, cbl = lane >> 3;
#pragma unroll
        for (int it = 0; it < 2; ++it) { const int c0 = (it * 64 + wave * 8 + cbl) * 8; const float* zp = ZT + (size_t)c0 * MT + rowbase + 4 * rg;
#pragma unroll
            for (int k = 0; k < 8; ++k) zb[it][k] = *(const f32x4*)(zp + (size_t)k * MT); }
#pragma unroll
        for (int it = 0; it < 2; ++it)
#pragma unroll
            for (int k = 0; k < 8; ++k)
#pragma unroll
                for (int i = 0; i < 4; ++i) sh4[i] += zb[it][k][i] * zb[it][k][i];
#pragma unroll
        for (int i = 0; i < 4; ++i) { float s = sh4[i]; s += __shfl_xor(s, 8); s += __shfl_xor(s, 16); s += __shfl_xor(s, 32); if (lane < 8) xh[wave * 32 + 4 * rg + i] = s; }
        __syncthreads();
        { volatile LAS unsigned* MISC = (volatile LAS unsigned*)(lds + MISC_OFF); TS_MARK(1, MK_TS == 52 && layer == MK_TSL && unit < 256); TS_MARK(0, MK_TS == 53 && layer == MK_TSL && unit < 256); }
        float ta = 0.f;
#pragma unroll
        for (int w = 0; w < 8; ++w) ta += xa[w * 32 + r32];
        const float ra = 1.0f / sqrtf(ta * (1.0f / ATTW) + EPS);
        float rh4[4];
#pragma unroll
        for (int i = 0; i < 4; ++i) { float th = 0.f;
#pragma unroll
            for (int w = 0; w < 8; ++w) th += xh[w * 32 + 4 * rg + i];
            rh4[i] = 1.0f / sqrtf(th * (1.0f / HY) + EPS); }
#pragma unroll
        for (int it = 0; it < 2; ++it) { const int c0 = (it * 64 + wave * 8 + cbl) * 8; const f32x4 g0 = *(const f32x4*)(ghy + c0), g1 = *(const f32x4*)(ghy + c0 + 4);
#pragma unroll
            for (int i = 0; i < 4; ++i) { const float r = rh4[i];
                u32x4 w; w.x = pk2(zb[it][0][i] * r * g0[0], zb[it][1][i] * r * g0[1]); w.y = pk2(zb[it][2][i] * r * g0[2], zb[it][3][i] * r * g0[3]);
                w.z = pk2(zb[it][4][i] * r * g1[0], zb[it][5][i] * r * g1[1]); w.w = pk2(zb[it][6][i] * r * g1[2], zb[it][7][i] * r * g1[3]);
                *(u32x4*)(YM + (size_t)(rowbase + 4 * rg + i) * D + c0) = w; } }
        { volatile LAS unsigned* MISC = (volatile LAS unsigned*)(lds + MISC_OFF); if (MK_TS == 53) asm volatile("s_waitcnt vmcnt(0)" ::: "memory"); TS_MARK(1, MK_TS == 53 && layer == MK_TSL && unit < 256); }
        if (hi == 0) al_l[r32] = ra; asm volatile("s_waitcnt lgkmcnt(0)" ::: "memory");
        { LAS unsigned char* ost = lds + AT_OST + wave * (32 * 272);
          float gc[4];
#pragma unroll
          for (int d = 0; d < 4; ++d) gc[d] = gat[h * HD + 32 * d + r32];
#pragma unroll
          for (int r = 0; r < 16; ++r) { const int q = crow(r, hi); const float rq = al_l[q];
#pragma unroll
              for (int d = 0; d < 4; ++d) *(LAS bf16_t*)(ost + q * 272 + (32 * d + r32) * 2) = (bf16_t)f2bf(o[d][r] * rq * gc[d]); }
          asm volatile("s_waitcnt lgkmcnt(0)" ::: "memory");
#pragma unroll
          for (int k = 0; k < 8; ++k) { const int q = k * 4 + (lane >> 4), ch = lane & 15;
              const u32x4 v = *(const LAS u32x4*)(ost + q * 272 + ch * 16);
              *(u32x4*)(YM + (size_t)(rowbase + q) * D + HY + h * HD + ch * 8) = v; } }
        { volatile LAS unsigned* MISC = (volatile LAS unsigned*)(lds + MISC_OFF); TS_MARK(1, MK_TS == 51 && layer == MK_TSL && unit < 256); }
    }
    __syncthreads();
}


template <int K>
__device__ __forceinline__ void ctx_small_gemm(LAS unsigned char* lds, const bf16_t* A, int lda, const bf16_t* Bt, int ldb, const float* Xin, bf16_t* X, const float* gate, const float* gnext, bf16_t* AN, float* ssqc, int G, const int wave_s, const int live = 1) {
    FRESH_IDS;
    typedef float f32x16_ __attribute__((ext_vector_type(16)));
    constexpr int KW = K / 8, NST = KW / 32;
    static_assert(KW % 32 == 0 && NST >= 2, "per-wave K slice in 32-deep steps");
    const int r32 = lane & 31, hi = lane >> 5;
    LAS unsigned char* wl = lds + wave * 16384;
    LAS float* rsum = (LAS float*)(lds + RING_BYTES + 5120);
    for (int tile = blockIdx.x; tile < (MC / 64) * (D / 64); tile += G) {
        const int rb = tile >> 5, cb = 4 * (tile & 7) + ((tile >> 3) & 3);
        const char* asrc[4]; const char* bsrc[4];
#pragma unroll
        for (int i = 0; i < 4; ++i) { const int vr = 4 * i + (lane >> 4), s = (lane & 15) ^ (vr & 7), row = 4 * vr + (s >> 2), ko = 8 * (s & 3);
            asrc[i] = (const char*)(A + (size_t)(rb * 64 + row) * lda + wave * KW + ko); bsrc[i] = (const char*)(Bt + (size_t)(cb * 64 + row) * ldb + wave * KW + ko); }
#define CS_ISSUE(st) do { LAS unsigned char* sl_ = wl + ((st) & 1) * 8192; _Pragma("unroll") for (int i_ = 0; i_ < 4; ++i_) { \
        __builtin_amdgcn_global_load_lds((const unsigned*)(asrc[i_] + (size_t)(st) * 64), (LAS unsigned*)(sl_ + i_ * 1024), 16, 0, 0); \
        __builtin_amdgcn_global_load_lds((const unsigned*)(bsrc[i_] + (size_t)(st) * 64), (LAS unsigned*)(sl_ + 4096 + i_ * 1024), 16, 0, 0); } } while (0)
        int foff[2][2];
#pragma unroll
        for (int blk = 0; blk < 2; ++blk)
#pragma unroll
            for (int ks = 0; ks < 2; ++ks) { const int row = 32 * blk + r32, vr = row >> 2; foff[blk][ks] = vr * 256 + ((((row & 3) * 4 + 2 * ks + hi) ^ (vr & 7)) << 4); }
        __syncthreads();
        f32x16_ acc[2][2];
#pragma unroll
        for (int i = 0; i < 2; ++i)
#pragma unroll
            for (int j = 0; j < 2; ++j)
#pragma unroll
                for (int q = 0; q < 16; ++q) acc[i][j][q] = 0.f;
        CS_ISSUE(0);
#pragma nounroll
        for (int st = 0; st < NST; ++st) {
            if (st + 1 < NST) { CS_ISSUE(st + 1); asm volatile("s_waitcnt vmcnt(8)" ::: "memory"); } else asm volatile("s_waitcnt vmcnt(0)" ::: "memory");
            const LAS unsigned char* sl = wl + (st & 1) * 8192;
            pg8::bf16x8 a[2][2], b[2][2];
#pragma unroll
            for (int blk = 0; blk < 2; ++blk)
#pragma unroll
                for (int ks = 0; ks < 2; ++ks) { a[blk][ks] = *(const LAS pg8::bf16x8*)(sl + foff[blk][ks]); b[blk][ks] = *(const LAS pg8::bf16x8*)(sl + 4096 + foff[blk][ks]); }
#pragma unroll
            for (int ks = 0; ks < 2; ++ks)
#pragma unroll
                for (int i = 0; i < 2; ++i)
#pragma unroll
                    for (int j = 0; j < 2; ++j) acc[i][j] = __builtin_amdgcn_mfma_f32_32x32x16_bf16(a[i][ks], b[j][ks], acc[i][j], 0, 0, 0);
            asm volatile("s_waitcnt lgkmcnt(0)" ::: "memory");
        }
#undef CS_ISSUE
        LAS float* red = (LAS float*)lds;
#pragma unroll
        for (int i = 0; i < 2; ++i)
#pragma unroll
            for (int j = 0; j < 2; ++j)
#pragma unroll
                for (int q = 0; q < 16; ++q) red[(wave * 64 + (i * 2 + j) * 16 + q) * 64 + lane] = acc[i][j][q];
        __syncthreads();
        { const int bi = wave >> 2, bj = (wave >> 1) & 1, qh = wave & 1;
          const int col = cb * 64 + bj * 32 + r32; const float gt = gate[col], gn = gnext ? gnext[col] : 0.f;
#pragma unroll
          for (int qq = 0; qq < 8; ++qq) { const int q = qh * 8 + qq; float v = 0.f;
#pragma unroll
              for (int w = 0; w < 8; ++w) v += red[(w * 64 + (bi * 2 + bj) * 16 + q) * 64 + lane];
              const int rloc = bi * 32 + (q & 3) + 8 * (q >> 2) + 4 * hi, row = rb * 64 + rloc;
              const float x = (Xin ? Xin[(size_t)row * D + col] : bf1(X[(size_t)row * D + col])) + gt * v;
              if (live) X[(size_t)row * D + col] = (bf16_t)f2bf(x);
              if (gnext && live) AN[(size_t)row * D + col] = (bf16_t)f2bf(x * gn);
              float s = x * x;
#pragma unroll
              for (int m = 1; m < 32; m <<= 1) s += __shfl_xor(s, m);
              if (r32 == 0) rsum[bj * 64 + rloc] = s; } }
        __syncthreads();
        if (wave == 0 && live) ssqc[(size_t)cb * MC + rb * 64 + lane] = rsum[lane] + rsum[64 + lane];
    }
    __syncthreads();
}

__device__ __forceinline__ void final_norm(int G, const int wave_s) {
    FRESH_IDS; FRESH_KP;
    unsigned char* ws = Pp->ws; const int gw = blockIdx.x * NWAVES + wave, NGW = G * NWAVES;
    const bf16_t* X = (const bf16_t*)(ws + WS_X); const float* SSQ = (const float*)(ws + WS_SSQ); const float* g = Pp->in[25];
    for (int row = gw; row < ML; row += NGW) {
        const float s = wave_sum(lane < 32 ? SSQ[((size_t)(lane >> 2) * MT + row) * 4 + (lane & 3)] : 0.f);
        const float r = 1.0f / sqrtf(s * (1.0f / D) + EPS);
#pragma unroll
        for (int j = 0; j < 4; ++j) { const int c = lane * 8 + 512 * j; const u32x4 xw = *(const u32x4*)(X + (size_t)row * D + c);
            const f32x4 g0 = *(const f32x4*)(g + c), g1 = *(const f32x4*)(g + c + 4);
            *(f32x4*)(Pp->out + (size_t)row * D + c) = (f32x4){bf_lo(xw.x), bf_hi(xw.x), bf_lo(xw.y), bf_hi(xw.y)} * r * g0;
            *(f32x4*)(Pp->out + (size_t)row * D + c + 4) = (f32x4){bf_lo(xw.z), bf_hi(xw.z), bf_lo(xw.w), bf_hi(xw.w)} * r * g1; }
    }
}

#ifndef MK_REP
#define MK_REP -1
#endif
#define REP(k) _Pragma("unroll") for (int rep_ = 0; rep_ < (MK_REP == (k) ? 2 : 1); ++rep_)
constexpr int NPHASE = 3 + 6 * DEPTH + 1;
__global__ void __launch_bounds__(NTHR, 2) mk_fwd(Params P) {
    extern __shared__ __attribute__((aligned(16))) unsigned char lds_raw[];
    LAS unsigned char* lds = (LAS unsigned char*)lds_raw;
    const int tid = threadIdx.x, G = gridDim.x, wave_s = __builtin_amdgcn_readfirstlane(tid >> 6);
    unsigned char* ws; int lo, hi; { FRESH_KP; ws = Pp->ws; lo = Pp->ph_lo; hi = Pp->ph_hi; }
    volatile LAS unsigned* MISC = (volatile LAS unsigned*)(lds + MISC_OFF);
    for (int u = tid; u < (LDS_BYTES - RING_BYTES) / 4; u += NTHR) ((LAS unsigned*)(lds + RING_BYTES))[u] = 0u;
    __syncthreads();
    XcdBarrier bar = xcd_barrier_post((unsigned*)(ws + WS_CTL) + CW_BAR, MISC + 8);
#define IN(k) (lo <= (k) && (k) < hi)
#define SEAM(k) do { if (IN(k) && IN((k) + 1)) xcd_barrier(bar, wave_s); } while (0)

    TS_MARK(0, MK_TS == 10); if (IN(0)) { REP(100) p0a(lds, G, wave_s); } SEAM(0); TS_MARK(1, MK_TS == 10); TS_MARK(0, MK_TS == 11);
    if (IN(1)) { p0b(G, wave_s); } SEAM(1); TS_MARK(1, MK_TS == 11); TS_MARK(0, MK_TS == 12);
    if (IN(2)) { REP(102) p0c(lds, G, wave_s); } SEAM(2); TS_MARK(1, MK_TS == 12);

    for (int layer = 0; layer < DEPTH; ++layer) {
        const int pb = 3 + 6 * layer;
        TS_MARK(0, MK_TS == 0 && layer == MK_TSL);
#define WSL FRESH_KP; unsigned char* w = Pp->ws; const float* MODL = (const float*)(w + WS_MOD) + (size_t)layer * 3 * 6 * D; (void)MODL
        if (IN(pb)) {
            WSL;
            pg8::Gemm g{(const bf16_t*)(w + WS_AN), (const bf16_t*)(w + WS_WIN) + (size_t)layer * INW * D, MT, INW_A, D, D, D};
            pg8::StaticOrder S; S.init(MT, INW_A, G, (int)blockIdx.x);
            EpiIn E{(const float*)(w + WS_SSQ), (const float*)(w + WS_SSQC), (const float*)(w + WS_SHWIN) + (size_t)layer * 3 * INW, (bf16_t*)(w + WS_PHY), (bf16_t*)(w + WS_Q), (bf16_t*)(w + WS_K), (bf16_t*)(w + WS_V), (const float*)(w + WS_ROPE), 1, 0};
            if (MK_REP == 8) { EpiIn Ed = E; Ed.live = lo > 1000; pg8::gemm_phase<EpiIn, pg8::StaticOrder, true, true>(lds, g, S, Ed, wave_s); }
            pg8::gemm_phase<EpiIn, pg8::StaticOrder, true, true>(lds, g, S, E, wave_s);
        }
        SEAM(pb); TS_MARK(1, MK_TS == 0 && layer == MK_TSL); TS_MARK(0, MK_TS == 1 && layer == MK_TSL);
        if (IN(pb + 1)) REP(2) {
            if ((int)blockIdx.x < NQKV) { WSL;
                pg8::Gemm g{(const bf16_t*)(w + WS_AN), (const bf16_t*)(w + WS_WIN) + ((size_t)layer * INW + INW_A) * D, MT, INW - INW_A, D, D, D};
                pg8::StaticOrder S; S.init(MT, INW - INW_A, G, (int)blockIdx.x);
                EpiIn E{(const float*)(w + WS_SSQ), (const float*)(w + WS_SSQC), (const float*)(w + WS_SHWIN) + (size_t)layer * 3 * INW, (bf16_t*)(w + WS_PHY), (bf16_t*)(w + WS_Q), (bf16_t*)(w + WS_K), (bf16_t*)(w + WS_V), (const float*)(w + WS_ROPE), 1, INW_A / 256};
                pg8::gemm_phase<EpiIn, pg8::StaticOrder, true, true>(lds, g, S, E, wave_s);
            }
            REP(21) hyena_fft(lds, layer, G, wave_s);
            if (layer != DEPTH - 1 && (int)blockIdx.x >= NQKV) REP(22) hyena_ctx(lds, layer, (int)blockIdx.x - NQKV, G - NQKV, wave_s);
        }
        SEAM(pb + 1); TS_MARK(1, MK_TS == 1 && layer == MK_TSL); TS_MARK(0, MK_TS == 2 && layer == MK_TSL);
        if (IN(pb + 2)) REP(3) {
            attn_mfma(lds, layer, G, wave_s);
            if (layer + 1 < DEPTH && (int)blockIdx.x >= MC / 32) { __syncthreads();
                convert_few(lds, layer + 1, ((int)blockIdx.x - MC / 32) * NWAVES + wave_s, (G - MC / 32) * NWAVES, wave_s, 0, CV_OUTD); }
        }
        SEAM(pb + 2); TS_MARK(1, MK_TS == 2 && layer == MK_TSL); TS_MARK(0, MK_TS == 3 && layer == MK_TSL);
        if (IN(pb + 3)) {
            WSL;
            pg8::Gemm g{(const bf16_t*)(w + WS_YM), (const bf16_t*)(w + WS_WOUT) + (size_t)layer * D * D, ML, D, D, D, D};
            pg8::StaticOrder S; S.init(ML, D, G, (int)blockIdx.x);
            EpiResid E{layer == 0 ? Pp->in[0] : (const float*)nullptr, (const bf16_t*)(w + WS_X), (bf16_t*)(w + WS_X), MODL + 2 * D, (const float*)(w + WS_GMV) + ((size_t)layer * 2 + 1) * 3 * D, (bf16_t*)(w + WS_AN), (float*)(w + WS_SSQ), 1};
            if (MK_REP == 4) { EpiResid Ed = E; Ed.live = lo > 1000; pg8::gemm_phase<EpiResid, pg8::StaticOrder, true, true>(lds, g, S, Ed, wave_s); }
            TS_MARK(0, MK_TS == 42 && layer == MK_TSL);
            pg8::gemm_phase<EpiResid, pg8::StaticOrder, true, true>(lds, g, S, E, wave_s);
            TS_MARK(1, MK_TS == 42 && layer == MK_TSL); TS_MARK(0, MK_TS == 40 && layer == MK_TSL);
            if (layer != DEPTH - 1)
                ctx_small_gemm<D>(lds, (const bf16_t*)(w + WS_YM) + (size_t)ML * D, D, (const bf16_t*)(w + WS_WOUT) + (size_t)layer * D * D, D, layer == 0 ? Pp->in[2] : (const float*)nullptr, (bf16_t*)(w + WS_X) + (size_t)ML * D,
                                  MODL + 2 * D + 2 * 6 * D, (const float*)(w + WS_GMV) + ((size_t)layer * 2 + 1) * 3 * D + 2 * D, (bf16_t*)(w + WS_AN) + (size_t)ML * D, (float*)(w + WS_SSQC), G, wave_s);
            TS_MARK(1, MK_TS == 40 && layer == MK_TSL);
        }
        SEAM(pb + 3); TS_MARK(1, MK_TS == 3 && layer == MK_TSL); TS_MARK(0, MK_TS == 4 && layer == MK_TSL);
        if (IN(pb + 4)) REP(5) {
            WSL;
            const int mrows = layer == DEPTH - 1 ? ML : MT;
            pg8::Gemm g{(const bf16_t*)(w + WS_AN), (const bf16_t*)(w + WS_WGU) + (size_t)layer * GU * D, mrows, GU, D, D, D};
            pg8::StaticOrder S; S.init(mrows, GU, G, (int)blockIdx.x);
            TS_MARK(0, MK_TS == 61 && layer == MK_TSL);
            EpiGU E{(const float*)(w + WS_SSQ), (const float*)(w + WS_SSQC), (const float*)(w + WS_SHWGU) + (size_t)layer * 3 * GU, (bf16_t*)(w + WS_HB), MISC, wave_s, layer == MK_TSL};
            pg8::gemm_phase<EpiGU, pg8::StaticOrder, true, true>(lds, g, S, E, wave_s);
        }
        SEAM(pb + 4); TS_MARK(1, MK_TS == 4 && layer == MK_TSL); TS_MARK(0, MK_TS == 5 && layer == MK_TSL);
        if (IN(pb + 5)) {
            WSL;
            pg8::Gemm g{(const bf16_t*)(w + WS_HB), (const bf16_t*)(w + WS_WD) + (size_t)layer * D * FF, ML, D, FF, FF, FF};
            pg8::StaticOrder S; S.init(ML, D, G, (int)blockIdx.x);
            EpiResid E{(const float*)nullptr, (const bf16_t*)(w + WS_X), (bf16_t*)(w + WS_X), MODL + 5 * D, layer + 1 < DEPTH ? (const float*)(w + WS_GMV) + ((size_t)(layer + 1) * 2 + 0) * 3 * D : nullptr, (bf16_t*)(w + WS_AN), (float*)(w + WS_SSQ), 1};
            if (MK_REP == 6) { EpiResid Ed = E; Ed.live = lo > 1000; pg8::gemm_phase<EpiResid, pg8::StaticOrder, true, true>(lds, g, S, Ed, wave_s); }
            TS_MARK(0, MK_TS == 43 && layer == MK_TSL);
            pg8::gemm_phase<EpiResid, pg8::StaticOrder, true, true>(lds, g, S, E, wave_s);
            TS_MARK(1, MK_TS == 43 && layer == MK_TSL); TS_MARK(0, MK_TS == 41 && layer == MK_TSL);
            if (layer != DEPTH - 1)
                ctx_small_gemm<FF>(lds, (const bf16_t*)(w + WS_HB) + (size_t)ML * FF, FF, (const bf16_t*)(w + WS_WD) + (size_t)layer * D * FF, FF, (const float*)nullptr, (bf16_t*)(w + WS_X) + (size_t)ML * D,
                                   MODL + 5 * D + 2 * 6 * D, (const float*)(w + WS_GMV) + ((size_t)(layer + 1) * 2 + 0) * 3 * D + 2 * D, (bf16_t*)(w + WS_AN) + (size_t)ML * D, (float*)(w + WS_SSQC), G, wave_s);
            TS_MARK(1, MK_TS == 41 && layer == MK_TSL);
            if (MK_REP == 7 && layer != DEPTH - 1)
                ctx_small_gemm<FF>(lds, (const bf16_t*)(w + WS_HB) + (size_t)ML * FF, FF, (const bf16_t*)(w + WS_WD) + (size_t)layer * D * FF, FF, (const float*)nullptr, (bf16_t*)(w + WS_X) + (size_t)ML * D,
                                   MODL + 5 * D + 2 * 6 * D, (const float*)(w + WS_GMV) + ((size_t)(layer + 1) * 2 + 0) * 3 * D + 2 * D, (bf16_t*)(w + WS_AN) + (size_t)ML * D, (float*)(w + WS_SSQC), G, wave_s, lo > 1000);
        }
        SEAM(pb + 5); TS_MARK(1, MK_TS == 5 && layer == MK_TSL); TS_MARK(0, MK_TS == 6 && layer == MK_TSL);
    }
    if (MK_REP == 50) { for (int e_ = 0; e_ < 40; ++e_) xcd_barrier(bar, wave_s); }
    if (IN(NPHASE - 1)) final_norm(G, wave_s);
    if (MK_TS >= 0 && blockIdx.x == MK_TSB && wave_s == 0) {
        const unsigned long long a_ = ((unsigned long long)MISC[17] << 32) | MISC[16], b_ = ((unsigned long long)MISC[19] << 32) | MISC[18], d_ = (b_ - a_) * 8ull;
        const unsigned long long s_ = __builtin_amdgcn_s_memrealtime();
        while (__builtin_amdgcn_s_memrealtime() - s_ < d_ && d_ < 400000000ull) __builtin_amdgcn_s_sleep(8);
    }
#undef IN
#undef SEAM
}
}

#ifndef MK_N_LAUNCHES
#define MK_N_LAUNCHES 1
#endif
extern "C" void kernel_launch(void* const* d_in, const int* in_sizes, int n_in, void* d_out, int out_size, void* d_ws, size_t ws_size, hipStream_t stream) {
    using namespace mk;
    static int grid = 0;
    if (grid == 0) {
        if (n_in != 26 || ws_size < WS_END) { fprintf(stderr, "kernel_launch: need 26 inputs and %zu bytes of workspace (got %d, %zu)\n", (size_t)WS_END, n_in, ws_size); grid = -1; return; }
        int dev = 0, cus = 0, per_cu = 0;
        if (hipGetDevice(&dev) != hipSuccess || hipDeviceGetAttribute(&cus, hipDeviceAttributeMultiprocessorCount, dev) != hipSuccess) { grid = -1; return; }
        if (hipFuncSetAttribute((const void*)mk_fwd, hipFuncAttributeMaxDynamicSharedMemorySize, LDS_BYTES) != hipSuccess) { fprintf(stderr, "kernel_launch: hipFuncSetAttribute failed\n"); grid = -1; return; }
        if (hipOccupancyMaxActiveBlocksPerMultiprocessor(&per_cu, (const void*)mk_fwd, NTHR, LDS_BYTES) != hipSuccess || per_cu < 1) { fprintf(stderr, "kernel_launch: occupancy query says %d\n", per_cu); }
        (void)hipGetLastError();
        grid = cus;
    }
    if (grid < 0) return;
    (void)hipMemsetAsync((char*)d_ws + WS_CTL, 0, CTL_BYTES, stream);
    Params p{};
    for (int i = 0; i < 26; ++i) p.in[i] = (const float*)d_in[i];
    p.out = (float*)d_out; p.ws = (unsigned char*)d_ws;
#if MK_N_LAUNCHES == 1
    p.ph_lo = 0; p.ph_hi = NPHASE;
    hipLaunchKernelGGL(mk_fwd, dim3(grid), dim3(NTHR), LDS_BYTES, stream, p);
#else
    for (int ph = 0; ph < NPHASE; ++ph) { p.ph_lo = ph; p.ph_hi = ph + 1; hipLaunchKernelGGL(mk_fwd, dim3(grid), dim3(NTHR), LDS_BYTES, stream, p); }
#endif
}
```

```cpp
#include <hip/hip_runtime.h>
#include <cstdint>
#include <cstdio>
#define LAS __attribute__((address_space(3)))
#define GAS __attribute__((address_space(1)))
#define MK_LANE_ASM(l) asm volatile("v_mbcnt_lo_u32_b32 %0, -1, 0\n\tv_mbcnt_hi_u32_b32 %0, -1, %0" : "=v"(l))
namespace pg8 {
#define PG8_LAS __attribute__((address_space(3)))
typedef unsigned short bf16_t;
typedef short bf16x8 __attribute__((ext_vector_type(8)));
typedef float f32x4 __attribute__((ext_vector_type(4)));
typedef unsigned u32x4 __attribute__((ext_vector_type(4)));
constexpr int BM = 256, BK = 64, HALF = 128, HTB = HALF * BK * 2  , STAGE_BYTES = 8 * HTB, NXCD = 8, WGM = 8;

__host__ __device__ __forceinline__ int lds_byte(int r, int c) { const int st = (r >> 4) * 2 + (c >> 5), rr = r & 15, cc = c & 31, ob = rr * 64 + cc * 2; return st * 1024 + (ob ^ (((ob >> 9) & 1) << 5)); }
__host__ __device__ __forceinline__ void stage_rc(int b, int& R, int& C) { const int st = b / 1024, sb = b % 1024, swz = sb ^ (((sb >> 9) & 1) << 5); R = (st >> 1) * 16 + swz / 64; C = (st & 1) * 32 + (swz % 64) / 2; }
__host__ __device__ __forceinline__ int perm32(int rho) { const int n = rho >> 4, i = rho & 15; return 8 * (i >> 2) + 4 * n + (i & 3); }

struct Unit { int pm, pn; };
struct Gemm { const bf16_t* A; const bf16_t* Bt; int M, N, K, lda, ldb; };

struct StaticOrder {
    int nM, nN, nwg, G, c;
    __host__ __device__ void init(int M, int N, int G_, int c_) { nM = M / BM; nN = N / BM; nwg = nM * nN; G = G_; c = c_; }
    __host__ __device__ bool next(int i, Unit& u) const {
        const long L = (long)i * G + c; if (L >= nwg) return false;
        int wgid = (int)L; { const int q = nwg / NXCD, r = nwg % NXCD, xcd = wgid % NXCD, off = wgid / NXCD; wgid = (xcd < r ? xcd * (q + 1) : r * (q + 1) + (xcd - r) * q) + off; }
        const int nig = WGM * nN, gid = wgid / nig, fm = gid * WGM, gsz = (nM - fm) < WGM ? (nM - fm) : WGM;
        u.pm = fm + ((wgid % nig) % gsz); u.pn = (wgid % nig) / gsz; return true;
    }
    __device__ __forceinline__ void a_ready(const Unit&) const {}
    __device__ __forceinline__ void done(const Unit&) const {}
};

template <class Epi, class Sched, bool ALIGN_EPI = false, bool SP2 = false>
__device__ __forceinline__ void gemm_phase(PG8_LAS unsigned char* lds, const Gemm g, const Sched& S, const Epi& E, const int wave_s) {
    int lane_; MK_LANE_ASM(lane_); int wv_ = wave_s; asm volatile("" : "+s"(wv_)); const int wid = wv_, lane = lane_, tid = wid * 64 + lane, wr = wid >> 2, wc = wid & 3, fr = lane & 15, fq = lane >> 4;
    const int K = g.K, nt = K / BK;
    unsigned voffA[2], voffB[2];
#pragma unroll
    for (int i = 0; i < 2; ++i) { int R, C; stage_rc(tid * 16 + i * 8192, R, C); const int Rb = Epi::PERM ? ((R & ~31) + perm32(R & 31)) : R;
        voffA[i] = (unsigned)(R * g.lda + C) * 2u; voffB[i] = (unsigned)(Rb * g.ldb + C) * 2u; }
    const size_t kstep = (size_t)(BK * 2);
    const size_t hstepA = (size_t)HALF * g.lda * 2, hstepB = (size_t)HALF * g.ldb * 2;
    const size_t tstepA = 2 * hstepA, tstepB = 2 * hstepB;
    const unsigned ldsw = (unsigned)wid * 1024u;
    const int aoff = lds_byte(wr * 64 + fr, fq * 8), boff = lds_byte(wc * 32 + fr, fq * 8);
#define PG8_SA(b, h) (((b) * 2 + (h)) * HTB)
#define PG8_SB(b, h) ((4 + (b) * 2 + (h)) * HTB)
#define PG8_STAGE(bufoff, gbase, voff) do { _Pragma("unroll") for (int _i = 0; _i < 2; ++_i) \
        __builtin_amdgcn_global_load_lds((const unsigned*)((const char*)(gbase) + (voff)[_i]), (PG8_LAS unsigned*)(lds + (bufoff) + ldsw + _i * 8192), 16, 0, 0); } while (0)
#define PG8_LDA(dst, b, h) do { _Pragma("unroll") for (int m = 0; m < 4; ++m) _Pragma("unroll") for (int k = 0; k < 2; ++k) dst[m][k] = *(const PG8_LAS bf16x8*)(lds + PG8_SA(b, h) + aoff + m * 2048 + k * 1024); } while (0)
#define PG8_LDB(dst, b, h) do { _Pragma("unroll") for (int n = 0; n < 2; ++n) _Pragma("unroll") for (int k = 0; k < 2; ++k) dst[n][k] = *(const PG8_LAS bf16x8*)(lds + PG8_SB(b, h) + boff + n * 2048 + k * 1024); } while (0)
#define PG8_MMA(ai, bj, At, Bt) do { __builtin_amdgcn_s_setprio(1); _Pragma("unroll") for (int m = 0; m < 4; ++m) _Pragma("unroll") for (int n = 0; n < 2; ++n) _Pragma("unroll") for (int k = 0; k < 2; ++k) \
        acc[ai][bj][m][n] = __builtin_amdgcn_mfma_f32_16x16x32_bf16(Bt[n][k], At[m][k], acc[ai][bj][m][n], 0, 0, 0); __builtin_amdgcn_s_setprio(0); } while (0)
#define PG8_WAIT_V(n) asm volatile("s_waitcnt vmcnt(" #n ")" ::: "memory")
#define PG8_WAIT_L(n) asm volatile("s_waitcnt lgkmcnt(" #n ")" ::: "memory")
#define PG8_BAR __builtin_amdgcn_s_barrier()
#define PG8_SCHED __builtin_amdgcn_sched_barrier(0)
    Unit cur, nxt; int ui = 0;
    (void)S.next(0, cur);
    f32x4 acc[2][2][4][2];
#pragma unroll
    for (int a = 0; a < 2; ++a)
#pragma unroll
        for (int b = 0; b < 2; ++b)
#pragma unroll
            for (int m = 0; m < 4; ++m)
#pragma unroll
                for (int n = 0; n < 2; ++n) acc[a][b][m][n] = (f32x4){0.f, 0.f, 0.f, 0.f};
    bf16x8 At[4][2], B0[2][2], B1[2][2];
    const char* cA = (const char*)g.A + (size_t)cur.pm * tstepA; const char* cB = (const char*)g.Bt + (size_t)cur.pn * tstepB;
    S.a_ready(cur);
    if constexpr (SP2) {
        PG8_STAGE(PG8_SB(0, 0), cB, voffB); PG8_STAGE(PG8_SB(0, 1), cB + hstepB, voffB); PG8_STAGE(PG8_SA(0, 0), cA, voffA); PG8_STAGE(PG8_SA(0, 1), cA + hstepA, voffA);
        if (wr == 1) PG8_BAR;
        PG8_WAIT_V(2); PG8_BAR;
        PG8_STAGE(PG8_SB(1, 0), cB + kstep, voffB); PG8_STAGE(PG8_SA(1, 0), cA + kstep, voffA); PG8_STAGE(PG8_SB(1, 1), cB + hstepB + kstep, voffB);
        PG8_WAIT_V(6); PG8_BAR;
    } else {
        PG8_STAGE(PG8_SB(0, 0), cB, voffB); PG8_STAGE(PG8_SA(0, 0), cA, voffA); PG8_STAGE(PG8_SB(0, 1), cB + hstepB, voffB); PG8_STAGE(PG8_SA(0, 1), cA + hstepA, voffA);
        if (wr == 1) PG8_BAR;
        PG8_WAIT_V(4); PG8_BAR;
        PG8_STAGE(PG8_SB(1, 0), cB + kstep, voffB); PG8_STAGE(PG8_SA(1, 0), cA + kstep, voffA); PG8_STAGE(PG8_SB(1, 1), cB + hstepB + kstep, voffB);
        PG8_WAIT_V(6); PG8_BAR;
    }
    for (;;) {
        const bool has_next = S.next(ui + 1, nxt);
        const char* nA = has_next ? (const char*)g.A + (size_t)nxt.pm * tstepA : cA; const char* nB = has_next ? (const char*)g.Bt + (size_t)nxt.pn * tstepB : cB;
        for (int t = 0; t < nt; t += 2) {
            const bool last = (t == nt - 2);
            const char* a1 = cA + (size_t)(t + 1) * kstep;
            const char* a2 = last ? nA : cA + (size_t)(t + 2) * kstep; const char* b2 = last ? nB : cB + (size_t)(t + 2) * kstep;
            const char* a3 = a2 + kstep; const char* b3 = b2 + kstep;
            if (last && has_next) S.a_ready(nxt);
            if constexpr (SP2) {
            PG8_LDB(B0, 0, 0); PG8_LDB(B1, 0, 1); PG8_SCHED; PG8_LDA(At, 0, 0); PG8_STAGE(PG8_SA(1, 1), a1 + hstepA, voffA);
            PG8_WAIT_V(8); PG8_WAIT_L(0); PG8_BAR; PG8_MMA(0, 0, At, B0); PG8_MMA(0, 1, At, B1); PG8_BAR; PG8_SCHED;
            PG8_LDA(At, 0, 1); PG8_STAGE(PG8_SB(0, 0), b2, voffB); PG8_STAGE(PG8_SB(0, 1), b2 + hstepB, voffB); PG8_STAGE(PG8_SA(0, 0), a2, voffA);
            PG8_WAIT_V(8); PG8_WAIT_L(0); PG8_BAR; PG8_MMA(1, 0, At, B0); PG8_MMA(1, 1, At, B1); PG8_BAR; PG8_SCHED;
            PG8_LDB(B0, 1, 0); PG8_LDB(B1, 1, 1); PG8_SCHED; PG8_LDA(At, 1, 0); PG8_STAGE(PG8_SA(0, 1), a2 + hstepA, voffA);
            PG8_WAIT_V(8); PG8_WAIT_L(0); PG8_BAR; PG8_MMA(0, 0, At, B0); PG8_MMA(0, 1, At, B1); PG8_BAR; PG8_SCHED;
            PG8_LDA(At, 1, 1); PG8_STAGE(PG8_SB(1, 0), b3, voffB); PG8_STAGE(PG8_SB(1, 1), b3 + hstepB, voffB); PG8_STAGE(PG8_SA(1, 0), a3, voffA);
            PG8_WAIT_V(8); PG8_WAIT_L(0); PG8_BAR; PG8_MMA(1, 0, At, B0); PG8_MMA(1, 1, At, B1); PG8_BAR; PG8_SCHED;
            } else {
            PG8_LDB(B0, 0, 0); PG8_SCHED; PG8_LDA(At, 0, 0); PG8_STAGE(PG8_SA(1, 1), a1 + hstepA, voffA);
            PG8_WAIT_L(8); PG8_BAR; PG8_WAIT_L(0); PG8_MMA(0, 0, At, B0); PG8_BAR; PG8_SCHED;
            PG8_LDB(B1, 0, 1); PG8_STAGE(PG8_SB(0, 0), b2, voffB);
            PG8_BAR; PG8_WAIT_L(0); PG8_MMA(0, 1, At, B1); PG8_BAR;
            PG8_LDA(At, 0, 1); PG8_STAGE(PG8_SA(0, 0), a2, voffA);
            PG8_BAR; PG8_WAIT_L(0); PG8_MMA(1, 0, At, B0); PG8_BAR; PG8_SCHED;
            PG8_STAGE(PG8_SB(0, 1), b2 + hstepB, voffB);
            PG8_WAIT_V(6); PG8_BAR; PG8_MMA(1, 1, At, B1); PG8_BAR;
            PG8_LDB(B0, 1, 0); PG8_SCHED; PG8_LDA(At, 1, 0); PG8_STAGE(PG8_SA(0, 1), a2 + hstepA, voffA);
            PG8_WAIT_L(8); PG8_BAR; PG8_WAIT_L(0); PG8_MMA(0, 0, At, B0); PG8_BAR; PG8_SCHED;
            PG8_LDB(B1, 1, 1); PG8_STAGE(PG8_SB(1, 0), b3, voffB);
            PG8_BAR; PG8_WAIT_L(0); PG8_MMA(0, 1, At, B1); PG8_BAR;
            PG8_LDA(At, 1, 1); PG8_STAGE(PG8_SA(1, 0), a3, voffA);
            PG8_BAR; PG8_WAIT_L(0); PG8_MMA(1, 0, At, B0); PG8_BAR; PG8_SCHED;
            PG8_STAGE(PG8_SB(1, 1), b3 + hstepB, voffB);
            PG8_WAIT_V(6); PG8_BAR; PG8_MMA(1, 1, At, B1); PG8_BAR;
            }
        }
        if constexpr (ALIGN_EPI) { if (wr == 0) PG8_BAR; }
        if constexpr (!Epi::AFTER_DRAIN) { E(acc, cur, wr, wc, fr, fq); S.done(cur); }
        if (!has_next) break;
#pragma unroll
        for (int a = 0; a < 2; ++a)
#pragma unroll
            for (int b = 0; b < 2; ++b)
#pragma unroll
                for (int m = 0; m < 4; ++m)
#pragma unroll
                    for (int n = 0; n < 2; ++n) acc[a][b][m][n] = (f32x4){0.f, 0.f, 0.f, 0.f};
        cur = nxt; cA = nA; cB = nB; ++ui;
        if constexpr (ALIGN_EPI) { if (wr == 1) PG8_BAR; }
    }
    PG8_WAIT_V(0);
    if constexpr (!ALIGN_EPI) { if (wr == 0) PG8_BAR; }
    PG8_BAR;
    if constexpr (Epi::AFTER_DRAIN) { E.fused(acc, cur, wr, wc, fr, fq, lds, wid, lane); S.done(cur); }
#undef PG8_SA
#undef PG8_SB
#undef PG8_STAGE
#undef PG8_LDA
#undef PG8_LDB
#undef PG8_MMA
#undef PG8_WAIT_V
#undef PG8_WAIT_L
#undef PG8_BAR
#undef PG8_SCHED
}
}

#define XB_TMO      128
#define XB_XCNT(j)  (256  + 64 * (j))
#define XB_XSUB(j)  (1280 + 64 * (j))
#define XB_XGEN(j)  (2304 + 64 * (j))
#define XB_TOP      3328
#define XB_TOPGEN   3392
#define XCD_BAR_WORDS 3456
#define XB_SPIN_CAP (1u << 18)

__device__ __forceinline__ unsigned xb_ld(unsigned* p)              { return __hip_atomic_load(p, __ATOMIC_RELAXED, __HIP_MEMORY_SCOPE_AGENT); }
__device__ __forceinline__ unsigned xb_add(unsigned* p, unsigned v) { return __hip_atomic_fetch_add(p, v, __ATOMIC_RELAXED, __HIP_MEMORY_SCOPE_AGENT); }
__device__ __forceinline__ unsigned xb_xcc_id() { return (unsigned)__builtin_amdgcn_s_getreg((3 << 11) | 20) & 0xFu; }
#define XB_SPIN(cond, bar) do { unsigned _sp = 0; while (cond) { __builtin_amdgcn_s_sleep(1); \
    if ((++_sp & 255u) == 0u) { if (xb_ld(&(bar)[XB_TMO])) break; if (_sp > XB_SPIN_CAP) { atomicAdd(&(bar)[XB_TMO], 1u); break; } } } } while (0)

struct XcdBarrier {
    unsigned* bar; unsigned x;
    volatile LAS unsigned* st;
};

__device__ __forceinline__ XcdBarrier xcd_barrier_post(unsigned* bar, volatile LAS unsigned* st) {
    XcdBarrier b; b.bar = bar; b.x = xb_xcc_id(); b.st = st;
    if (threadIdx.x == 0) (void)xb_add(&bar[XB_XCNT(b.x)], 1u);
    return b;
}
__device__ __forceinline__ void xcd_barrier_complete(unsigned* bar, unsigned x, unsigned& nloc, unsigned& nx) {
    const unsigned G = gridDim.x * gridDim.y * gridDim.z;
    unsigned sum, cnt, mine, sp = 0u;
    for (;;) {
        sum = 0u; cnt = 0u; mine = 0u;
#pragma unroll
        for (unsigned j = 0; j < 16; ++j) { const unsigned c = xb_ld(&bar[XB_XCNT(j)]); sum += c; cnt += (c > 0u) ? 1u : 0u; mine = (j == x) ? c : mine; }
        if (sum == G) break;
        __builtin_amdgcn_s_sleep(1);
        if ((++sp & 255u) == 0u) { if (xb_ld(&bar[XB_TMO])) break; if (sp > XB_SPIN_CAP) { atomicAdd(&bar[XB_TMO], 1u); break; } }
    }
    nloc = mine > 0u ? mine : 1u; nx = cnt > 0u ? cnt : 1u;
}

__device__ __forceinline__ void xcd_barrier(const XcdBarrier& b, const int wave_s) {
    int xb_lane_; MK_LANE_ASM(xb_lane_); const bool xb_t0 = (wave_s == 0) && (xb_lane_ == 0);
    asm volatile("s_waitcnt vmcnt(0)" ::: "memory");
    __syncthreads();
    if (xb_t0) {
        unsigned* bar = b.bar;
        __builtin_amdgcn_s_waitcnt(0);
        unsigned nloc = b.st[0], nx = b.st[1];
        if (nloc == 0u) { xcd_barrier_complete(bar, b.x, nloc, nx); b.st[0] = nloc; b.st[1] = nx; }
        const unsigned old = xb_add(&bar[XB_XSUB(b.x)], 1u);
        const unsigned gen = old / nloc;
        if (old + 1u == (gen + 1u) * nloc) {
            __builtin_amdgcn_fence(__ATOMIC_RELEASE, "agent");
            asm volatile("s_waitcnt vmcnt(0)" ::: "memory");
            const unsigned og = xb_add(&bar[XB_TOP], 1u);
            const unsigned tg = og / nx;
            if (og + 1u == (tg + 1u) * nx) xb_add(&bar[XB_TOPGEN], 1u);
            else XB_SPIN(xb_ld(&bar[XB_TOPGEN]) == tg, bar);
            __builtin_amdgcn_fence(__ATOMIC_ACQUIRE, "agent");
            xb_add(&bar[XB_XGEN(b.x)], 1u);
            asm volatile("s_waitcnt vmcnt(0)" ::: "memory");
        } else {
            XB_SPIN(xb_ld(&bar[XB_XGEN(b.x)]) == gen, bar);
            __builtin_amdgcn_fence(__ATOMIC_ACQUIRE, "agent");
            asm volatile("s_waitcnt vmcnt(0)" ::: "memory");
        }
    }
    __syncthreads();
}


namespace mk {
using pg8::bf16_t; using pg8::f32x4; using pg8::Unit; using pg8::BM; using pg8::HALF;
typedef unsigned u32x4 __attribute__((ext_vector_type(4)));
typedef unsigned u32x2 __attribute__((ext_vector_type(2)));
typedef float f32x2 __attribute__((ext_vector_type(2)));

constexpr int D = 2048, BATCH = 2, SEQ = 4096, DEPTH = 4, CTX = 256;
constexpr int HY = 1024, NH = 8, NKV = 2, HD = 128, ATTW = 1024, KVW = 256;
constexpr int INW = 4608, FF = 5632, GU = 2 * FF, FH = 64, FE = 33;
constexpr int ML = BATCH * SEQ, MC = BATCH * CTX, MT = ML + MC;
constexpr float EPS = 1e-6f;
constexpr float LOG2E = 1.4426950408889634f;
constexpr float QSCALE = 0.08838834764831845f * LOG2E;
constexpr int WINDOW = 128;
constexpr int NWAVES = 8, NTHR = 512;
constexpr int MOD_KC = 8;

constexpr size_t al(size_t x) { return (x + 255) & ~(size_t)255; }
constexpr size_t WS_CTL = 0, CTL_BYTES = 1u << 20;
constexpr size_t WS_X = CTL_BYTES;
constexpr size_t WS_AN = WS_X + al((size_t)MT * D * 4);
constexpr size_t WS_SSQ = WS_AN + al((size_t)MT * D * 2);
constexpr size_t WS_SSQC = WS_SSQ + al((size_t)MT * 32 * 4);
constexpr size_t WS_PHY = WS_SSQC + al((size_t)32 * MC * 4);
constexpr size_t WS_Q = WS_PHY + al((size_t)3 * HY * MT * 2);
constexpr size_t WS_K = WS_Q + al((size_t)MT * ATTW * 2);
constexpr size_t WS_V = WS_K + al((size_t)MT * KVW * 2);
constexpr size_t WS_YM = WS_V + al((size_t)MT * KVW * 2);
constexpr size_t WS_SSHY = WS_YM + al((size_t)MT * D * 2);
constexpr size_t WS_HB = WS_SSHY + al((size_t)HY * MT * 4);
constexpr size_t WS_MODP = WS_HB + al((size_t)MT * FF * 2);
constexpr size_t WS_MOD = WS_MODP + al((size_t)MOD_KC * DEPTH * 3 * 6 * D * 4);
constexpr size_t WS_MODB = WS_MOD + al((size_t)DEPTH * 3 * 6 * D * 4);
constexpr size_t WS_GMV = WS_MODB + al((size_t)DEPTH * 3 * 6 * D * 2);
constexpr size_t WS_SHWIN = WS_GMV + al((size_t)DEPTH * 2 * 3 * D * 4);
constexpr size_t WS_SHWGU = WS_SHWIN + al((size_t)DEPTH * 3 * INW * 4);
constexpr size_t WS_HIDL = WS_SHWGU + al((size_t)DEPTH * 3 * GU * 4);
constexpr size_t WS_W3T = WS_HIDL + al((size_t)DEPTH * SEQ * FH * 2);
constexpr size_t WS_HIDC = WS_HIDL + al((size_t)DEPTH * SEQ * FH * 4);
constexpr size_t WS_ROPE = WS_HIDC + al((size_t)DEPTH * CTX * FH * 4);
constexpr size_t WS_FLT = WS_ROPE + al((size_t)64 * 32 * 2 * 4);
constexpr size_t WS_FLTC = WS_FLT + al((size_t)DEPTH * 4 * HY * SEQ * 4);
constexpr size_t WS_WIN = WS_FLTC + al((size_t)DEPTH * 4 * HY * CTX * 4);
constexpr size_t WS_WOUT = WS_WIN + al((size_t)DEPTH * INW * D * 2);
constexpr size_t WS_WGU = WS_WOUT + al((size_t)DEPTH * D * D * 2);
constexpr size_t WS_WD = WS_WGU + al((size_t)DEPTH * GU * D * 2);
constexpr size_t WS_END = WS_WD + al((size_t)DEPTH * D * FF * 2);
constexpr int INW_A = 15 * 256, NQKV = ((INW - INW_A) / 256) * (MT / 256);
constexpr int CW_BAR = 4096;

constexpr int RING_BYTES = 135168  , MISC_OFF = RING_BYTES + 320, LDS_BYTES = RING_BYTES + 8192;

__device__ __forceinline__ unsigned f2bf(float f) { unsigned u = __builtin_bit_cast(unsigned, f); return (u + 0x7fffu + ((u >> 16) & 1u)) >> 16; }
__device__ __forceinline__ unsigned pk2(float lo, float hi) { unsigned r; asm("v_cvt_pk_bf16_f32 %0, %1, %2" : "=v"(r) : "v"(lo), "v"(hi)); return r; }
__device__ __forceinline__ float bf_lo(unsigned w) { return __builtin_bit_cast(float, w << 16); }
__device__ __forceinline__ float bf_hi(unsigned w) { return __builtin_bit_cast(float, w & 0xffff0000u); }
__device__ __forceinline__ float bf1(bf16_t b) { return __builtin_bit_cast(float, (unsigned)b << 16); }
__device__ __forceinline__ float wave_sum(float v) {
#pragma unroll
    for (int o = 1; o < 64; o <<= 1) v += __shfl_xor(v, o);
    return v;
}
__device__ __forceinline__ float wave_max(float v) {
#pragma unroll
    for (int o = 1; o < 64; o <<= 1) v = fmaxf(v, __shfl_xor(v, o));
    return v;
}
__device__ __forceinline__ int vec_of_panel(int pm) { return pm < 16 ? 0 : (pm < 32 ? 1 : 2); }
__device__ __forceinline__ int vec_of_row(int row) { return row < SEQ ? 0 : (row < ML ? 1 : 2); }
__host__ __device__ __forceinline__ int qk_dim(int j) { const int wc = j >> 5, fq = (j >> 3) & 3, n = (j >> 2) & 1, e = j & 3, idx = wc * 16 + fq * 4 + e; return (idx < 32 ? idx : idx + 32) + 32 * n; }

#define FRESH_IDS int lane_; MK_LANE_ASM(lane_); int wv_ = wave_s; asm volatile("" : "+s"(wv_)); const int lane = lane_, wave = wv_, tid = wv_ * 64 + lane_; (void)lane; (void)wave; (void)tid
#ifndef MK_TS
#define MK_TS -1
#endif
#ifndef MK_TSL
#define MK_TSL 1
#endif
#ifndef MK_TSB
#define MK_TSB 0
#endif
#define TS_MARK(word, cond) do { if (MK_TS >= 0 && (cond) && blockIdx.x == MK_TSB && wave_s == 0) { int l_; MK_LANE_ASM(l_); if (l_ == 0) { const unsigned long long t_ = __builtin_amdgcn_s_memrealtime(); MISC[16 + 2 * (word)] = (unsigned)t_; MISC[17 + 2 * (word)] = (unsigned)(t_ >> 32); } } } while (0)
struct Params {
    const float* in[26];
    float* out;
    unsigned char* ws;
    int ph_lo, ph_hi;
};
typedef __attribute__((address_space(4))) const Params* KP;
#define FRESH_KP KP Pp; { unsigned long long ki_ = (unsigned long long)__builtin_amdgcn_kernarg_segment_ptr(); asm volatile("" : "+s"(ki_)); Pp = (KP)ki_; }

__device__ __forceinline__ void load_rstd8(const float* ssq, const float* ssqc, int row0, int fq, float (&rs)[2][4]) {
    const bool isc = row0 >= ML;
#pragma unroll
    for (int ai = 0; ai < 2; ++ai)
#pragma unroll
        for (int m = 0; m < 4; ++m) {
            const int row = row0 + ai * HALF + m * 16;
            float s;
            if (!isc) { const f32x4 a = *(const f32x4*)(ssq + ((size_t)(2 * fq) * MT + row) * 4), b = *(const f32x4*)(ssq + ((size_t)(2 * fq + 1) * MT + row) * 4);
                s = ((a[0] + a[1]) + (a[2] + a[3])) + ((b[0] + b[1]) + (b[2] + b[3])); }
            else { s = 0.f;
#pragma unroll
                for (int j = 0; j < 8; ++j) s += ssqc[(size_t)(fq * 8 + j) * MC + (row - ML)]; }
            s += __shfl_xor(s, 16); s += __shfl_xor(s, 32);
            rs[ai][m] = 1.0f / sqrtf(s * (1.0f / D) + EPS);
        }
}

struct EpiIn {
    static constexpr bool PERM = true, AFTER_DRAIN = false;
    const float* ssq; const float* ssqc; const float* shw;
    bf16_t* PHY; bf16_t* Q; bf16_t* Kb; bf16_t* Vb; const float* rope; int live; int pn_off;
    __device__ __forceinline__ void operator()(const f32x4 (&acc)[2][2][4][2], const Unit& u, int wr, int wc, int fr_, int fq_) const {
        int fr = fr_, fq = fq_; asm volatile("" : "+v"(fr), "+v"(fq));
        const int row0 = u.pm * BM + wr * 64 + fr, v = vec_of_panel(u.pm);
        const int pn = u.pn + pn_off;
        float rs[2][4]; load_rstd8(ssq, ssqc, row0, fq, rs);
        const int cpos = wc * 32 + 8 * fq;
        const int colb = pn * BM + cpos;
        f32x4 sh[2][2];
#pragma unroll
        for (int bj = 0; bj < 2; ++bj)
#pragma unroll
            for (int n = 0; n < 2; ++n) { const int dsrc = (wc < 2 ? 16 * wc + 4 * fq : 16 * wc + 4 * fq + 32) + 32 * n;
                sh[bj][n] = *(const f32x4*)(shw + (size_t)v * INW + (pn >= 12 && pn < 17 ? pn * BM + bj * HALF + dsrc : colb + bj * HALF + 4 * n)); }
        if (pn < 12) {
#pragma unroll
            for (int ai = 0; ai < 2; ++ai)
#pragma unroll
                for (int m = 0; m < 4; ++m) { const int row = row0 + ai * HALF + m * 16; const float r = rs[ai][m];
#pragma unroll
                    for (int bj = 0; bj < 2; ++bj)
#pragma unroll
                        for (int n = 0; n < 2; ++n) { const f32x4 x = acc[ai][bj][m][n] * r + sh[bj][n];
                            u32x2 w; w.x = pk2(x[0], x[1]); w.y = pk2(x[2], x[3]);
                            const int cg = (colb + bj * HALF) / 4 + n;
                            if (live) *(u32x2*)(PHY + ((size_t)cg * MT + row) * 4) = w; } }
        } else if (pn < 17) {
            const bool isq = pn < 16, latent = u.pm < 32;
            const int axis = wc >> 1, p0 = (wc * 16 + fq * 4) & 31;
            const float qs = isq ? QSCALE : 1.0f;
#pragma unroll
            for (int ai = 0; ai < 2; ++ai)
#pragma unroll
                for (int m = 0; m < 4; ++m) { const int row = row0 + ai * HALF + m * 16; const float r = rs[ai][m];
                    const int l = row & (SEQ - 1), pos = axis ? (l & 63) : (l >> 6);
                    f32x4 t0 = (f32x4){1.f, 0.f, 1.f, 0.f}, t1 = t0;
                    if (latent) { const f32x4* tp = (const f32x4*)(rope + ((size_t)pos * 32 + p0) * 2); t0 = tp[0]; t1 = tp[1]; }
                    const float cs[4] = {t0[0], t0[2], t1[0], t1[2]}, sn[4] = {t0[1], t0[3], t1[1], t1[3]};
#pragma unroll
                    for (int bj = 0; bj < 2; ++bj) { const f32x4 a = acc[ai][bj][m][0] * r + sh[bj][0], b = acc[ai][bj][m][1] * r + sh[bj][1];
                        float ra[4], rb[4];
#pragma unroll
                        for (int e = 0; e < 4; ++e) { ra[e] = (a[e] * cs[e] - b[e] * sn[e]) * qs; rb[e] = (a[e] * sn[e] + b[e] * cs[e]) * qs; }
                        u32x4 w; w.x = pk2(ra[0], ra[1]); w.y = pk2(ra[2], ra[3]); w.z = pk2(rb[0], rb[1]); w.w = pk2(rb[2], rb[3]);
                        bf16_t* dst = isq ? Q + (size_t)row * ATTW + (pn - 12) * BM + bj * HALF + cpos : Kb + (size_t)row * KVW + bj * HALF + cpos;
                        if (live) *(u32x4*)dst = w; } }
        } else {
#pragma unroll
            for (int ai = 0; ai < 2; ++ai)
#pragma unroll
                for (int m = 0; m < 4; ++m) { const int row = row0 + ai * HALF + m * 16; const float r = rs[ai][m];
#pragma unroll
                    for (int bj = 0; bj < 2; ++bj) { const f32x4 a = acc[ai][bj][m][0] * r + sh[bj][0], b = acc[ai][bj][m][1] * r + sh[bj][1];
                        u32x4 w; w.x = pk2(a[0], a[1]); w.y = pk2(a[2], a[3]); w.z = pk2(b[0], b[1]); w.w = pk2(b[2], b[3]);
                        if (live) *(u32x4*)(Vb + (size_t)row * KVW + bj * HALF + cpos) = w; } }
        }
    }
};

struct EpiOutA {
    static constexpr bool PERM = true, AFTER_DRAIN = false;
    float* X; const float* gate;
    const float* sshy;
    __device__ __forceinline__ void operator()(const f32x4 (&acc)[2][2][4][2], const Unit& u, int wr, int wc, int fr_, int fq_) const {
        int fr = fr_, fq = fq_; asm volatile("" : "+v"(fr), "+v"(fq));
        const int row0 = u.pm * BM + wr * 64 + fr, v = vec_of_panel(u.pm);
        const int colb = u.pn * BM + wc * 32 + 8 * fq;
        f32x4 gt[2][2];
#pragma unroll
        for (int bj = 0; bj < 2; ++bj)
#pragma unroll
            for (int n = 0; n < 2; ++n) gt[bj][n] = *(const f32x4*)(gate + (size_t)v * 6 * D + colb + bj * HALF + 4 * n);
#pragma unroll
        for (int ai = 0; ai < 2; ++ai)
#pragma unroll
            for (int m = 0; m < 4; ++m) { const int row = row0 + ai * HALF + m * 16;
                const float r = 1.0f / sqrtf(sshy[row] * (1.0f / HY) + EPS);
                float* xr = X + (size_t)row * D + colb;
#pragma unroll
                for (int bj = 0; bj < 2; ++bj)
#pragma unroll
                    for (int n = 0; n < 2; ++n) { f32x4* px = (f32x4*)(xr + bj * HALF + 4 * n); *px = *px + gt[bj][n] * (acc[ai][bj][m][n] * r); } }
    }
};

struct EpiResid {
    static constexpr bool PERM = true, AFTER_DRAIN = false;
    const float* Xin; const bf16_t* Xb; bf16_t* X; const float* gate; const float* gnext  ; bf16_t* AN; float* ssq; int live;
    __device__ __forceinline__ void operator()(const f32x4 (&acc)[2][2][4][2], const Unit& u, int wr, int wc, int fr_, int fq_) const {
        int fr = fr_, fq = fq_; asm volatile("" : "+v"(fr), "+v"(fq));
        const int row0 = u.pm * BM + wr * 64 + fr, v = vec_of_panel(u.pm);
        const int colb = u.pn * BM + wc * 32 + 8 * fq;
        f32x4 gt[2][2], gn[2][2];
#pragma unroll
        for (int bj = 0; bj < 2; ++bj)
#pragma unroll
            for (int n = 0; n < 2; ++n) { gt[bj][n] = *(const f32x4*)(gate + (size_t)v * 6 * D + colb + bj * HALF + 4 * n);
                gn[bj][n] = gnext ? *(const f32x4*)(gnext + (size_t)v * D + colb + bj * HALF + 4 * n) : (f32x4){0.f, 0.f, 0.f, 0.f}; }
#pragma unroll
        for (int ai = 0; ai < 2; ++ai)
#pragma unroll
            for (int m = 0; m < 4; ++m) { const int row = row0 + ai * HALF + m * 16;
                const size_t eo = (size_t)row * D + colb; float s = 0.f;
#pragma unroll
                for (int bj = 0; bj < 2; ++bj) { f32x4 x[2];
                    if (Xin) { x[0] = *(const f32x4*)(Xin + eo + bj * HALF); x[1] = *(const f32x4*)(Xin + eo + bj * HALF + 4); }
                    else { const u32x4 xw = *(const u32x4*)(Xb + eo + bj * HALF); x[0] = (f32x4){bf_lo(xw.x), bf_hi(xw.x), bf_lo(xw.y), bf_hi(xw.y)}; x[1] = (f32x4){bf_lo(xw.z), bf_hi(xw.z), bf_lo(xw.w), bf_hi(xw.w)}; }
#pragma unroll
                    for (int n = 0; n < 2; ++n) { x[n] = x[n] + gt[bj][n] * acc[ai][bj][m][n];
                        s += (x[n][0] * x[n][0] + x[n][1] * x[n][1]) + (x[n][2] * x[n][2] + x[n][3] * x[n][3]); }
                    if (live) { u32x4 xo; xo.x = pk2(x[0][0], x[0][1]); xo.y = pk2(x[0][2], x[0][3]); xo.z = pk2(x[1][0], x[1][1]); xo.w = pk2(x[1][2], x[1][3]); *(u32x4*)(X + eo + bj * HALF) = xo; }
                    if (gnext && live) { const f32x4 a = x[0] * gn[bj][0], b = x[1] * gn[bj][1];
                        u32x4 w; w.x = pk2(a[0], a[1]); w.y = pk2(a[2], a[3]); w.z = pk2(b[0], b[1]); w.w = pk2(b[2], b[3]);
                        *(u32x4*)(AN + (size_t)row * D + colb + bj * HALF) = w; } }
                s += __shfl_xor(s, 16); s += __shfl_xor(s, 32);
                if (fq == 0 && live) ssq[((size_t)u.pn * MT + row) * 4 + wc] = s; }
    }
};

struct EpiGU {
    static constexpr bool PERM = true, AFTER_DRAIN = false;
    const float* ssq; const float* ssqc; const float* shw;
    bf16_t* HB; volatile LAS unsigned* MISC; int wave_s; int tsl;
    __device__ __forceinline__ void operator()(const f32x4 (&acc)[2][2][4][2], const Unit& u, int wr, int wc, int fr_, int fq_) const {
        int fr = fr_, fq = fq_; asm volatile("" : "+v"(fr), "+v"(fq));
        const bool first_ = (MK_TS == 60 || MK_TS == 61) ? (MISC[20] == 0u) : false;
        TS_MARK(1, MK_TS == 61 && tsl && first_); TS_MARK(0, MK_TS == 60 && tsl && first_);
        const int row0 = u.pm * BM + wr * 64 + fr, v = vec_of_panel(u.pm);
        float rs[2][4]; load_rstd8(ssq, ssqc, row0, fq, rs);
        const int colb = u.pn * BM + wc * 32 + 8 * fq;
        f32x4 sh[2][2];
#pragma unroll
        for (int bj = 0; bj < 2; ++bj)
#pragma unroll
            for (int n = 0; n < 2; ++n) sh[bj][n] = *(const f32x4*)(shw + (size_t)v * GU + colb + bj * HALF + 4 * n);
#pragma unroll
        for (int ai = 0; ai < 2; ++ai)
#pragma unroll
            for (int m = 0; m < 4; ++m) { const int row = row0 + ai * HALF + m * 16; const float r = rs[ai][m];
                unsigned hw[4];
#pragma unroll
                for (int n = 0; n < 2; ++n) { const f32x4 g = acc[ai][0][m][n] * r + sh[0][n], up = acc[ai][1][m][n] * r + sh[1][n];
                    float h[4];
#pragma unroll
                    for (int e = 0; e < 4; ++e) h[e] = g[e] * __builtin_amdgcn_rcpf(1.0f + __builtin_amdgcn_exp2f(-g[e] * LOG2E)) * up[e];
                    hw[2 * n] = pk2(h[0], h[1]); hw[2 * n + 1] = pk2(h[2], h[3]); }
                u32x4 w; w.x = hw[0]; w.y = hw[1]; w.z = hw[2]; w.w = hw[3];
                *(u32x4*)(HB + (size_t)row * FF + u.pn * HALF + wc * 32 + 8 * fq) = w; }
        if (MK_TS == 60 || MK_TS == 61) { asm volatile("s_waitcnt vmcnt(0)" ::: "memory"); TS_MARK(1, MK_TS == 60 && tsl && first_); if (tsl && wave_s == 0) MISC[20] = 1u; }
    }
};

template <class RowMap>
__device__ __forceinline__ void transpose_item(const float* W, int K, int N, bf16_t* WT, LAS float* scr, int item, int lane, const RowMap& rm) {
    const int nblk = N / 32, kb = item / nblk, nb = item % nblk, k0 = 64 * kb, n0 = 32 * nb;
    const int lr = lane >> 3, ln = (lane & 7) * 4;
#pragma unroll
    for (int i = 0; i < 8; ++i) { const int kk = 8 * i + lr; const f32x4 v = *(const f32x4*)(W + (size_t)(k0 + kk) * N + n0 + ln); *(LAS f32x4*)(scr + kk * 36 + ln) = v; }
    asm volatile("s_waitcnt lgkmcnt(0)" ::: "memory");
    const int c = lane & 7;
#pragma unroll
    for (int j = 0; j < 4; ++j) { const int n = (lane >> 3) + 8 * j; const LAS float* s = scr + (8 * c) * 36 + n;
        u32x4 o; o.x = pk2(s[0 * 36], s[1 * 36]); o.y = pk2(s[2 * 36], s[3 * 36]); o.z = pk2(s[4 * 36], s[5 * 36]); o.w = pk2(s[6 * 36], s[7 * 36]);
        *(u32x4*)(WT + (size_t)rm(n0 + n) * K + k0 + 8 * c) = o; }
    asm volatile("s_waitcnt lgkmcnt(0)" ::: "memory");
}
struct MapId { __device__ __forceinline__ int operator()(int n) const { return n; } };
struct MapIn { __device__ __forceinline__ int operator()(int n) const {
    if (n < 3 * HY || n >= 3 * HY + ATTW + KVW) return n;
    const int h0 = (n - 3 * HY) & ~127, d = (n - 3 * HY) & 127;
    const int nn = (d >> 5) & 1, base = d - 32 * nn, idx = base < 32 ? base : base - 32, wc = idx >> 4, fq = (idx >> 2) & 3, e = idx & 3;
    return 3 * HY + h0 + 32 * wc + 8 * fq + 4 * nn + e; } };
struct MapGU { int up; __device__ __forceinline__ int operator()(int n) const { return (n >> 7) * 256 + up * 128 + (n & 127); } };

struct ConvItem { const float* src; bf16_t* dst; int K, N, k0, n0, kind; };
struct ConvSrc { const float* win; const float* wout; const float* wg; const float* wu; const float* wd; };
__device__ __forceinline__ ConvItem conv_item(const ConvSrc& in, unsigned char* ws, int layer, int r) {
    constexpr int I_IN = (D / 64) * (INW / 32), I_OUT = (D / 64) * (D / 32), I_G = (D / 64) * (FF / 32);
    ConvItem c; int nn;
    if (r < I_IN) { c.src = in.win + (size_t)layer * D * INW; c.dst = (bf16_t*)(ws + WS_WIN) + (size_t)layer * INW * D; c.K = D; nn = INW; c.kind = 1; }
    else if ((r -= I_IN) < I_OUT) { c.src = in.wout + (size_t)layer * D * D; c.dst = (bf16_t*)(ws + WS_WOUT) + (size_t)layer * D * D; c.K = D; nn = D; c.kind = 0; }
    else if ((r -= I_OUT) < I_G) { c.src = in.wg + (size_t)layer * D * FF; c.dst = (bf16_t*)(ws + WS_WGU) + (size_t)layer * GU * D; c.K = D; nn = FF; c.kind = 2; }
    else if ((r -= I_G) < I_G) { c.src = in.wu + (size_t)layer * D * FF; c.dst = (bf16_t*)(ws + WS_WGU) + (size_t)layer * GU * D; c.K = D; nn = FF; c.kind = 3; }
    else { r -= I_G; c.src = in.wd + (size_t)layer * FF * D; c.dst = (bf16_t*)(ws + WS_WD) + (size_t)layer * D * FF; c.K = FF; nn = D; c.kind = 0; }
    const int nblk = nn / 32; c.N = nn; c.k0 = 64 * (r / nblk); c.n0 = 32 * (r % nblk); return c;
}
__device__ __forceinline__ void convert_layer(LAS unsigned char* lds, const int layer, int w0, int nw, const int wave_s, const int lo, const int hi) {
    FRESH_IDS; FRESH_KP;
    unsigned char* ws = Pp->ws;
    LAS float* scr = (LAS float*)(lds + wave * 9216);
    constexpr int I_IN = (D / 64) * (INW / 32), I_OUT = (D / 64) * (D / 32), I_G = (D / 64) * (FF / 32), I_D = (FF / 64) * (D / 32);
    const ConvSrc inp{Pp->in[8], Pp->in[21], Pp->in[22], Pp->in[23], Pp->in[24]};
    const int lr = lane >> 3, ln = (lane & 7) * 4, c8 = lane & 7;
    f32x4 v[8];
    int it = lo + w0; const int TOT = hi;
#define CONV_ITEM(i_) conv_item(inp, ws, layer, (i_) < I_OUT ? I_IN + (i_) : I_IN + 2 * I_G + (i_))
    if (it < TOT) {
    ConvItem cur = CONV_ITEM(it);
#pragma unroll
    for (int i = 0; i < 8; ++i) v[i] = __builtin_nontemporal_load((const f32x4*)(cur.src + (size_t)(cur.k0 + 8 * i + lr) * cur.N + cur.n0 + ln));
    for (;;) {
#pragma unroll
        for (int i = 0; i < 8; ++i) *(LAS f32x4*)(scr + (8 * i + lr) * 36 + ln) = v[i];
        const int itn = it + nw; const bool more = itn < TOT; ConvItem nxt = cur;
        if (more) { nxt = CONV_ITEM(itn);
#pragma unroll
            for (int i = 0; i < 8; ++i) v[i] = __builtin_nontemporal_load((const f32x4*)(nxt.src + (size_t)(nxt.k0 + 8 * i + lr) * nxt.N + nxt.n0 + ln)); }
        asm volatile("s_waitcnt lgkmcnt(0)" ::: "memory");
#pragma unroll
        for (int j = 0; j < 4; ++j) { const int nl_ = (lane >> 3) + 8 * j, n = cur.n0 + nl_; const LAS float* s = scr + (8 * c8) * 36 + nl_;
            u32x4 o; o.x = pk2(s[0 * 36], s[1 * 36]); o.y = pk2(s[2 * 36], s[3 * 36]); o.z = pk2(s[4 * 36], s[5 * 36]); o.w = pk2(s[6 * 36], s[7 * 36]);
            const int row = cur.kind == 1 ? MapIn{}(n) : cur.kind == 2 ? MapGU{0}(n) : cur.kind == 3 ? MapGU{1}(n) : n;
            __builtin_nontemporal_store(o, (u32x4*)(cur.dst + (size_t)row * cur.K + cur.k0 + 8 * c8)); }
        asm volatile("s_waitcnt lgkmcnt(0)" ::: "memory");
        if (!more) break;
        cur = nxt; it = itn;
    } }
}

__device__ __forceinline__ void shw_items(int layer, int part, int w0, int nw, const int wave_s) {
    FRESH_IDS; FRESH_KP;
    unsigned char* ws = Pp->ws;
    const float* MOD = (const float*)(ws + WS_MOD);
    const bool isin = part == 0; const int nitems = (isin ? INW : GU) / 32;
    const float* sh = MOD + (size_t)layer * 3 * 6 * D + (isin ? 0 : 3) * D;
    float s0[32], s1[32], s2[32];
#pragma unroll
    for (int j = 0; j < 4; ++j)
#pragma unroll
        for (int e = 0; e < 8; ++e) { const int k = lane * 8 + 512 * j + e; s0[j * 8 + e] = sh[k]; s1[j * 8 + e] = sh[6 * D + k]; s2[j * 8 + e] = sh[12 * D + k]; }
    for (int it = w0; it < nitems; it += nw) { const int r0 = it * 32;
        const bf16_t* wbase = isin ? (const bf16_t*)(ws + WS_WIN) + ((size_t)layer * INW + r0) * D : (const bf16_t*)(ws + WS_WGU) + ((size_t)layer * GU + r0) * D;
        float k0 = 0.f, k1 = 0.f, k2 = 0.f;
#pragma unroll 2
        for (int rr = 0; rr < 32; ++rr) { const bf16_t* wrow = wbase + (size_t)rr * D;
            float a0 = 0.f, a1 = 0.f, a2 = 0.f;
#pragma unroll
            for (int j = 0; j < 4; ++j) { const int k = lane * 8 + 512 * j; const u32x4 w = *(const u32x4*)(wrow + k);
                const float wf[8] = {bf_lo(w.x), bf_hi(w.x), bf_lo(w.y), bf_hi(w.y), bf_lo(w.z), bf_hi(w.z), bf_lo(w.w), bf_hi(w.w)};
#pragma unroll
                for (int e = 0; e < 8; ++e) { a0 += wf[e] * s0[j * 8 + e]; a1 += wf[e] * s1[j * 8 + e]; a2 += wf[e] * s2[j * 8 + e]; } }
            a0 = wave_sum(a0); a1 = wave_sum(a1); a2 = wave_sum(a2);
            if (lane == rr) { k0 = a0; k1 = a1; k2 = a2; } }
        if (lane < 32) { float* o = isin ? (float*)(ws + WS_SHWIN) + (size_t)layer * 3 * INW + r0 + lane : (float*)(ws + WS_SHWGU) + (size_t)layer * 3 * GU + r0 + lane;
            const int st = isin ? INW : GU; o[0] = k0; o[st] = k1; o[2 * st] = k2; } }
}

__device__ __forceinline__ float silu_acc(float v) { return v / (1.f + expf(-v)); }

constexpr int CV_OUTD = (D / 64) * (D / 32) + (FF / 64) * (D / 32);
__device__ __forceinline__ void convert_shw(LAS unsigned char* lds, int w0, int nw, const int wave_s) {
    FRESH_IDS; FRESH_KP;
    unsigned char* ws = Pp->ws;
    LAS float* scr = (LAS float*)(lds + wave * 9216);
    const int lr = lane >> 3, ln = (lane & 7) * 4, c8 = lane & 7;
    constexpr int B_IN = INW / 32, B_G = FF / 32, PERL = B_IN + 2 * B_G;
#pragma nounroll
    for (int it = w0; it < DEPTH * PERL; it += nw) {
        const int layer = it / PERL; int r = it % PERL;
        const float* src; bf16_t* dst; float* shw; int N, n0, kind;
        if (r < B_IN) { kind = 1; N = INW; n0 = 32 * r; src = Pp->in[8] + (size_t)layer * D * INW; dst = (bf16_t*)(ws + WS_WIN) + (size_t)layer * INW * D; shw = (float*)(ws + WS_SHWIN) + (size_t)layer * 3 * INW + n0; }
        else { r -= B_IN; const int up = r >= B_G ? 1 : 0; if (up) r -= B_G; kind = 2 + up; N = FF; n0 = 32 * r; src = (up ? Pp->in[23] : Pp->in[22]) + (size_t)layer * D * FF;
               dst = (bf16_t*)(ws + WS_WGU) + (size_t)layer * GU * D; shw = (float*)(ws + WS_SHWGU) + (size_t)layer * 3 * GU + MapGU{up}(n0); }
        const int sstride = kind == 1 ? INW : GU;
        const float* shv = (const float*)(ws + WS_MOD) + (size_t)layer * 3 * 6 * D + (kind == 1 ? 0 : 3) * D + 8 * c8;
        const float* sp = src + (size_t)lr * N + n0 + ln;
        f32x4 v[8], sv[3][2]; float acc[4][3];
#pragma unroll
        for (int j = 0; j < 4; ++j) { acc[j][0] = 0.f; acc[j][1] = 0.f; acc[j][2] = 0.f; }
#pragma unroll
        for (int i = 0; i < 8; ++i) v[i] = __builtin_nontemporal_load((const f32x4*)(sp + (size_t)(8 * i) * N));
#pragma unroll
        for (int vv = 0; vv < 3; ++vv) { sv[vv][0] = *(const f32x4*)(shv + (size_t)vv * 6 * D); sv[vv][1] = *(const f32x4*)(shv + (size_t)vv * 6 * D + 4); }
#pragma nounroll
        for (int kb = 0; kb < D / 64; ++kb) {
#pragma unroll
            for (int i = 0; i < 8; ++i) *(LAS f32x4*)(scr + (8 * i + lr) * 36 + ln) = v[i];
            float cs[3][8];
#pragma unroll
            for (int vv = 0; vv < 3; ++vv)
#pragma unroll
                for (int e = 0; e < 8; ++e) cs[vv][e] = sv[vv][e >> 2][e & 3];
            if (kb + 1 < D / 64) { const float* spn = sp + (size_t)(64 * (kb + 1)) * N; const float* shn = shv + 64 * (kb + 1);
#pragma unroll
                for (int i = 0; i < 8; ++i) v[i] = __builtin_nontemporal_load((const f32x4*)(spn + (size_t)(8 * i) * N));
#pragma unroll
                for (int vv = 0; vv < 3; ++vv) { sv[vv][0] = *(const f32x4*)(shn + (size_t)vv * 6 * D); sv[vv][1] = *(const f32x4*)(shn + (size_t)vv * 6 * D + 4); } }
            asm volatile("s_waitcnt lgkmcnt(0)" ::: "memory");
#pragma unroll
            for (int j = 0; j < 4; ++j) { const int nl_ = (lane >> 3) + 8 * j, n = n0 + nl_; const LAS float* s = scr + (8 * c8) * 36 + nl_;
                float w[8];
#pragma unroll
                for (int e = 0; e < 8; ++e) w[e] = s[e * 36];
                u32x4 o; o.x = pk2(w[0], w[1]); o.y = pk2(w[2], w[3]); o.z = pk2(w[4], w[5]); o.w = pk2(w[6], w[7]);
                const int row = kind == 1 ? MapIn{}(n) : MapGU{kind - 2}(n);
                __builtin_nontemporal_store(o, (u32x4*)(dst + (size_t)row * D + 64 * kb + 8 * c8));
#pragma unroll
                for (int vv = 0; vv < 3; ++vv) { float a = acc[j][vv];
#pragma unroll
                    for (int e = 0; e < 8; ++e) a += cs[vv][e] * w[e];
                    acc[j][vv] = a; } }
            asm volatile("s_waitcnt lgkmcnt(0)" ::: "memory");
        }
#pragma unroll
        for (int j = 0; j < 4; ++j)
#pragma unroll
            for (int vv = 0; vv < 3; ++vv) { float a = acc[j][vv]; a += __shfl_xor(a, 1); a += __shfl_xor(a, 2); a += __shfl_xor(a, 4);
                if (c8 == 0) shw[(size_t)vv * sstride + (lane >> 3) + 8 * j] = a; }
    }
}
__device__ __forceinline__ void p0a(LAS unsigned char* lds, int G, const int wave_s) {
    FRESH_IDS; FRESH_KP;
    unsigned char* ws = Pp->ws;
    const int gw = blockIdx.x * NWAVES + wave, NGW = G * NWAVES;
    const int gt = blockIdx.x * NTHR + tid, NGT = G * NTHR;
    { float* rope = (float*)(ws + WS_ROPE);
      for (int i = gt; i < 64 * 32; i += NGT) { const int pos = i >> 5, p = i & 31; const float inv = powf(10000.f, -(float)p / 32.f); const float ang = (float)pos * inv; rope[2 * i] = cosf(ang); rope[2 * i + 1] = sinf(ang); }
    }
    LAS float* SV = (LAS float*)(lds + 98304);
    for (int i = tid; i < 3 * D; i += NTHR) SV[i] = silu_acc(i < 2 * D ? Pp->in[1][i] : Pp->in[3][i - 2 * D]);
    __syncthreads();
    volatile LAS unsigned* MISC = (volatile LAS unsigned*)(lds + MISC_OFF); (void)MISC;
    TS_MARK(0, MK_TS == 13);
    constexpr int NGEMV = DEPTH * (6 * D / 256);
    static_assert(NGEMV < 256 && MOD_KC == NWAVES, "GEMV workgroups");
    if ((int)blockIdx.x < NGEMV) { constexpr int KCH = D / MOD_KC, NCH = 6 * D / 256;
          const int kc = wave, nc = (int)blockIdx.x % NCH, layer = (int)blockIdx.x / NCH;
          const float* W = Pp->in[6] + (size_t)layer * D * 6 * D + (size_t)(kc * KCH) * 6 * D + nc * 256 + lane * 4;
          f32x4 a0 = {0.f, 0.f, 0.f, 0.f}, a1 = a0, a2 = a0;
#pragma unroll 16
          for (int k = 0; k < KCH; ++k) { const f32x4 w = __builtin_nontemporal_load((const f32x4*)(W + (size_t)k * 6 * D)); const int kk = kc * KCH + k;
              a0 += w * SV[kk]; a1 += w * SV[D + kk]; a2 += w * SV[2 * D + kk]; }
          LAS f32x4* red = (LAS f32x4*)lds;
          red[(wave * 3 + 0) * 64 + lane] = a0; red[(wave * 3 + 1) * 64 + lane] = a1; red[(wave * 3 + 2) * 64 + lane] = a2;
          __syncthreads();
          const LAS float* redf = (const LAS float*)lds;
          for (int o = tid; o < 3 * 256; o += NTHR) { const int v = o >> 8, col = o & 255; float s = Pp->in[7][(size_t)layer * 6 * D + nc * 256 + col];
#pragma unroll
              for (int w = 0; w < NWAVES; ++w) s += redf[(w * 3 + v) * 256 + col];
              const size_t mi = ((size_t)layer * 3 + v) * 6 * D + nc * 256 + col;
              ((float*)(ws + WS_MOD))[mi] = s; ((bf16_t*)(ws + WS_MODB))[mi] = (bf16_t)f2bf(s); } }
    TS_MARK(1, MK_TS == 13); TS_MARK(0, MK_TS == 14);
    if ((int)blockIdx.x >= NGEMV) { constexpr int PL = SEQ + CTX; const int fw = ((int)blockIdx.x - NGEMV) * NWAVES + wave, NFW = (G - NGEMV) * NWAVES;
#pragma nounroll
      for (int layer = 0; layer < DEPTH; ++layer) {
          const float* w1 = Pp->in[11] + (size_t)layer * FE * FH + lane; const float* w2 = Pp->in[13] + (size_t)layer * FH * FH + lane;
          float w1c[FE], w2c[FH];
#pragma unroll
          for (int j = 0; j < FE; ++j) w1c[j] = w1[j * FH];
#pragma unroll
          for (int j = 0; j < FH; ++j) w2c[j] = w2[j * FH];
          const float b1l = Pp->in[12][layer * FH + lane], b2l = Pp->in[14][layer * FH + lane], frl = Pp->in[16][layer * FH + lane];
#pragma nounroll
          for (int r = fw; r < PL; r += NFW) { const bool isc = r >= SEQ; const int l = isc ? r - SEQ : r, L = isc ? CTX : SEQ;
              float emb = 0.f;
              if (lane < FE) { const float t = (float)l / (float)(L - 1); const float w = (2.0f * 3.14159265358979323846f / (float)L) * (float)l;
                  if (lane == 0) emb = t; else { const int bi = (lane - 1) & 15; const float band = 1e-4f + (float)bi * ((15.0f - 1e-4f) / 15.0f); emb = lane <= 16 ? cosf(band * w) : -sinf(band * w); } }
              float a = b1l;
#pragma unroll
              for (int j = 0; j < FE; ++j) a += __shfl(emb, j) * w1c[j];
              const float h1 = sinf(frl * a);
              float c = b2l;
#pragma unroll
              for (int j = 0; j < FH; ++j) c += __shfl(h1, j) * w2c[j];
              bf16_t* dst = isc ? (bf16_t*)(ws + WS_HIDC) + ((size_t)layer * CTX + l) * FH : (bf16_t*)(ws + WS_HIDL) + ((size_t)layer * SEQ + l) * FH;
              dst[lane] = (bf16_t)f2bf(sinf(frl * c)); } } }
    TS_MARK(1, MK_TS == 14); TS_MARK(0, MK_TS == 15);
    if ((int)blockIdx.x >= NGEMV) { for (int it = ((int)blockIdx.x - NGEMV) * NWAVES + wave; it < DEPTH * 64; it += (G - NGEMV) * NWAVES) { const int layer = it >> 6, np = (it & 63) * 64 + lane;
          const int j = (np & 1) * 2048 + ((np >> 1) & 1) * 1024 + (np >> 2);
          const float* w3 = Pp->in[15] + (size_t)layer * FH * 4096 + j;
          bf16_t* dst = (bf16_t*)(ws + WS_W3T) + ((size_t)layer * 4096 + np) * FH;
#pragma unroll
          for (int k8 = 0; k8 < 8; ++k8) { float v[8];
#pragma unroll
              for (int e = 0; e < 8; ++e) v[e] = w3[(size_t)(k8 * 8 + e) * 4096];
              u32x4 w; w.x = pk2(v[0], v[1]); w.y = pk2(v[2], v[3]); w.z = pk2(v[4], v[5]); w.w = pk2(v[6], v[7]);
              *(u32x4*)(dst + k8 * 8) = w; } } }
    TS_MARK(1, MK_TS == 15);
}

__device__ __forceinline__ void p0b(int G, const int wave_s) {
    FRESH_IDS; FRESH_KP;
    unsigned char* ws = Pp->ws; const int gt = blockIdx.x * NTHR + tid, NGT = G * NTHR;
    const float* MODP = (const float*)(ws + WS_MODP); float* MOD = (float*)(ws + WS_MOD);
    constexpr int NTOT = DEPTH * 3 * 6 * D;
    for (int i = gt; i < NTOT; i += NGT) { const int layer = i / (3 * 6 * D), n = i % (6 * D); float s = Pp->in[7][(size_t)layer * 6 * D + n];
#pragma unroll
        for (int kc = 0; kc < MOD_KC; ++kc) { const int rest = i % (3 * 6 * D); s += MODP[((size_t)(kc * DEPTH + layer) * 3) * 6 * D + rest]; }
        MOD[i] = s; ((bf16_t*)(ws + WS_MODB))[i] = (bf16_t)f2bf(s); }
}

template <int NLB> __device__ __forceinline__ void taps_items(int layer_lo, int nlayers, int first, int stride, const int wave_s) {
    FRESH_IDS; FRESH_KP;
    unsigned char* ws = Pp->ws;

    { typedef float f32x16_ __attribute__((ext_vector_type(16)));
      const int r32 = lane & 31, hi = lane >> 5;
      constexpr int IT_L = 128 * (128 / NLB), IT_C = 128 * (8 / NLB), PER = IT_L + IT_C;
      for (int it = first; it < nlayers * PER; it += stride) {
          const int layer = layer_lo + it / PER; int r = it % PER; const bool isc = r >= IT_L; if (isc) r -= IT_L;
          const int nb = r & 127, lc = r >> 7, L = isc ? CTX : SEQ; constexpr int nlb = NLB;
          const bf16_t* arow = (const bf16_t*)(ws + WS_W3T) + ((size_t)layer * 4096 + nb * 32 + r32) * FH + hi * 8;
          pg8::bf16x8 a[4];
#pragma unroll
          for (int s = 0; s < 4; ++s) a[s] = *(const pg8::bf16x8*)(arow + 16 * s);
          const bf16_t* hb = isc ? (const bf16_t*)(ws + WS_HIDC) + (size_t)layer * CTX * FH : (const bf16_t*)(ws + WS_HIDL) + (size_t)layer * SEQ * FH;
          unsigned* tf = isc ? (unsigned*)(ws + WS_FLTC) + (size_t)layer * HY * CTX : (unsigned*)(ws + WS_FLT) + (size_t)layer * HY * SEQ;
          unsigned* tb = isc ? (unsigned*)(ws + WS_FLTC) + (size_t)(DEPTH + layer) * HY * CTX : (unsigned*)(ws + WS_FLT) + (size_t)(DEPTH + layer) * HY * SEQ;
          float dl[8];
#pragma unroll
          for (int rp = 0; rp < 8; ++rp) { const int c = (nb * 32 + (2 * (rp & 1)) + 8 * (rp >> 1) + 4 * hi) >> 2;
              dl[rp] = fabsf(-3.0701134573253945f + (float)c * ((-15.350567286626973f + 3.0701134573253945f) / 1023.f)) * LOG2E; }
#pragma unroll 4
          for (int lb = 0; lb < nlb; ++lb) { const int l = (lc * NLB + lb) * 32 + r32;
              const bf16_t* brow = hb + (size_t)l * FH + hi * 8;
              f32x16_ acc;
#pragma unroll
              for (int q = 0; q < 16; ++q) acc[q] = 0.f;
#pragma unroll
              for (int s = 0; s < 4; ++s) acc = __builtin_amdgcn_mfma_f32_32x32x16_bf16(a[s], *(const pg8::bf16x8*)(brow + 16 * s), acc, 0, 0, 0);
              const float t = (float)l / (float)(L - 1);
#pragma unroll
              for (int rp = 0; rp < 8; ++rp) { const int rr = 2 * rp, n = nb * 32 + (rr & 3) + 8 * (rr >> 2) + 4 * hi, c = n >> 2, d = (n >> 1) & 1;
                  const float wdw = __builtin_amdgcn_exp2f(-t * dl[rp]);
                  const unsigned v = pk2(acc[rr] * wdw, acc[rr + 1] * wdw);
                  if (d == 0) tf[(size_t)c * L + l] = v; else tb[(size_t)c * L + l] = l == 0 ? 0u : v; } } } }
}

__device__ __forceinline__ void p0c(LAS unsigned char* lds, int G, const int wave_s) {
    FRESH_IDS; FRESH_KP;
    unsigned char* ws = Pp->ws;
    const int gw = blockIdx.x * NWAVES + wave, NGW = G * NWAVES;
    const int gt = blockIdx.x * NTHR + tid, NGT = G * NTHR;
    const float* MOD = (const float*)(ws + WS_MOD);
    volatile LAS unsigned* MISC = (volatile LAS unsigned*)(lds + MISC_OFF);
    TS_MARK(0, MK_TS == 30);
    { float* GMV = (float*)(ws + WS_GMV);
      for (int i = gt; i < DEPTH * 2 * 3 * D; i += NGT) { const int c = i % D, v = (i / D) % 3, which = (i / (3 * D)) % 2, layer = i / (6 * D);
          const float g = which ? Pp->in[5][layer * D + c] : Pp->in[4][layer * D + c];
          GMV[i] = g * (1.0f + MOD[((size_t)layer * 3 + v) * 6 * D + (which ? 4 : 1) * D + c]); } }
    TS_MARK(1, MK_TS == 30);
#pragma nounroll
    for (int st = 0; st < 3; ++st) { const int part = (wave & 1) ? 2 - st : st;
    if (part == 0) {

    { constexpr int NSUP = DEPTH * ((INW + 2 * FF) / 32), FIRST = 32 * (256 * NWAVES - NSUP);
      convert_shw(lds, gw, NGW, wave_s);
      (void)FIRST; }
    } else if (part == 1) {

    { bf16_t* AN = (bf16_t*)(ws + WS_AN); float* SSQ = (float*)(ws + WS_SSQ); float* SSQC = (float*)(ws + WS_SSQC);
      const int nlat = (ML + NGW - 1 - gw) / NGW;
      const int nctx = (int)blockIdx.x < MC / 32 ? 4 : 0;
#pragma unroll 2
      for (int i = 0; i < nlat + nctx; ++i) { const bool isc = i >= nlat; const int row = isc ? ML + (int)blockIdx.x * 32 + wave * 4 + (i - nlat) : gw + i * NGW;
          const int v = vec_of_row(row); const float* xr = isc ? Pp->in[2] + (size_t)(row - ML) * D : Pp->in[0] + (size_t)row * D; float s = 0.f;
#pragma unroll
          for (int j = 0; j < 4; ++j) { const int c = lane * 8 + 512 * j; const f32x4 a = __builtin_nontemporal_load((const f32x4*)(xr + c)), b = __builtin_nontemporal_load((const f32x4*)(xr + c + 4));
              s += (a[0] * a[0] + a[1] * a[1]) + (a[2] * a[2] + a[3] * a[3]) + (b[0] * b[0] + b[1] * b[1]) + (b[2] * b[2] + b[3] * b[3]);
              const f32x4 g0 = *(const f32x4*)(Pp->in[4] + c), g1 = *(const f32x4*)(Pp->in[4] + c + 4), m0 = *(const f32x4*)(MOD + (size_t)v * 6 * D + D + c), m1 = *(const f32x4*)(MOD + (size_t)v * 6 * D + D + c + 4);
              const f32x4 ga = a * g0 * (m0 + 1.0f), gb = b * g1 * (m1 + 1.0f);
              u32x4 w; w.x = pk2(ga[0], ga[1]); w.y = pk2(ga[2], ga[3]); w.z = pk2(gb[0], gb[1]); w.w = pk2(gb[2], gb[3]);
              *(u32x4*)(AN + (size_t)row * D + c) = w; }
          s = wave_sum(s);
          if (!isc) { if (lane < 32) SSQ[((size_t)(lane >> 2) * MT + row) * 4 + (lane & 3)] = lane == 0 ? s : 0.f; }
          else if (lane < 32) SSQC[(size_t)lane * MC + (row - ML)] = lane == 0 ? s : 0.f; } }
    } else {
    taps_items<8>(0, 1, gw, NGW, wave_s);
    } }
    TS_MARK(1, MK_TS == 33);
}

__device__ __forceinline__ void attn_simple(LAS unsigned char* lds, int layer, int G, int nrows, const int wave_s) {
    FRESH_IDS; FRESH_KP;
    unsigned char* ws = Pp->ws;
    const bf16_t* Q = (const bf16_t*)(ws + WS_Q); const bf16_t* Kb = (const bf16_t*)(ws + WS_K); const bf16_t* Vb = (const bf16_t*)(ws + WS_V);
    bf16_t* YM = (bf16_t*)(ws + WS_YM);
    LAS float* qs = (LAS float*)lds + wave * HD;
    LAS float* ps = (LAS float*)(lds + 4096) + wave * 640;
    LAS float* red = (LAS float*)(lds + 4096 + 8 * 640 * 4);
    const int h = wave, kv = h >> 2;
    const float sk = Pp->in[18][layer * NH + h] * LOG2E;
    const float* gat = Pp->in[20] + layer * ATTW; const float* ghy = Pp->in[19] + layer * HY; const float* ZT = (const float*)(ws + WS_SSHY);
    for (int row = blockIdx.x; row < nrows; row += G) {
        { const unsigned w = *(const unsigned*)(Q + (size_t)row * ATTW + h * HD + 2 * lane); qs[2 * lane] = bf_lo(w); qs[2 * lane + 1] = bf_hi(w); }
        int b, j0 = 0, nwin = 0;
        if (row < ML) { b = row / SEQ; const int l = row % SEQ; j0 = l - WINDOW < 0 ? 0 : l - WINDOW; const int j1 = l + WINDOW > SEQ - 1 ? SEQ - 1 : l + WINDOW; nwin = j1 - j0 + 1; }
        else b = (row - ML) / CTX;
        const int nk = nwin + CTX;
        float mx = -3.0e38f;
        for (int j = lane; j < nk; j += 64) {
            const int krow = j < nwin ? b * SEQ + j0 + j : ML + b * CTX + (j - nwin);
            const bf16_t* kr = Kb + (size_t)krow * KVW + kv * HD;
            float s = 0.f;
#pragma unroll
            for (int d = 0; d < HD; d += 8) { const u32x4 w = *(const u32x4*)(kr + d);
                s += qs[d] * bf_lo(w.x) + qs[d + 1] * bf_hi(w.x) + qs[d + 2] * bf_lo(w.y) + qs[d + 3] * bf_hi(w.y) + qs[d + 4] * bf_lo(w.z) + qs[d + 5] * bf_hi(w.z) + qs[d + 6] * bf_lo(w.w) + qs[d + 7] * bf_hi(w.w); }
            ps[j] = s; mx = fmaxf(mx, s);
        }
        mx = fmaxf(wave_max(mx), sk);
        float sum = 0.f;
        for (int j = lane; j < nk; j += 64) { const float e = __builtin_amdgcn_exp2f(ps[j] - mx); ps[j] = e; sum += e; }
        sum = wave_sum(sum) + __builtin_amdgcn_exp2f(sk - mx);
        float o0 = 0.f, o1 = 0.f;
        for (int j = 0; j < nk; ++j) {
            const int krow = j < nwin ? b * SEQ + j0 + j : ML + b * CTX + (j - nwin);
            const unsigned w = *(const unsigned*)(Vb + (size_t)krow * KVW + kv * HD + 2 * lane);
            const float pj = ps[j]; o0 += pj * bf_lo(w); o1 += pj * bf_hi(w);
        }
        const float inv = 1.f / sum; o0 *= inv; o1 *= inv;
        const float part = wave_sum(o0 * o0 + o1 * o1);
        const float z0 = ZT[(size_t)(2 * tid) * MT + row], z1 = ZT[(size_t)(2 * tid + 1) * MT + row];
        const float parth = wave_sum(z0 * z0 + z1 * z1);
        __syncthreads();
        if (lane == 0) { red[wave] = part; red[8 + wave] = parth; }
        __syncthreads();
        float tot = 0.f, toth = 0.f;
#pragma unroll
        for (int i = 0; i < 8; ++i) { tot += red[i]; toth += red[8 + i]; }
        const float r = 1.0f / sqrtf(tot * (1.0f / ATTW) + EPS), rh = 1.0f / sqrtf(toth * (1.0f / HY) + EPS);
        const int c = h * HD + 2 * lane;
        *(unsigned*)(YM + (size_t)row * D + HY + c) = pk2(o0 * r * gat[c], o1 * r * gat[c + 1]);
        *(unsigned*)(YM + (size_t)row * D + 2 * tid) = pk2(z0 * rh * ghy[2 * tid], z1 * rh * ghy[2 * tid + 1]);
    }
    __syncthreads();
}

__device__ __forceinline__ float phy_at(const bf16_t* PHY, int row, int ch) { return bf1(PHY[((size_t)(ch >> 2) * MT + row) * 4 + (ch & 3)]); }
__device__ __forceinline__ float sconv(const bf16_t* PHY, const float* cw, const float* cb, int row, int ch, int l, int L) {
    float a = cb[ch] + cw[3 * HY + ch] * phy_at(PHY, row, ch);
    if (l > 0) a += cw[ch] * phy_at(PHY, row - 1, ch);
    if (l < L - 1) a += cw[2 * 3 * HY + ch] * phy_at(PHY, row + 1, ch);
    return a;
}
template <int L>
__device__ __forceinline__ void hyena_direct(LAS unsigned char* lds, int layer, int G, int row_base, const int wave_s) {
    FRESH_IDS; FRESH_KP;
    unsigned char* ws = Pp->ws;
    constexpr int TPB = L < NTHR ? L : NTHR, NI = L / TPB;
    const bf16_t* PHY = (const bf16_t*)(ws + WS_PHY); float* ZT = (float*)(ws + WS_SSHY);
    const unsigned* TF = L == SEQ ? (const unsigned*)(ws + WS_FLT) + (size_t)layer * HY * SEQ : (const unsigned*)(ws + WS_FLTC) + (size_t)layer * HY * CTX;
    const unsigned* TB = L == SEQ ? (const unsigned*)(ws + WS_FLT) + (size_t)(DEPTH + layer) * HY * SEQ : (const unsigned*)(ws + WS_FLTC) + (size_t)(DEPTH + layer) * HY * CTX;
    const float* cw = Pp->in[9] + (size_t)layer * 3 * 3 * HY; const float* cb = Pp->in[10] + (size_t)layer * 3 * HY;
    const float* fbias = Pp->in[17] + (size_t)layer * 2 * HY;
    LAS float* G0 = (LAS float*)lds; LAS float* G1 = G0 + 2 * L; LAS float* z = G1 + 2 * L;
    for (int it = blockIdx.x; it < HY * BATCH; it += G) {
        const int c = it % HY, seq = it / HY, row0 = row_base + seq * L;
        __syncthreads();
#pragma nounroll
        for (int d = tid; d < L; d += NTHR) {
            { const unsigned f = TF[(size_t)c * L + d]; G0[L - 1 + d] = bf_lo(f); G1[L - 1 + d] = bf_hi(f); }
            if (d > 0) { const unsigned bk = TB[(size_t)c * L + d]; G0[L - 1 - d] = bf_lo(bk); G1[L - 1 - d] = bf_hi(bk); }
            z[d] = sconv(PHY, cw, cb, row0 + d, 2 * HY + c, d, L);
        }
        __syncthreads();
#pragma unroll
        for (int o = 0; o < 2; ++o) {
            LAS float* Gg = o ? G1 : G0;
            float acc[NI], zn[NI];
#pragma unroll
            for (int i = 0; i < NI; ++i) acc[i] = 0.f;
            if (tid < TPB) {
                for (int s = 0; s < L; ++s) { const float zs = z[s];
#pragma unroll
                    for (int i = 0; i < NI; ++i) acc[i] += zs * Gg[tid + TPB * i - s + L - 1]; }
                const float fb = fbias[o * HY + c];
#pragma nounroll
                for (int i = 0; i < NI; ++i) { const int t = tid + TPB * i; zn[i] = sconv(PHY, cw, cb, row0 + t, o * HY + c, t, L) * (acc[i] + fb * z[t]); }
            }
            __syncthreads();
            if (tid < TPB) {
#pragma unroll
                for (int i = 0; i < NI; ++i) z[tid + TPB * i] = zn[i];
            }
            __syncthreads();
        }
        if (tid < TPB) {
#pragma unroll
            for (int i = 0; i < NI; ++i) { const int t = tid + TPB * i; ZT[(size_t)c * MT + row0 + t] = z[t]; } }
    }
    __syncthreads();
}

__device__ __forceinline__ void hyena_ctx(LAS unsigned char* lds, int layer, int first, int stride, const int wave_s) {
    FRESH_IDS; FRESH_KP;
    unsigned char* ws = Pp->ws;
    constexpr int L = CTX;
    const bf16_t* PHY = (const bf16_t*)(ws + WS_PHY); float* ZT = (float*)(ws + WS_SSHY);
    const unsigned* TF = (const unsigned*)(ws + WS_FLTC) + (size_t)layer * HY * CTX; const unsigned* TB = (const unsigned*)(ws + WS_FLTC) + (size_t)(DEPTH + layer) * HY * CTX;
    const float* cw = Pp->in[9] + (size_t)layer * 3 * 3 * HY; const float* cb = Pp->in[10] + (size_t)layer * 3 * HY; const float* fbias = Pp->in[17] + (size_t)layer * 2 * HY;
    const int half = tid >> 8, t = tid & 255;
    LAS float* Gb = (LAS float*)(lds + half * 8192);
    LAS float* zb = Gb + 1024;
    for (int it = first; it < HY / 2; it += stride) {
        const int c = 2 * it + half;
        __syncthreads();
        { const unsigned f = TF[(size_t)c * L + t]; Gb[255 + t] = bf_lo(f); Gb[512 + 255 + t] = bf_hi(f);
          if (t > 0) { const unsigned bk = TB[(size_t)c * L + t]; Gb[255 - t] = bf_lo(bk); Gb[512 + 255 - t] = bf_hi(bk); }
          zb[t] = sconv(PHY, cw, cb, ML + t, 2 * HY + c, t, L); zb[256 + t] = sconv(PHY, cw, cb, ML + L + t, 2 * HY + c, t, L); }
        float gte[2][2];
#pragma unroll
        for (int o = 0; o < 2; ++o) { gte[o][0] = sconv(PHY, cw, cb, ML + t, o * HY + c, t, L); gte[o][1] = sconv(PHY, cw, cb, ML + L + t, o * HY + c, t, L); }
        __syncthreads();
#pragma unroll
        for (int o = 0; o < 2; ++o) {
            const LAS float* Gg = Gb + o * 512 + t + 255;
            float a0 = 0.f, a1 = 0.f;
#pragma unroll 4
            for (int s = 0; s < L; s += 4) { const f32x4 z0 = *(const LAS f32x4*)(zb + s), z1 = *(const LAS f32x4*)(zb + 256 + s);
#pragma unroll
                for (int e = 0; e < 4; ++e) { const float g = Gg[-(s + e)]; a0 += z0[e] * g; a1 += z1[e] * g; } }
            const float fb = fbias[o * HY + c];
            const float n0 = gte[o][0] * (a0 + fb * zb[t]);
            const float n1 = gte[o][1] * (a1 + fb * zb[256 + t]);
            __syncthreads();
            zb[t] = n0; zb[256 + t] = n1;
            __syncthreads();
        }
        ZT[(size_t)c * MT + ML + t] = zb[t]; ZT[(size_t)c * MT + ML + L + t] = zb[256 + t];
    }
    __syncthreads();
}

constexpr int FN = 8192, FPAD = FN + FN / 32;
__device__ __forceinline__ int fpad(int p) { return p + (p >> 5); }
__device__ __forceinline__ f32x2 cmul(f32x2 a, f32x2 b) { return (f32x2){a.x * b.x - a.y * b.y, a.x * b.y + a.y * b.x}; }
__device__ __forceinline__ f32x2 cmulc(f32x2 a, f32x2 b) { return (f32x2){a.x * b.x + a.y * b.y, a.y * b.x - a.x * b.y}; }
template <bool INV> __device__ __forceinline__ f32x2 cmul_tw(f32x2 a, f32x2 w) { return INV ? cmulc(a, w) : cmul(a, w); }
template <bool INV> __device__ __forceinline__ void dft4(f32x2& x0, f32x2& x1, f32x2& x2, f32x2& x3) {
    const f32x2 t0 = x0 + x2, t1 = x0 - x2, t2 = x1 + x3, t3 = x1 - x3;
    const f32x2 jt3 = INV ? (f32x2){-t3.y, t3.x} : (f32x2){t3.y, -t3.x};
    x0 = t0 + t2; x2 = t0 - t2; x1 = t1 + jt3; x3 = t1 - jt3;
}
template <bool INV> __device__ __forceinline__ void dft16(f32x2 (&x)[16]) {
    constexpr float C1 = 0.92387953251128674f, S1 = 0.38268343236508977f, C2 = 0.70710678118654752f;
#pragma unroll
    for (int b = 0; b < 4; ++b) dft4<INV>(x[b], x[4 + b], x[8 + b], x[12 + b]);
    const f32x2 w1 = {C1, -S1}, w2 = {C2, -C2}, w3 = {S1, -C1}, w4 = {0.f, -1.f}, w6 = {-C2, -C2}, w9 = {-C1, S1};
    x[4 * 1 + 1] = cmul_tw<INV>(x[5], w1); x[4 * 1 + 2] = cmul_tw<INV>(x[6], w2); x[4 * 1 + 3] = cmul_tw<INV>(x[7], w3);
    x[4 * 2 + 1] = cmul_tw<INV>(x[9], w2); x[4 * 2 + 2] = cmul_tw<INV>(x[10], w4); x[4 * 2 + 3] = cmul_tw<INV>(x[11], w6);
    x[4 * 3 + 1] = cmul_tw<INV>(x[13], w3); x[4 * 3 + 2] = cmul_tw<INV>(x[14], w6); x[4 * 3 + 3] = cmul_tw<INV>(x[15], w9);
#pragma unroll
    for (int c = 0; c < 4; ++c) dft4<INV>(x[4 * c], x[4 * c + 1], x[4 * c + 2], x[4 * c + 3]);
    f32x2 y[16];
#pragma unroll
    for (int k = 0; k < 16; ++k) y[k] = x[4 * (k & 3) + (k >> 2)];
#pragma unroll
    for (int k = 0; k < 16; ++k) x[k] = y[k];
}
__device__ __forceinline__ void dft16_fwd_lo(f32x2 (&x)[16]) {
    constexpr float C1 = 0.92387953251128674f, S1 = 0.38268343236508977f, C2 = 0.70710678118654752f;
#pragma unroll
    for (int b = 0; b < 4; ++b) { const f32x2 x0 = x[b], x1 = x[4 + b]; const f32x2 j1 = {x1.y, -x1.x};
        x[b] = x0 + x1; x[4 + b] = x0 + j1; x[8 + b] = x0 - x1; x[12 + b] = x0 - j1; }
    const f32x2 w1 = {C1, -S1}, w2 = {C2, -C2}, w3 = {S1, -C1}, w4 = {0.f, -1.f}, w6 = {-C2, -C2}, w9 = {-C1, S1};
    x[5] = cmul(x[5], w1); x[6] = cmul(x[6], w2); x[7] = cmul(x[7], w3);
    x[9] = cmul(x[9], w2); x[10] = cmul(x[10], w4); x[11] = cmul(x[11], w6);
    x[13] = cmul(x[13], w3); x[14] = cmul(x[14], w6); x[15] = cmul(x[15], w9);
#pragma unroll
    for (int c = 0; c < 4; ++c) dft4<false>(x[4 * c], x[4 * c + 1], x[4 * c + 2], x[4 * c + 3]);
    f32x2 y[16];
#pragma unroll
    for (int k = 0; k < 16; ++k) y[k] = x[4 * (k & 3) + (k >> 2)];
#pragma unroll
    for (int k = 0; k < 16; ++k) x[k] = y[k];
}
__device__ __forceinline__ void dft16_inv_lo(f32x2 (&x)[16]) {
    constexpr float C1 = 0.92387953251128674f, S1 = 0.38268343236508977f, C2 = 0.70710678118654752f;
#pragma unroll
    for (int b = 0; b < 4; ++b) dft4<true>(x[b], x[4 + b], x[8 + b], x[12 + b]);
    const f32x2 w1 = {C1, -S1}, w2 = {C2, -C2}, w3 = {S1, -C1}, w4 = {0.f, -1.f}, w6 = {-C2, -C2}, w9 = {-C1, S1};
    x[5] = cmulc(x[5], w1); x[6] = cmulc(x[6], w2); x[7] = cmulc(x[7], w3);
    x[9] = cmulc(x[9], w2); x[10] = cmulc(x[10], w4); x[11] = cmulc(x[11], w6);
    x[13] = cmulc(x[13], w3); x[14] = cmulc(x[14], w6); x[15] = cmulc(x[15], w9);
    f32x2 y[8];
#pragma unroll
    for (int c = 0; c < 4; ++c) { const f32x2 t0 = x[4 * c] + x[4 * c + 2], t1 = x[4 * c] - x[4 * c + 2], t2 = x[4 * c + 1] + x[4 * c + 3], t3 = x[4 * c + 1] - x[4 * c + 3];
        y[c] = t0 + t2; y[4 + c] = t1 + (f32x2){-t3.y, t3.x}; }
#pragma unroll
    for (int k = 0; k < 8; ++k) x[k] = y[k];
}
template <bool INV> __device__ __forceinline__ void dft32(f32x2 (&x)[32]) {
    constexpr float CS[16] = {1.f, 0.98078528040323043f, 0.92387953251128674f, 0.83146961230254524f, 0.70710678118654752f, 0.55557023301960218f, 0.38268343236508977f, 0.19509032201612825f,
                              0.f, -0.19509032201612825f, -0.38268343236508977f, -0.55557023301960218f, -0.70710678118654752f, -0.83146961230254524f, -0.92387953251128674f, -0.98078528040323043f};
    constexpr float SN[16] = {0.f, 0.19509032201612825f, 0.38268343236508977f, 0.55557023301960218f, 0.70710678118654752f, 0.83146961230254524f, 0.92387953251128674f, 0.98078528040323043f,
                              1.f, 0.98078528040323043f, 0.92387953251128674f, 0.83146961230254524f, 0.70710678118654752f, 0.55557023301960218f, 0.38268343236508977f, 0.19509032201612825f};
    f32x2 a[16], b[16];
#pragma unroll
    for (int j = 0; j < 16; ++j) { a[j] = x[j] + x[j + 16]; const f32x2 d = x[j] - x[j + 16]; b[j] = cmul_tw<INV>(d, (f32x2){CS[j], -SN[j]}); }
    dft16<INV>(a); dft16<INV>(b);
#pragma unroll
    for (int k = 0; k < 16; ++k) { x[2 * k] = a[k]; x[2 * k + 1] = b[k]; }
}
__device__ __forceinline__ void tw_powers(f32x2 w1, f32x2 (&w)[16]) {
    w[1] = w1; w[2] = cmul(w1, w1); w[3] = cmul(w[2], w1); w[4] = cmul(w[2], w[2]); w[5] = cmul(w[4], w1); w[6] = cmul(w[3], w[3]); w[7] = cmul(w[4], w[3]);
    w[8] = cmul(w[4], w[4]); w[9] = cmul(w[8], w1); w[10] = cmul(w[5], w[5]); w[11] = cmul(w[8], w[3]); w[12] = cmul(w[6], w[6]); w[13] = cmul(w[8], w[5]); w[14] = cmul(w[7], w[7]); w[15] = cmul(w[8], w[7]);
}
__device__ __forceinline__ f32x2 tw_base(float turns) { asm volatile("" : "+v"(turns)); return (f32x2){__builtin_amdgcn_cosf(turns), -__builtin_amdgcn_sinf(turns)}; }
template <bool LO> __device__ __forceinline__ void fft_fwd1(f32x2 (&x)[16], LAS f32x2* B, int n2, const f32x2 (&w)[16]) {
    asm volatile("" : "+v"(n2));
    if (LO) dft16_fwd_lo(x); else dft16<false>(x);
    B[fpad(n2)] = x[0];
#pragma unroll
    for (int k = 1; k < 16; ++k) B[fpad(512 * k + n2)] = cmul(x[k], w[k]);
}
__device__ __forceinline__ void fft_fwd2(LAS f32x2* B, const LAS f32x2* TW2, int tid) {
    asm volatile("" : "+v"(tid));
    const int b = tid >> 5, n2 = tid & 31, base = 512 * b + n2; f32x2 x[16];
#pragma unroll
    for (int r = 0; r < 16; ++r) x[r] = B[fpad(base + 32 * r)];
    dft16<false>(x);
    B[fpad(base)] = x[0];
#pragma unroll
    for (int k = 1; k < 16; ++k) B[fpad(base + 32 * k)] = cmul(x[k], TW2[k * 32 + n2]);
}
__device__ __forceinline__ void fft_inv2(LAS f32x2* B, const LAS f32x2* TW2, int tid) {
    asm volatile("" : "+v"(tid));
    const int b = tid >> 5, n2 = tid & 31, base = 512 * b + n2; f32x2 x[16];
    x[0] = B[fpad(base)];
#pragma unroll
    for (int k = 1; k < 16; ++k) x[k] = cmulc(B[fpad(base + 32 * k)], TW2[k * 32 + n2]);
    dft16<true>(x);
#pragma unroll
    for (int r = 0; r < 16; ++r) B[fpad(base + 32 * r)] = x[r];
}
template <int MODE> __device__ __forceinline__ void fft_pair32(LAS f32x2* B, const LAS f32x2* F, int wave, int lane) {
    asm volatile("" : "+v"(lane));
    constexpr float CS[16] = {1.f, 0.98078528040323043f, 0.92387953251128674f, 0.83146961230254524f, 0.70710678118654752f, 0.55557023301960218f, 0.38268343236508977f, 0.19509032201612825f,
                              0.f, -0.19509032201612825f, -0.38268343236508977f, -0.55557023301960218f, -0.70710678118654752f, -0.83146961230254524f, -0.92387953251128674f, -0.98078528040323043f};
    constexpr float SN[16] = {0.f, 0.19509032201612825f, 0.38268343236508977f, 0.55557023301960218f, 0.70710678118654752f, 0.83146961230254524f, 0.92387953251128674f, 0.98078528040323043f,
                              1.f, 0.98078528040323043f, 0.92387953251128674f, 0.83146961230254524f, 0.70710678118654752f, 0.55557023301960218f, 0.38268343236508977f, 0.19509032201612825f};
    const int hi = lane >> 5, blk = 32 * wave + (lane & 31); const float sg = hi ? -1.f : 1.f;
    LAS f32x2* p = B + 33 * blk; f32x2 v[16];
#pragma unroll
    for (int j = 0; j < 16; ++j) { const f32x2 d = p[j] + p[j + 16] * sg;
        const f32x2 w = {hi ? CS[j] : 1.f, hi ? -SN[j] : 0.f}; v[j] = j == 0 ? d : cmul(d, w); }
    dft16<false>(v);
    if (MODE == 2) {
#pragma unroll
        for (int k = 0; k < 16; ++k) p[2 * k + hi] = v[k];
        return; }
    const int k1 = blk >> 4, k2 = blk & 15, kb1 = (16 - k1) & 15, b1 = k1 != 0 ? 1 : 0, kb2 = (16 - k2 - b1) & 15, b2 = (k2 != 0 || b1) ? 1 : 0;
    const LAS f32x2* fa = F + 33 * blk; const LAS f32x2* fb = F + 33 * (16 * kb1 + kb2);
    const LAS f32x2* fah = fa + hi; const LAS f32x2* fbh = fb + (1 - b2) - hi;
    constexpr float SC = 1.0f / (2.0f * (float)FN);
#pragma unroll
    for (int k = 0; k < 16; ++k) { const f32x2 A = fah[2 * k]; f32x2 Bm = fbh[31 - 2 * k];
        if (k == 0) { const f32x2 m0 = b2 ? fb[31] : fa[0]; Bm = hi ? Bm : m0; }
        const f32x2 H = MODE == 0 ? (f32x2){(A.x + Bm.x) * SC, (A.y - Bm.y) * SC} : (f32x2){(A.y + Bm.y) * SC, (Bm.x - A.x) * SC};
        v[k] = cmul(v[k], H); }
    dft16<true>(v);
#pragma unroll
    for (int j = 0; j < 16; ++j) { const f32x2 w = {hi ? CS[j] : 1.f, hi ? -SN[j] : 0.f}; const f32x2 u = j == 0 ? v[j] : cmulc(v[j], w);
        const auto rx = __builtin_amdgcn_permlane32_swap(__float_as_uint(u.x), __float_as_uint(u.x), false, false);
        const auto ry = __builtin_amdgcn_permlane32_swap(__float_as_uint(u.y), __float_as_uint(u.y), false, false);
        const f32x2 a = {__uint_as_float(rx[0]), __uint_as_float(ry[0])}, b = {__uint_as_float(rx[1]), __uint_as_float(ry[1])};
        p[16 * hi + j] = a + b * sg; }
}
__device__ __forceinline__ void fft_inv1(f32x2 (&x)[16], const LAS f32x2* B, int n2, const f32x2 (&w)[16]) {
    asm volatile("" : "+v"(n2));
    x[0] = B[fpad(n2)];
#pragma unroll
    for (int k = 1; k < 16; ++k) x[k] = cmulc(B[fpad(512 * k + n2)], w[k]);
    dft16_inv_lo(x);
}
#define WG_SYNC() do { asm volatile("s_waitcnt lgkmcnt(0)" ::: "memory"); __builtin_amdgcn_s_barrier(); asm volatile("" ::: "memory"); } while (0)
__device__ __forceinline__ void hy_stage(LAS float* plane, const bf16_t* PHY, int cg, int jc, int tid) {
    asm volatile("" : "+v"(tid));
    const u32x4* src = (const u32x4*)(PHY + (size_t)cg * MT * 4);
#pragma unroll
    for (int k = 0; k < 8; ++k) { const int i = tid + 512 * k; const u32x4 v = src[i];
        const unsigned w0 = (jc & 2) ? v.y : v.x, w1 = (jc & 2) ? v.w : v.z;
        f32x2 o; o.x = (jc & 1) ? bf_hi(w0) : bf_lo(w0); o.y = (jc & 1) ? bf_hi(w1) : bf_lo(w1);
        *(LAS f32x2*)(plane + 2 * i) = o; }
}
__device__ __forceinline__ void hy_sconv(const LAS float* plane, float w0, float w1, float w2, float cb, int n2, float (&u)[8][2]) {
    asm volatile("" : "+v"(n2));
#pragma unroll
    for (int r = 0; r < 8; ++r)
#pragma unroll
        for (int b = 0; b < 2; ++b) { const int t = n2 + 512 * r, row = b * SEQ + t;
            float a = cb + w1 * plane[row];
            if (t > 0) a += w0 * plane[row - 1];
            if (t < SEQ - 1) a += w2 * plane[row + 1];
            u[r][b] = a; }
}
#define WAVE_FENCE() do { asm volatile("s_waitcnt lgkmcnt(0)" ::: "memory"); __builtin_amdgcn_sched_barrier(0); } while (0)
constexpr int HY_TW2 = RING_BYTES + 1024;
__device__ __forceinline__ void hyena_fft(LAS unsigned char* lds, int layer, int G, const int wave_s) {
    FRESH_IDS; FRESH_KP;
    unsigned char* ws = Pp->ws;
    const bf16_t* PHY = (const bf16_t*)(ws + WS_PHY); float* ZT = (float*)(ws + WS_SSHY);
    const unsigned* TF = (const unsigned*)(ws + WS_FLT) + (size_t)layer * HY * SEQ; const unsigned* TB = (const unsigned*)(ws + WS_FLT) + (size_t)(DEPTH + layer) * HY * SEQ;
    const float* cw = Pp->in[9] + (size_t)layer * 3 * 3 * HY; const float* cb = Pp->in[10] + (size_t)layer * 3 * HY; const float* fbias = Pp->in[17] + (size_t)layer * 2 * HY;
    LAS f32x2* Db = (LAS f32x2*)lds; LAS f32x2* Fb = Db + FPAD; LAS f32x2* TW2 = (LAS f32x2*)(lds + HY_TW2);
    LAS float* pl0 = (LAS float*)lds; LAS float* pl1 = pl0 + 2 * SEQ;
    const int n2 = tid;
    TW2[tid] = tw_base((float)((tid & 31) * (tid >> 5)) * (1.0f / 512.f));
    f32x2 w1p[16]; tw_powers(tw_base((float)n2 * (1.0f / 8192.f)), w1p); w1p[0] = (f32x2){1.f, 0.f};
    int c_lo = 4 * (int)blockIdx.x, c_hi = c_lo + 4;
    if (layer == DEPTH - 1) { const int b = (int)blockIdx.x, i2 = b - NQKV, n5 = HY - 3 * NQKV - 4 * (256 - NQKV);
        if (b < NQKV) { c_lo = 3 * b; c_hi = c_lo + 3; } else if (i2 < n5) { c_lo = 3 * NQKV + 5 * i2; c_hi = c_lo + 5; } else { c_lo = 3 * NQKV + 5 * n5 + 4 * (i2 - n5); c_hi = c_lo + 4; } }
    {
#pragma nounroll
        for (int c = c_lo; c < c_hi; ++c) { const int unit = c >> 2, jc = c & 3;
            WG_SYNC();
            { f32x2 x[16]; const unsigned* tf = TF + (size_t)c * SEQ; const unsigned* tb = TB + (size_t)c * SEQ;
#pragma unroll
              for (int r = 0; r < 8; ++r) { const unsigned w = tf[n2 + 512 * r]; x[r] = (f32x2){bf_lo(w), bf_hi(w)}; }
#pragma unroll
              for (int r = 8; r < 16; ++r) { const int l = FN - 512 * r - n2; const unsigned w = l < SEQ ? tb[l] : 0u; x[r] = (f32x2){bf_lo(w), bf_hi(w)}; }
              __builtin_amdgcn_sched_barrier(0); fft_fwd1<false>(x, Fb, n2, w1p); __builtin_amdgcn_sched_barrier(0); }
            hy_stage(pl0, PHY, 2 * (HY / 4) + unit, jc, tid); __builtin_amdgcn_sched_barrier(0); hy_stage(pl1, PHY, unit, jc, tid); __builtin_amdgcn_sched_barrier(0);
            WG_SYNC();
            float uz[8][2], ux[8][2];
            hy_sconv(pl0, cw[2 * HY + c], cw[3 * HY + 2 * HY + c], cw[6 * HY + 2 * HY + c], cb[2 * HY + c], n2, uz);
            __builtin_amdgcn_sched_barrier(0); hy_sconv(pl1, cw[c], cw[3 * HY + c], cw[6 * HY + c], cb[c], n2, ux); __builtin_amdgcn_sched_barrier(0);
            fft_fwd2(Fb, TW2, tid); WAVE_FENCE(); fft_pair32<2>(Fb, Fb, wave, lane); __builtin_amdgcn_sched_barrier(0);
            WG_SYNC();
            f32x2 x[16];
#pragma unroll
            for (int r = 0; r < 8; ++r) { x[r] = (f32x2){uz[r][0], uz[r][1]}; x[r + 8] = (f32x2){0.f, 0.f}; }
            fft_fwd1<true>(x, Db, n2, w1p); WG_SYNC();
            fft_fwd2(Db, TW2, tid); WAVE_FENCE(); fft_pair32<0>(Db, Fb, wave, lane); WAVE_FENCE(); fft_inv2(Db, TW2, tid);
            WG_SYNC(); fft_inv1(x, Db, n2, w1p);
            { const float fb0 = fbias[c];
#pragma unroll
              for (int r = 0; r < 8; ++r) { uz[r][0] = ux[r][0] * (x[r].x + fb0 * uz[r][0]); uz[r][1] = ux[r][1] * (x[r].y + fb0 * uz[r][1]); } }
            WG_SYNC();
            hy_stage(pl0, PHY, (HY / 4) + unit, jc, tid);
            WG_SYNC();
            hy_sconv(pl0, cw[HY + c], cw[3 * HY + HY + c], cw[6 * HY + HY + c], cb[HY + c], n2, ux);
            WG_SYNC();
#pragma unroll
            for (int r = 0; r < 8; ++r) { x[r] = (f32x2){uz[r][0], uz[r][1]}; x[r + 8] = (f32x2){0.f, 0.f}; }
            fft_fwd1<true>(x, Db, n2, w1p); WG_SYNC();
            fft_fwd2(Db, TW2, tid); WAVE_FENCE(); fft_pair32<1>(Db, Fb, wave, lane); WAVE_FENCE(); fft_inv2(Db, TW2, tid);
            WG_SYNC(); fft_inv1(x, Db, n2, w1p);
            { const float fb1 = fbias[HY + c]; float* zo = ZT + (size_t)c * MT;
#pragma unroll
              for (int r = 0; r < 8; ++r) { const int t = n2 + 512 * r;
                  zo[t] = ux[r][0] * (x[r].x + fb1 * uz[r][0]); zo[SEQ + t] = ux[r][1] * (x[r].y + fb1 * uz[r][1]); } }
        }
    }
    WG_SYNC();
}

using f32x16 = __attribute__((ext_vector_type(16))) float;
using s16x4 = __attribute__((ext_vector_type(4))) short;
using bf16x8 = pg8::bf16x8;
#define AT_KSWZ(row, colB) ((row) * 256 + ((colB) ^ (((row) & 7) << 4)))
__device__ __forceinline__ int crow(int r, int hi) { return (r & 3) + 8 * (r >> 2) + 4 * hi; }
__device__ __forceinline__ unsigned cvtpk(float lo, float hi) { unsigned r; asm volatile("v_cvt_pk_bf16_f32 %0, %1, %2" : "=v"(r) : "v"(lo), "v"(hi)); return r; }
__device__ __forceinline__ int v_st(int k, int c) { const int kk = (k & ~0xC) | ((k & 4) << 1) | ((k & 8) >> 1); return ((kk >> 3) * 4 + (c >> 5)) * 512 + ((kk & 7) * 32 + (c & 31)) * 2; }
__device__ __forceinline__ int v_rd_base(int lane) { return ((lane & 3) << 3) | (((lane >> 2) & 3) << 6) | (((lane >> 4) & 1) << 5) | (((lane >> 5) & 1) << 8); }
constexpr int v_rd_off(int d0, int ks, int half) { return d0 * 512 + ks * 4096 + half * 2048; }
template <int OFF> __device__ __forceinline__ s16x4 tr_read(int vb) { s16x4 r; asm volatile("ds_read_b64_tr_b16 %0, %1 offset:%2" : "=&v"(r) : "v"(vb), "i"(OFF) : "memory"); return r; }
template <int D0> __device__ __forceinline__ void pv_one(f32x16& od, int vb, bf16x8 pa0, bf16x8 pa1) {
    const s16x4 l0 = tr_read<v_rd_off(D0, 0, 0)>(vb), h0 = tr_read<v_rd_off(D0, 0, 1)>(vb), l1 = tr_read<v_rd_off(D0, 1, 0)>(vb), h1 = tr_read<v_rd_off(D0, 1, 1)>(vb);
    asm volatile("s_waitcnt lgkmcnt(0)" ::: "memory"); __builtin_amdgcn_sched_barrier(0);
#define AT_PK(L, H) (bf16x8){L[0], L[1], L[2], L[3], H[0], H[1], H[2], H[3]}
    od = __builtin_amdgcn_mfma_f32_32x32x16_bf16(pa0, AT_PK(l0, h0), od, 0, 0, 0);
    od = __builtin_amdgcn_mfma_f32_32x32x16_bf16(pa1, AT_PK(l1, h1), od, 0, 0, 0);
#undef AT_PK
}
template <int D0> __device__ __forceinline__ void pv_one4(f32x16& od, int vb, bf16x8 pa0, bf16x8 pa1, bf16x8 pa2, bf16x8 pa3) {
    const s16x4 l0 = tr_read<v_rd_off(D0, 0, 0)>(vb), h0 = tr_read<v_rd_off(D0, 0, 1)>(vb), l1 = tr_read<v_rd_off(D0, 1, 0)>(vb), h1 = tr_read<v_rd_off(D0, 1, 1)>(vb);
    const s16x4 l2 = tr_read<v_rd_off(D0, 2, 0)>(vb), h2 = tr_read<v_rd_off(D0, 2, 1)>(vb), l3 = tr_read<v_rd_off(D0, 3, 0)>(vb), h3 = tr_read<v_rd_off(D0, 3, 1)>(vb);
    asm volatile("s_waitcnt lgkmcnt(0)" ::: "memory"); __builtin_amdgcn_sched_barrier(0);
#define AT_PK(L, H) (bf16x8){L[0], L[1], L[2], L[3], H[0], H[1], H[2], H[3]}
    od = __builtin_amdgcn_mfma_f32_32x32x16_bf16(pa0, AT_PK(l0, h0), od, 0, 0, 0);
    od = __builtin_amdgcn_mfma_f32_32x32x16_bf16(pa1, AT_PK(l1, h1), od, 0, 0, 0);
    od = __builtin_amdgcn_mfma_f32_32x32x16_bf16(pa2, AT_PK(l2, h2), od, 0, 0, 0);
    od = __builtin_amdgcn_mfma_f32_32x32x16_bf16(pa3, AT_PK(l3, h3), od, 0, 0, 0);
#undef AT_PK
}
constexpr int AT_BUF = 65536;
constexpr int AT_SCR = 2 * AT_BUF;
constexpr int AT_XA = AT_SCR + 2048;
constexpr int AT_XH = AT_XA + 1024;
constexpr int AT_OST = 0;
__device__ __forceinline__ void attn_mfma(LAS unsigned char* lds, int layer, int G, const int wave_s) {
    FRESH_IDS; FRESH_KP;
    unsigned char* ws = Pp->ws;
    const bf16_t* Q = (const bf16_t*)(ws + WS_Q); const bf16_t* Kb = (const bf16_t*)(ws + WS_K); const bf16_t* Vb = (const bf16_t*)(ws + WS_V);
    bf16_t* YM = (bf16_t*)(ws + WS_YM); const float* ZT = (const float*)(ws + WS_SSHY);
    const float* gat = Pp->in[20] + layer * ATTW; const float* ghy = Pp->in[19] + layer * HY;
    const int r32 = lane & 31, hi = lane >> 5, h = wave, kv = h >> 2;
    const float sk = Pp->in[18][layer * NH + h] * LOG2E;
    const unsigned lbase = (unsigned)(uintptr_t)lds;
    LAS float* al_l = (LAS float*)(lds + AT_SCR) + wave * 64; LAS float* li_l = al_l + 32;
    LAS float* xa = (LAS float*)(lds + AT_XA); LAS float* xh = (LAS float*)(lds + AT_XH);
    const int nunits = layer == DEPTH - 1 ? ML / 32 : MT / 32;
    for (int unit = blockIdx.x; unit < nunits; unit += G) {
        const bool isc = unit >= ML / 32;
        int b, q0, rowbase;
        if (!isc) { b = unit >> 7; q0 = (unit & 127) * 32; rowbase = b * SEQ + q0; } else { const int u = unit - ML / 32; b = u >> 3; q0 = (u & 7) * 32; rowbase = ML + b * CTX + q0; }
        int t_lo = 0, nw = 0;
        if (!isc) { int t_hi = 4; while (q0 - 128 + 64 * t_lo + 63 < 0) ++t_lo; while (q0 - 128 + 64 * t_hi > SEQ - 1) --t_hi; nw = t_hi - t_lo + 1; }
        const int NT = nw + CTX / 64;
        bf16x8 qr[8];
        { int hi_l = hi; asm volatile("" : "+v"(hi_l));
          const bf16_t* qp = Q + (size_t)(rowbase + r32) * ATTW + h * HD + hi_l * 8;
#pragma unroll
          for (int d0 = 0; d0 < 8; ++d0) qr[d0] = *(const bf16x8*)(qp + d0 * 16); }
        float m_reg = sk, l_reg = 1.0f; f32x16 o[4];
#pragma unroll
        for (int d = 0; d < 4; ++d)
#pragma unroll
            for (int r = 0; r < 16; ++r) o[d][r] = 0.f;
        bf16x8 s_k[4], s_v[4];
#define AT_KEY0(i) ((i) < nw ? q0 - 128 + 64 * (t_lo + (i)) : 64 * ((i) - nw))
#define AT_SLOAD(i) do { const bool win_ = (i) < nw; const int k0_ = AT_KEY0(i); int ll_; MK_LANE_ASM(ll_); const int tt_ = wave * 64 + ll_, sr = tt_ >> 4, sc = (tt_ & 15) * 8; \
        _Pragma("unroll") for (int hf_ = 0; hf_ < 2; ++hf_) { int kk_ = k0_ + sr + 32 * hf_; if (win_) kk_ = kk_ < 0 ? 0 : (kk_ > SEQ - 1 ? SEQ - 1 : kk_); \
            const size_t kr_ = (size_t)((win_ ? b * SEQ : ML + b * CTX) + kk_) * KVW + sc; \
            s_k[hf_] = *(const bf16x8*)(Kb + kr_); s_k[2 + hf_] = *(const bf16x8*)(Kb + kr_ + HD); s_v[hf_] = *(const bf16x8*)(Vb + kr_); s_v[2 + hf_] = *(const bf16x8*)(Vb + kr_ + HD); } } while (0)
#define AT_SWRITE(bf) do { LAS unsigned char* sb_ = lds + (bf) * AT_BUF; int ll_; MK_LANE_ASM(ll_); const int tt_ = wave * 64 + ll_, sr_ = tt_ >> 4, sc_ = (tt_ & 15) * 8, vst = v_st(sr_, sc_), kst = AT_KSWZ(sr_, sc_ * 2); \
        _Pragma("unroll") for (int hf_ = 0; hf_ < 2; ++hf_) { *(LAS bf16x8*)(sb_ + kst + hf_ * 8192) = s_k[hf_]; *(LAS bf16x8*)(sb_ + 16384 + kst + hf_ * 8192) = s_k[2 + hf_]; \
            *(LAS bf16x8*)(sb_ + 32768 + vst + hf_ * 8192) = s_v[hf_]; *(LAS bf16x8*)(sb_ + 49152 + vst + hf_ * 8192) = s_v[2 + hf_]; } } while (0)
        __syncthreads();
        { volatile LAS unsigned* MISC = (volatile LAS unsigned*)(lds + MISC_OFF); TS_MARK(0, MK_TS == 50 && layer == MK_TSL && unit < 256); }
        AT_SLOAD(0); AT_SWRITE(0);
        __syncthreads();
#pragma nounroll
        for (int i = 0; i < NT; ++i) {
            const int bf = i & 1;
            f32x16 p0, p1;
#pragma unroll
            for (int r = 0; r < 16; ++r) { p0[r] = 0.f; p1[r] = 0.f; }
            { const LAS unsigned char* Ks = lds + bf * AT_BUF + kv * 16384;
#pragma unroll
              for (int d0 = 0; d0 < 8; ++d0) { const int cb = (d0 * 16 + hi * 8) * 2;
                  const bf16x8 k0f = *(const LAS bf16x8*)(Ks + AT_KSWZ(r32, cb)), k1f = *(const LAS bf16x8*)(Ks + AT_KSWZ(32 + r32, cb));
                  p0 = __builtin_amdgcn_mfma_f32_32x32x16_bf16(k0f, qr[d0], p0, 0, 0, 0);
                  p1 = __builtin_amdgcn_mfma_f32_32x32x16_bf16(k1f, qr[d0], p1, 0, 0, 0); } }
            if (i < nw) { const int kb = AT_KEY0(i) + 4 * hi - (q0 + r32);
#pragma unroll
                for (int r = 0; r < 16; ++r) { const int d = kb + (r & 3) + 8 * (r >> 2), kk = d + q0 + r32;
                    if (d < -WINDOW || d > WINDOW || kk < 0) p0[r] = -1.0e30f;
                    if (d + 32 < -WINDOW || d + 32 > WINDOW || kk + 32 > SEQ - 1 || kk + 32 < 0) p1[r] = -1.0e30f;
                    if (kk > SEQ - 1) p0[r] = -1.0e30f; } }
            float pmax = fmaxf(p0[0], p1[0]);
#pragma unroll
            for (int r = 1; r < 16; ++r) pmax = fmaxf(pmax, fmaxf(p0[r], p1[r]));
            { auto rr = __builtin_amdgcn_permlane32_swap(__float_as_uint(pmax), __float_as_uint(pmax), false, false); pmax = fmaxf(__uint_as_float(rr[0]), __uint_as_float(rr[1])); }
            const float mn = fmaxf(m_reg, pmax), alpha = __builtin_amdgcn_exp2f(m_reg - mn); m_reg = mn;
            float ps = 0.f;
#pragma unroll
            for (int r = 0; r < 16; ++r) { p0[r] = __builtin_amdgcn_exp2f(p0[r] - mn); p1[r] = __builtin_amdgcn_exp2f(p1[r] - mn); ps += p0[r] + p1[r]; }
            { auto rr = __builtin_amdgcn_permlane32_swap(__float_as_uint(ps), __float_as_uint(ps), false, false); ps = __uint_as_float(rr[0]) + __uint_as_float(rr[1]); }
            l_reg = l_reg * alpha + ps;
            if (__any(alpha < 1.f)) { if (hi == 0) al_l[r32] = alpha; asm volatile("s_waitcnt lgkmcnt(0)" ::: "memory");
#pragma unroll
                for (int d = 0; d < 4; ++d)
#pragma unroll
                    for (int r = 0; r < 16; ++r) o[d][r] *= al_l[crow(r, hi)]; }
            bf16x8 pa0, pa1, pa2, pa3;
#define AT_PK4(P, BASE, OUT) do { unsigned a0 = cvtpk(P[BASE + 0], P[BASE + 1]), a1 = cvtpk(P[BASE + 2], P[BASE + 3]); unsigned b0 = cvtpk(P[BASE + 4], P[BASE + 5]), b1 = cvtpk(P[BASE + 6], P[BASE + 7]); \
    auto r0 = __builtin_amdgcn_permlane32_swap(a0, b0, false, false); auto r1 = __builtin_amdgcn_permlane32_swap(a1, b1, false, false); u32x4 w = {r0[0], r1[0], r0[1], r1[1]}; OUT = *reinterpret_cast<bf16x8*>(&w); } while (0)
            AT_PK4(p0, 0, pa0); AT_PK4(p0, 8, pa1); AT_PK4(p1, 0, pa2); AT_PK4(p1, 8, pa3);
#undef AT_PK4
            if (i + 1 < NT) AT_SLOAD(i + 1);
            { const int vb = (int)(lbase + bf * AT_BUF + 32768 + kv * 16384) + v_rd_base(lane);
              pv_one4<0>(o[0], vb, pa0, pa1, pa2, pa3); pv_one4<1>(o[1], vb, pa0, pa1, pa2, pa3); pv_one4<2>(o[2], vb, pa0, pa1, pa2, pa3); pv_one4<3>(o[3], vb, pa0, pa1, pa2, pa3); }
            if (i + 1 < NT) AT_SWRITE(bf ^ 1);
            __syncthreads();
        }
#undef AT_SLOAD
#undef AT_SWRITE
#undef AT_KEY0
        { volatile LAS unsigned* MISC = (volatile LAS unsigned*)(lds + MISC_OFF); TS_MARK(1, MK_TS == 50 && layer == MK_TSL && unit < 256); TS_MARK(0, MK_TS == 51 && layer == MK_TSL && unit < 256); TS_MARK(0, MK_TS == 52 && layer == MK_TSL && unit < 256); }
        if (hi == 0) li_l[r32] = l_reg; asm volatile("s_waitcnt lgkmcnt(0)" ::: "memory");
        float part[16];
#pragma unroll
        for (int r = 0; r < 16; ++r) { const float rl = __builtin_amdgcn_rcpf(li_l[crow(r, hi)]); float s = 0.f;
#pragma unroll
            for (int d = 0; d < 4; ++d) { o[d][r] *= rl; s += o[d][r] * o[d][r]; }
#pragma unroll
            for (int m = 1; m < 32; m <<= 1) s += __shfl_xor(s, m);
            part[r] = s; }
        if (r32 == 0) {
#pragma unroll
            for (int r = 0; r < 16; ++r) xa[wave * 32 + crow(r, hi)] = part[r]; }
        f32x4 zb[2][8]; float sh4[4] = {0.f, 0.f, 0.f, 0.f};
        const int rg = lane & 7, cbl = lane >> 3;
#pragma unroll
        for (int it = 0; it < 2; ++it) { const int c0 = (it * 64 + wave * 8 + cbl) * 8; const float* zp = ZT + (size_t)c0 * MT + rowbase + 4 * rg;
#pragma unroll
            for (int k = 0; k < 8; ++k) zb[it][k] = *(const f32x4*)(zp + (size_t)k * MT); }
#pragma unroll
        for (int it = 0; it < 2; ++it)
#pragma unroll
            for (int k = 0; k < 8; ++k)
#pragma unroll
                for (int i = 0; i < 4; ++i) sh4[i] += zb[it][k][i] * zb[it][k][i];
#pragma unroll
        for (int i = 0; i < 4; ++i) { float s = sh4[i]; s += __shfl_xor(s, 8); s += __shfl_xor(s, 16); s += __shfl_xor(s, 32); if (lane < 8) xh[wave * 32 + 4 * rg + i] = s; }
        __syncthreads();
        { volatile LAS unsigned* MISC = (volatile LAS unsigned*)(lds + MISC_OFF); TS_MARK(1, MK_TS == 52 && layer == MK_TSL && unit < 256); TS_MARK(0, MK_TS == 53 && layer == MK_TSL && unit < 256); }
        float ta = 0.f;
#pragma unroll
        for (int w = 0; w < 8; ++w) ta += xa[w * 32 + r32];
        const float ra = 1.0f / sqrtf(ta * (1.0f / ATTW) + EPS);
        float rh4[4];
#pragma unroll
        for (int i = 0; i < 4; ++i) { float th = 0.f;
#pragma unroll
            for (int w = 0; w < 8; ++w) th += xh[w * 32 + 4 * rg + i];
            rh4[i] = 1.0f / sqrtf(th * (1.0f / HY) + EPS); }
#pragma unroll
        for (int it = 0; it < 2; ++it) { const int c0 = (it * 64 + wave * 8 + cbl) * 8; const f32x4 g0 = *(const f32x4*)(ghy + c0), g1 = *(const f32x4*)(ghy + c0 + 4);
#pragma unroll
            for (int i = 0; i < 4; ++i) { const float r = rh4[i];
                u32x4 w; w.x = pk2(zb[it][0][i] * r * g0[0], zb[it][1][i] * r * g0[1]); w.y = pk2(zb[it][2][i] * r * g0[2], zb[it][3][i] * r * g0[3]);
                w.z = pk2(zb[it][4][i] * r * g1[0], zb[it][5][i] * r * g1[1]); w.w = pk2(zb[it][6][i] * r * g1[2], zb[it][7][i] * r * g1[3]);
                *(u32x4*)(YM + (size_t)(rowbase + 4 * rg + i) * D + c0) = w; } }
        { volatile LAS unsigned* MISC = (volatile LAS unsigned*)(lds + MISC_OFF); if (MK_TS == 53) asm volatile("s_waitcnt vmcnt(0)" ::: "memory"); TS_MARK(1, MK_TS == 53 && layer == MK_TSL && unit < 256); }
        if (hi == 0) al_l[r32] = ra; asm volatile("s_waitcnt lgkmcnt(0)" ::: "memory");
        { LAS unsigned char* ost = lds + AT_OST + wave * (32 * 272);
          float gc[4];
#pragma unroll
          for (int d = 0; d < 4; ++d) gc[d] = gat[h * HD + 32 * d + r32];
#pragma unroll
          for (int r = 0; r < 16; ++r) { const int q = crow(r, hi); const float rq = al_l[q];
#pragma unroll
              for (int d = 0; d < 4; ++d) *(LAS bf16_t*)(ost + q * 272 + (32 * d + r32) * 2) = (bf16_t)f2bf(o[d][r] * rq * gc[d]); }
          asm volatile("s_waitcnt lgkmcnt(0)" ::: "memory");
#pragma unroll
          for (int k = 0; k < 8; ++k) { const int q = k * 4 + (lane >> 4), ch = lane & 15;
              const u32x4 v = *(const LAS u32x4*)(ost + q * 272 + ch * 16);
              *(u32x4*)(YM + (size_t)(rowbase + q) * D + HY + h * HD + ch * 8) = v; } }
        { volatile LAS unsigned* MISC = (volatile LAS unsigned*)(lds + MISC_OFF); TS_MARK(1, MK_TS == 51 && layer == MK_TSL && unit < 256); }
    }
    __syncthreads();
}


template <int K>
__device__ __forceinline__ void ctx_small_gemm(LAS unsigned char* lds, const bf16_t* A, int lda, const bf16_t* Bt, int ldb, const float* Xin, bf16_t* X, const float* gate, const float* gnext, bf16_t* AN, float* ssqc, int G, const int wave_s, const int live = 1) {
    FRESH_IDS;
    typedef float f32x16_ __attribute__((ext_vector_type(16)));
    constexpr int KW = K / 8, NST = KW / 32;
    static_assert(KW % 32 == 0 && NST >= 2, "per-wave K slice in 32-deep steps");
    const int r32 = lane & 31, hi = lane >> 5;
    LAS unsigned char* wl = lds + wave * 16384;
    LAS float* rsum = (LAS float*)(lds + RING_BYTES + 5120);
    for (int tile = blockIdx.x; tile < (MC / 64) * (D / 64); tile += G) {
        const int rb = tile >> 5, cb = 4 * (tile & 7) + ((tile >> 3) & 3);
        const char* asrc[4]; const char* bsrc[4];
#pragma unroll
        for (int i = 0; i < 4; ++i) { const int vr = 4 * i + (lane >> 4), s = (lane & 15) ^ (vr & 7), row = 4 * vr + (s >> 2), ko = 8 * (s & 3);
            asrc[i] = (const char*)(A + (size_t)(rb * 64 + row) * lda + wave * KW + ko); bsrc[i] = (const char*)(Bt + (size_t)(cb * 64 + row) * ldb + wave * KW + ko); }
#define CS_ISSUE(st) do { LAS unsigned char* sl_ = wl + ((st) & 1) * 8192; _Pragma("unroll") for (int i_ = 0; i_ < 4; ++i_) { \
        __builtin_amdgcn_global_load_lds((const unsigned*)(asrc[i_] + (size_t)(st) * 64), (LAS unsigned*)(sl_ + i_ * 1024), 16, 0, 0); \
        __builtin_amdgcn_global_load_lds((const unsigned*)(bsrc[i_] + (size_t)(st) * 64), (LAS unsigned*)(sl_ + 4096 + i_ * 1024), 16, 0, 0); } } while (0)
        int foff[2][2];
#pragma unroll
        for (int blk = 0; blk < 2; ++blk)
#pragma unroll
            for (int ks = 0; ks < 2; ++ks) { const int row = 32 * blk + r32, vr = row >> 2; foff[blk][ks] = vr * 256 + ((((row & 3) * 4 + 2 * ks + hi) ^ (vr & 7)) << 4); }
        __syncthreads();
        f32x16_ acc[2][2];
#pragma unroll
        for (int i = 0; i < 2; ++i)
#pragma unroll
            for (int j = 0; j < 2; ++j)
#pragma unroll
                for (int q = 0; q < 16; ++q) acc[i][j][q] = 0.f;
        CS_ISSUE(0);
#pragma nounroll
        for (int st = 0; st < NST; ++st) {
            if (st + 1 < NST) { CS_ISSUE(st + 1); asm volatile("s_waitcnt vmcnt(8)" ::: "memory"); } else asm volatile("s_waitcnt vmcnt(0)" ::: "memory");
            const LAS unsigned char* sl = wl + (st & 1) * 8192;
            pg8::bf16x8 a[2][2], b[2][2];
#pragma unroll
            for (int blk = 0; blk < 2; ++blk)
#pragma unroll
                for (int ks = 0; ks < 2; ++ks) { a[blk][ks] = *(const LAS pg8::bf16x8*)(sl + foff[blk][ks]); b[blk][ks] = *(const LAS pg8::bf16x8*)(sl + 4096 + foff[blk][ks]); }
#pragma unroll
            for (int ks = 0; ks < 2; ++ks)
#pragma unroll
                for (int i = 0; i < 2; ++i)
#pragma unroll
                    for (int j = 0; j < 2; ++j) acc[i][j] = __builtin_amdgcn_mfma_f32_32x32x16_bf16(a[i][ks], b[j][ks], acc[i][j], 0, 0, 0);
            asm volatile("s_waitcnt lgkmcnt(0)" ::: "memory");
        }
#undef CS_ISSUE
        LAS float* red = (LAS float*)lds;
#pragma unroll
        for (int i = 0; i < 2; ++i)
#pragma unroll
            for (int j = 0; j < 2; ++j)
#pragma unroll
                for (int q = 0; q < 16; ++q) red[(wave * 64 + (i * 2 + j) * 16 + q) * 64 + lane] = acc[i][j][q];
        __syncthreads();
        { const int bi = wave >> 2, bj = (wave >> 1) & 1, qh = wave & 1;
          const int col = cb * 64 + bj * 32 + r32; const float gt = gate[col], gn = gnext ? gnext[col] : 0.f;
#pragma unroll
          for (int qq = 0; qq < 8; ++qq) { const int q = qh * 8 + qq; float v = 0.f;
#pragma unroll
              for (int w = 0; w < 8; ++w) v += red[(w * 64 + (bi * 2 + bj) * 16 + q) * 64 + lane];
              const int rloc = bi * 32 + (q & 3) + 8 * (q >> 2) + 4 * hi, row = rb * 64 + rloc;
              const float x = (Xin ? Xin[(size_t)row * D + col] : bf1(X[(size_t)row * D + col])) + gt * v;
              if (live) X[(size_t)row * D + col] = (bf16_t)f2bf(x);
              if (gnext && live) AN[(size_t)row * D + col] = (bf16_t)f2bf(x * gn);
              float s = x * x;
#pragma unroll
              for (int m = 1; m < 32; m <<= 1) s += __shfl_xor(s, m);
              if (r32 == 0) rsum[bj * 64 + rloc] = s; } }
        __syncthreads();
        if (wave == 0 && live) ssqc[(size_t)cb * MC + rb * 64 + lane] = rsum[lane] + rsum[64 + lane];
    }
    __syncthreads();
}

__device__ __forceinline__ void final_norm(int G, const int wave_s) {
    FRESH_IDS; FRESH_KP;
    unsigned char* ws = Pp->ws; const int gw = blockIdx.x * NWAVES + wave, NGW = G * NWAVES;
    const bf16_t* X = (const bf16_t*)(ws + WS_X); const float* SSQ = (const float*)(ws + WS_SSQ); const float* g = Pp->in[25];
    for (int row = gw; row < ML; row += NGW) {
        const float s = wave_sum(lane < 32 ? SSQ[((size_t)(lane >> 2) * MT + row) * 4 + (lane & 3)] : 0.f);
        const float r = 1.0f / sqrtf(s * (1.0f / D) + EPS);
#pragma unroll
        for (int j = 0; j < 4; ++j) { const int c = lane * 8 + 512 * j; const u32x4 xw = __builtin_nontemporal_load((const u32x4*)(X + (size_t)row * D + c));
            const f32x4 g0 = *(const f32x4*)(g + c), g1 = *(const f32x4*)(g + c + 4);
            __builtin_nontemporal_store((f32x4){bf_lo(xw.x), bf_hi(xw.x), bf_lo(xw.y), bf_hi(xw.y)} * r * g0, (f32x4*)(Pp->out + (size_t)row * D + c));
            __builtin_nontemporal_store((f32x4){bf_lo(xw.z), bf_hi(xw.z), bf_lo(xw.w), bf_hi(xw.w)} * r * g1, (f32x4*)(Pp->out + (size_t)row * D + c + 4)); }
    }
}

#ifndef MK_REP
#define MK_REP -1
#endif
#define REP(k) _Pragma("unroll") for (int rep_ = 0; rep_ < (MK_REP == (k) ? 2 : 1); ++rep_)
constexpr int NPHASE = 3 + 6 * DEPTH + 1;
__global__ void __launch_bounds__(NTHR, 2) mk_fwd(Params P) {
    extern __shared__ __attribute__((aligned(16))) unsigned char lds_raw[];
    LAS unsigned char* lds = (LAS unsigned char*)lds_raw;
    const int tid = threadIdx.x, G = gridDim.x, wave_s = __builtin_amdgcn_readfirstlane(tid >> 6);
    unsigned char* ws; int lo, hi; { FRESH_KP; ws = Pp->ws; lo = Pp->ph_lo; hi = Pp->ph_hi; }
    volatile LAS unsigned* MISC = (volatile LAS unsigned*)(lds + MISC_OFF);
    for (int u = tid; u < (LDS_BYTES - RING_BYTES) / 4; u += NTHR) ((LAS unsigned*)(lds + RING_BYTES))[u] = 0u;
    __syncthreads();
    XcdBarrier bar = xcd_barrier_post((unsigned*)(ws + WS_CTL) + CW_BAR, MISC + 8);
#define IN(k) (lo <= (k) && (k) < hi)
#define SEAM(k) do { if (IN(k) && IN((k) + 1)) xcd_barrier(bar, wave_s); } while (0)

    TS_MARK(0, MK_TS == 10); if (IN(0)) { REP(100) p0a(lds, G, wave_s); } SEAM(0); TS_MARK(1, MK_TS == 10); TS_MARK(0, MK_TS == 11);
    TS_MARK(0, MK_TS == 12);
    if (IN(2)) { REP(102) p0c(lds, G, wave_s); } SEAM(2); TS_MARK(1, MK_TS == 12);

    for (int layer = 0; layer < DEPTH; ++layer) {
        const int pb = 3 + 6 * layer;
        TS_MARK(0, MK_TS == 0 && layer == MK_TSL);
#define WSL FRESH_KP; unsigned char* w = Pp->ws; const float* MODL = (const float*)(w + WS_MOD) + (size_t)layer * 3 * 6 * D; (void)MODL
        if (IN(pb)) {
            WSL;
            pg8::Gemm g{(const bf16_t*)(w + WS_AN), (const bf16_t*)(w + WS_WIN) + (size_t)layer * INW * D, MT, INW_A, D, D, D};
            pg8::StaticOrder S; S.init(MT, INW_A, G, (int)blockIdx.x);
            EpiIn E{(const float*)(w + WS_SSQ), (const float*)(w + WS_SSQC), (const float*)(w + WS_SHWIN) + (size_t)layer * 3 * INW, (bf16_t*)(w + WS_PHY), (bf16_t*)(w + WS_Q), (bf16_t*)(w + WS_K), (bf16_t*)(w + WS_V), (const float*)(w + WS_ROPE), 1, 0};
            if (MK_REP == 8) { EpiIn Ed = E; Ed.live = lo > 1000; pg8::gemm_phase<EpiIn, pg8::StaticOrder, true, true>(lds, g, S, Ed, wave_s); }
            pg8::gemm_phase<EpiIn, pg8::StaticOrder, true, true>(lds, g, S, E, wave_s);
        }
        SEAM(pb); TS_MARK(1, MK_TS == 0 && layer == MK_TSL); TS_MARK(0, MK_TS == 1 && layer == MK_TSL);
        if (IN(pb + 1)) REP(2) {
            if ((int)blockIdx.x < NQKV) { WSL;
                pg8::Gemm g{(const bf16_t*)(w + WS_AN), (const bf16_t*)(w + WS_WIN) + ((size_t)layer * INW + INW_A) * D, MT, INW - INW_A, D, D, D};
                pg8::StaticOrder S; S.init(MT, INW - INW_A, G, (int)blockIdx.x);
                EpiIn E{(const float*)(w + WS_SSQ), (const float*)(w + WS_SSQC), (const float*)(w + WS_SHWIN) + (size_t)layer * 3 * INW, (bf16_t*)(w + WS_PHY), (bf16_t*)(w + WS_Q), (bf16_t*)(w + WS_K), (bf16_t*)(w + WS_V), (const float*)(w + WS_ROPE), 1, INW_A / 256};
                pg8::gemm_phase<EpiIn, pg8::StaticOrder, true, true>(lds, g, S, E, wave_s);
            }
            REP(21) hyena_fft(lds, layer, G, wave_s);
            if (layer != DEPTH - 1 && (int)blockIdx.x >= NQKV) REP(22) hyena_ctx(lds, layer, (int)blockIdx.x - NQKV, G - NQKV, wave_s);
            { constexpr int C4 = HY / 2 - 3 * (256 - NQKV);
              constexpr int N5 = HY - 3 * NQKV - 4 * (256 - NQKV);
              const int cfirst = layer != DEPTH - 1 ? NQKV + C4 : NQKV + N5;
              if ((int)blockIdx.x >= cfirst) { __syncthreads(); convert_layer(lds, layer, ((int)blockIdx.x - cfirst) * NWAVES + wave_s, (G - cfirst) * NWAVES, wave_s, 0, (D / 64) * (D / 32)); } }
        }
        SEAM(pb + 1); TS_MARK(1, MK_TS == 1 && layer == MK_TSL); TS_MARK(0, MK_TS == 2 && layer == MK_TSL);
        if (IN(pb + 2)) REP(3) {
            attn_mfma(lds, layer, G, wave_s);
            if (layer + 1 < DEPTH && (int)blockIdx.x >= MC / 32) { __syncthreads();
                taps_items<4>(layer + 1, 1, ((int)blockIdx.x - MC / 32) * NWAVES + wave_s, (G - MC / 32) * NWAVES, wave_s); }
        }
        SEAM(pb + 2); TS_MARK(1, MK_TS == 2 && layer == MK_TSL); TS_MARK(0, MK_TS == 3 && layer == MK_TSL);
        if (IN(pb + 3)) {
            WSL;
            pg8::Gemm g{(const bf16_t*)(w + WS_YM), (const bf16_t*)(w + WS_WOUT) + (size_t)layer * D * D, ML, D, D, D, D};
            pg8::StaticOrder S; S.init(ML, D, G, (int)blockIdx.x);
            EpiResid E{layer == 0 ? Pp->in[0] : (const float*)nullptr, (const bf16_t*)(w + WS_X), (bf16_t*)(w + WS_X), MODL + 2 * D, (const float*)(w + WS_GMV) + ((size_t)layer * 2 + 1) * 3 * D, (bf16_t*)(w + WS_AN), (float*)(w + WS_SSQ), 1};
            if (MK_REP == 4) { EpiResid Ed = E; Ed.live = lo > 1000; pg8::gemm_phase<EpiResid, pg8::StaticOrder, true, true>(lds, g, S, Ed, wave_s); }
            TS_MARK(0, MK_TS == 42 && layer == MK_TSL);
            pg8::gemm_phase<EpiResid, pg8::StaticOrder, true, true>(lds, g, S, E, wave_s);
            TS_MARK(1, MK_TS == 42 && layer == MK_TSL); TS_MARK(0, MK_TS == 40 && layer == MK_TSL);
            if (layer != DEPTH - 1)
                ctx_small_gemm<D>(lds, (const bf16_t*)(w + WS_YM) + (size_t)ML * D, D, (const bf16_t*)(w + WS_WOUT) + (size_t)layer * D * D, D, layer == 0 ? Pp->in[2] : (const float*)nullptr, (bf16_t*)(w + WS_X) + (size_t)ML * D,
                                  MODL + 2 * D + 2 * 6 * D, (const float*)(w + WS_GMV) + ((size_t)layer * 2 + 1) * 3 * D + 2 * D, (bf16_t*)(w + WS_AN) + (size_t)ML * D, (float*)(w + WS_SSQC), G, wave_s);
            TS_MARK(1, MK_TS == 40 && layer == MK_TSL);
        }
        SEAM(pb + 3); TS_MARK(1, MK_TS == 3 && layer == MK_TSL); TS_MARK(0, MK_TS == 4 && layer == MK_TSL);
        if (IN(pb + 4)) REP(5) {
            WSL;
            const int mrows = layer == DEPTH - 1 ? ML : MT;
            pg8::Gemm g{(const bf16_t*)(w + WS_AN), (const bf16_t*)(w + WS_WGU) + (size_t)layer * GU * D, mrows, GU, D, D, D};
            pg8::StaticOrder S; S.init(mrows, GU, G, (int)blockIdx.x);
            TS_MARK(0, MK_TS == 61 && layer == MK_TSL);
            EpiGU E{(const float*)(w + WS_SSQ), (const float*)(w + WS_SSQC), (const float*)(w + WS_SHWGU) + (size_t)layer * 3 * GU, (bf16_t*)(w + WS_HB), MISC, wave_s, layer == MK_TSL};
            pg8::gemm_phase<EpiGU, pg8::StaticOrder, true, true>(lds, g, S, E, wave_s);
            { const int busy = ((mrows / 256) * (GU / 256)) % G;
              if (busy && (int)blockIdx.x >= busy) convert_layer(lds, layer, ((int)blockIdx.x - busy) * NWAVES + wave_s, (G - busy) * NWAVES, wave_s, (D / 64) * (D / 32), CV_OUTD); }
        }
        SEAM(pb + 4); TS_MARK(1, MK_TS == 4 && layer == MK_TSL); TS_MARK(0, MK_TS == 5 && layer == MK_TSL);
        if (IN(pb + 5)) {
            WSL;
            pg8::Gemm g{(const bf16_t*)(w + WS_HB), (const bf16_t*)(w + WS_WD) + (size_t)layer * D * FF, ML, D, FF, FF, FF};
            pg8::StaticOrder S; S.init(ML, D, G, (int)blockIdx.x);
            EpiResid E{(const float*)nullptr, (const bf16_t*)(w + WS_X), (bf16_t*)(w + WS_X), MODL + 5 * D, layer + 1 < DEPTH ? (const float*)(w + WS_GMV) + ((size_t)(layer + 1) * 2 + 0) * 3 * D : nullptr, (bf16_t*)(w + WS_AN), (float*)(w + WS_SSQ), 1};
            if (MK_REP == 6) { EpiResid Ed = E; Ed.live = lo > 1000; pg8::gemm_phase<EpiResid, pg8::StaticOrder, true, true>(lds, g, S, Ed, wave_s); }
            TS_MARK(0, MK_TS == 43 && layer == MK_TSL);
            pg8::gemm_phase<EpiResid, pg8::StaticOrder, true, true>(lds, g, S, E, wave_s);
            TS_MARK(1, MK_TS == 43 && layer == MK_TSL); TS_MARK(0, MK_TS == 41 && layer == MK_TSL);
            if (layer != DEPTH - 1)
                ctx_small_gemm<FF>(lds, (const bf16_t*)(w + WS_HB) + (size_t)ML * FF, FF, (const bf16_t*)(w + WS_WD) + (size_t)layer * D * FF, FF, (const float*)nullptr, (bf16_t*)(w + WS_X) + (size_t)ML * D,
                                   MODL + 5 * D + 2 * 6 * D, (const float*)(w + WS_GMV) + ((size_t)(layer + 1) * 2 + 0) * 3 * D + 2 * D, (bf16_t*)(w + WS_AN) + (size_t)ML * D, (float*)(w + WS_SSQC), G, wave_s);
            TS_MARK(1, MK_TS == 41 && layer == MK_TSL);
            if (MK_REP == 7 && layer != DEPTH - 1)
                ctx_small_gemm<FF>(lds, (const bf16_t*)(w + WS_HB) + (size_t)ML * FF, FF, (const bf16_t*)(w + WS_WD) + (size_t)layer * D * FF, FF, (const float*)nullptr, (bf16_t*)(w + WS_X) + (size_t)ML * D,
                                   MODL + 5 * D + 2 * 6 * D, (const float*)(w + WS_GMV) + ((size_t)(layer + 1) * 2 + 0) * 3 * D + 2 * D, (bf16_t*)(w + WS_AN) + (size_t)ML * D, (float*)(w + WS_SSQC), G, wave_s, lo > 1000);
        }
        SEAM(pb + 5); TS_MARK(1, MK_TS == 5 && layer == MK_TSL); TS_MARK(0, MK_TS == 6 && layer == MK_TSL);
    }
    if (MK_REP == 50) { for (int e_ = 0; e_ < 40; ++e_) xcd_barrier(bar, wave_s); }
    if (IN(NPHASE - 1)) final_norm(G, wave_s);
    if (MK_TS >= 0 && blockIdx.x == MK_TSB && wave_s == 0) {
        const unsigned long long a_ = ((unsigned long long)MISC[17] << 32) | MISC[16], b_ = ((unsigned long long)MISC[19] << 32) | MISC[18], d_ = (b_ - a_) * 8ull;
        const unsigned long long s_ = __builtin_amdgcn_s_memrealtime();
        while (__builtin_amdgcn_s_memrealtime() - s_ < d_ && d_ < 400000000ull) __builtin_amdgcn_s_sleep(8);
    }
#undef IN
#undef SEAM
}
}

#ifndef MK_N_LAUNCHES
#define MK_N_LAUNCHES 1
#endif
extern "C" void kernel_launch(void* const* d_in, const int* in_sizes, int n_in, void* d_out, int out_size, void* d_ws, size_t ws_size, hipStream_t stream) {
    using namespace mk;
    static int grid = 0;
    if (grid == 0) {
        if (n_in != 26 || ws_size < WS_END) { fprintf(stderr, "kernel_launch: need 26 inputs and %zu bytes of workspace (got %d, %zu)\n", (size_t)WS_END, n_in, ws_size); grid = -1; return; }
        int dev = 0, cus = 0, per_cu = 0;
        if (hipGetDevice(&dev) != hipSuccess || hipDeviceGetAttribute(&cus, hipDeviceAttributeMultiprocessorCount, dev) != hipSuccess) { grid = -1; return; }
        if (hipFuncSetAttribute((const void*)mk_fwd, hipFuncAttributeMaxDynamicSharedMemorySize, LDS_BYTES) != hipSuccess) { fprintf(stderr, "kernel_launch: hipFuncSetAttribute failed\n"); grid = -1; return; }
        if (hipOccupancyMaxActiveBlocksPerMultiprocessor(&per_cu, (const void*)mk_fwd, NTHR, LDS_BYTES) != hipSuccess || per_cu < 1) { fprintf(stderr, "kernel_launch: occupancy query says %d\n", per_cu); }
        (void)hipGetLastError();
        grid = cus;
    }
    if (grid < 0) return;
    (void)hipMemsetAsync((char*)d_ws + WS_CTL, 0, CTL_BYTES, stream);
    Params p{};
    for (int i = 0; i < 26; ++i) p.in[i] = (const float*)d_in[i];
    p.out = (float*)d_out; p.ws = (unsigned char*)d_ws;
#if MK_N_LAUNCHES == 1
    p.ph_lo = 0; p.ph_hi = NPHASE;
    hipLaunchKernelGGL(mk_fwd, dim3(grid), dim3(NTHR), LDS_BYTES, stream, p);
#else
    for (int ph = 0; ph < NPHASE; ++ph) { p.ph_lo = ph; p.ph_hi = ph + 1; hipLaunchKernelGGL(mk_fwd, dim3(grid), dim3(NTHR), LDS_BYTES, stream, p); }
#endif
}
```
